# Optimizing an MI355X kernel written in HIP

```python
import math
import jax, jax.numpy as jnp
from jax import lax
import numpy as np

D_MODEL = 1024
BATCH = 16
SEQ = 256
DEPTH = 4
DEC_BATCH = 8
DEC_SEQ = 1024
PAST_LEN = 512

GRID_W = 64
N_BRANCH = 4
BRANCH_W = D_MODEL // 4
POOL_GROUPS = 4
POOL_GC = BRANCH_W // POOL_GROUPS
POOL_WINDOWS = (2, 4, 8, 16)
DA_HEADS = 4
DA_HD = BRANCH_W // DA_HEADS
DA_D = DA_HD // 2
FT_GROUPS = 4
FT_GC = BRANCH_W // FT_GROUPS
MLA_HEADS = 4
MLA_NOPE = 64
MLA_ROPE = 32
MLA_V = 64
MLA_QK = MLA_NOPE + MLA_ROPE
Q_LORA = 192
KV_LORA = 128
FFN_HIDDEN = 2816
CONV_W = 3
ROPE_BASE = 10000.0
EPS = 1e-6
Q_BLOCK = 128
GATE_COLS = N_BRANCH * D_MODEL
POOL_COLS = BRANCH_W
DA_COLS = 3 * DA_HEADS * DA_HD
FT_COLS = BRANCH_W
MLA_COLS = Q_LORA + KV_LORA + MLA_ROPE
IN_COLS = GATE_COLS + POOL_COLS + DA_COLS + FT_COLS + MLA_COLS
IN_SPLITS = [GATE_COLS, GATE_COLS + POOL_COLS, GATE_COLS + POOL_COLS + DA_COLS,
             GATE_COLS + POOL_COLS + DA_COLS + FT_COLS]

kernel_name = 'hybrid_diffusion_prefix_trunk_step'


def _rms(x, g):
    xf = x.astype(jnp.float32)
    y = xf * lax.rsqrt(jnp.mean(xf * xf, axis=-1, keepdims=True) + EPS)
    return (y * g.astype(jnp.float32)).astype(x.dtype)


def _rope_half(x, pos):
    half = x.shape[-1] // 2
    inv = ROPE_BASE ** (-jnp.arange(half, dtype=jnp.float32) / half)
    ang = pos.astype(jnp.float32)[:, None] * inv[None, :]
    cos = jnp.cos(ang)[:, None, :].astype(x.dtype)
    sin = jnp.sin(ang)[:, None, :].astype(x.dtype)
    x1, x2 = x[..., :half], x[..., half:]
    return jnp.concatenate([x1 * cos - x2 * sin, x1 * sin + x2 * cos], axis=-1)


def _rope_2d(x, pos):
    rows, cols = pos
    half = x.shape[-1] // 2
    return jnp.concatenate([_rope_half(x[..., :half], rows), _rope_half(x[..., half:], cols)], axis=-1)


def _map_query_blocks(fn, *qs):
    B, Q = qs[0].shape[:2]
    nb = Q // Q_BLOCK
    blocks = tuple(jnp.swapaxes(q.reshape((B, nb, Q_BLOCK) + q.shape[2:]), 0, 1) for q in qs)
    out = lax.map(lambda args: fn(*args), blocks)
    return jnp.swapaxes(out, 0, 1).reshape((B, Q) + out.shape[3:])


def _pool_mixer(xa, pool_w, pool_scale):
    B, T, _ = xa.shape
    xf = xa.reshape(B, T, POOL_GROUPS, POOL_GC).astype(jnp.float32)
    csum = jnp.concatenate([jnp.zeros_like(xf[:, :1]), jnp.cumsum(xf, axis=1)], axis=1)
    t = jnp.arange(T)[:, None]
    half = jnp.array(POOL_WINDOWS, dtype=jnp.int32)[None, :] // 2
    lo = jnp.clip(t - half, 0, T)
    hi = jnp.clip(t + half, 0, T)
    g = jnp.arange(POOL_GROUPS)[None, :]
    win = csum[:, hi, g, :] - csum[:, lo, g, :]
    mean = win / (hi - lo).astype(jnp.float32)[None, :, :, None]
    pooled = (mean - xf).astype(xa.dtype)
    y = jnp.einsum('btgc,gce->btge', pooled, pool_w)
    return y.reshape(B, T, BRANCH_W) * pool_scale


def _fourier(xc):
    B, T, _ = xc.shape
    xf = xc.reshape(B, T, FT_GROUPS, FT_GC).astype(jnp.float32)
    y = jnp.fft.fft2(xf, axes=(1, 3), norm='ortho').real
    return y.reshape(B, T, BRANCH_W).astype(xc.dtype)


def _diff_attention(q1, q2, k, v, lam):
    k1, k2 = k[..., :DA_D], k[..., DA_D:]
    scale = DA_D ** -0.5

    def blk(q1b, q2b):
        a1 = jax.nn.softmax((jnp.einsum('bqhd,bkhd->bhqk', q1b, k1) * scale).astype(jnp.float32), axis=-1)
        a2 = jax.nn.softmax((jnp.einsum('bqhd,bkhd->bhqk', q2b, k2) * scale).astype(jnp.float32), axis=-1)
        a = (a1 - lam * a2).astype(v.dtype)
        return jnp.einsum('bhqk,bkhd->bqhd', a, v)

    return _map_query_blocks(blk, q1, q2)


def _softmax_attention(q, k, v):
    scale = q.shape[-1] ** -0.5

    def blk(qb):
        s = jnp.einsum('bqhd,bkhd->bhqk', qb, k) * scale
        a = jax.nn.softmax(s.astype(jnp.float32), axis=-1).astype(v.dtype)
        return jnp.einsum('bhqk,bkhd->bqhd', a, v)

    return _map_query_blocks(blk, q)


def _mla_keys(ckv_n, krope, w_ukv, knorm, pos):
    B, T, _ = ckv_n.shape
    kv = (ckv_n @ w_ukv).reshape(B, T, MLA_HEADS, MLA_NOPE + MLA_V)
    k_nope, v = kv[..., :MLA_NOPE], kv[..., MLA_NOPE:]
    k_r = jnp.broadcast_to(krope[:, :, None, :], (B, T, MLA_HEADS, MLA_ROPE))
    k = _rms(jnp.concatenate([k_nope, k_r], axis=-1), knorm)
    if pos is not None:
        k = jnp.concatenate([k[..., :MLA_NOPE], _rope_2d(k[..., MLA_NOPE:], pos)], axis=-1)
    return k, v


def _conv_ffn(h, w_up, conv_w, conv_b, w_down):
    u = h @ w_up
    up = jnp.pad(u, ((0, 0), (1, 1), (0, 0)))
    u = up[:, :-2] * conv_w[0] + up[:, 1:-1] * conv_w[1] + up[:, 2:] * conv_w[2] + conv_b
    gate, val = jnp.split(u, 2, axis=-1)
    return (jax.nn.silu(gate) * val) @ w_down


def _layer(x, cond, p, lam_init, pos, ctx):
    B, T, _ = x.shape
    mod = jnp.einsum('bd,de->be', jax.nn.silu(cond), p['w_ada']) + p['b_ada']
    sh1, sc1, g1, sh2, sc2, g2 = jnp.split(mod[:, None, :], 6, axis=-1)
    h = _rms(x, p['g_norm1']) * (1 + sc1) + sh1
    u = h @ p['w_in']
    gates, xa, qkv_da, xc, mla_in = jnp.split(u, IN_SPLITS, axis=-1)

    out_a = _pool_mixer(xa, p['pool_w'], p['pool_scale'])

    qkv = qkv_da.reshape(B, T, 3, DA_HEADS, DA_HD)
    q_da, k_da, v_da = qkv[:, :, 0], qkv[:, :, 1], qkv[:, :, 2]
    q1 = _rms(q_da[..., :DA_D], p['diff_qnorm'])
    q2 = _rms(q_da[..., DA_D:], p['diff_qnorm'])
    k1 = _rms(k_da[..., :DA_D], p['diff_knorm'])
    k2 = _rms(k_da[..., DA_D:], p['diff_knorm'])
    k_cache_form = jnp.concatenate([k1, k2], axis=-1)
    if pos is not None:
        q1, q2 = _rope_2d(q1, pos), _rope_2d(q2, pos)
        k_self = jnp.concatenate([_rope_2d(k1, pos), _rope_2d(k2, pos)], axis=-1)
    else:
        k_self = k_cache_form
    if ctx is None:
        k_all, v_all = k_self, v_da
    else:
        k_all = jnp.concatenate([ctx['diff_k'], k_self], axis=1)
        v_all = jnp.concatenate([ctx['diff_v'], v_da], axis=1)
    lq = p['diff_lambda'].astype(jnp.float32)
    lam = jnp.exp(jnp.sum(lq[0] * lq[1])) - jnp.exp(jnp.sum(lq[2] * lq[3])) + lam_init
    out_b = _diff_attention(q1, q2, k_all, v_all, lam)
    out_b = (_rms(out_b, p['diff_subln']) * (1.0 - lam_init)).reshape(B, T, BRANCH_W)

    out_c = _fourier(xc)

    c_q = mla_in[..., :Q_LORA]
    c_kv = mla_in[..., Q_LORA:Q_LORA + KV_LORA]
    k_rope = mla_in[..., Q_LORA + KV_LORA:]
    q = (_rms(c_q, p['mla_qa_norm']) @ p['w_uq']).reshape(B, T, MLA_HEADS, MLA_QK)
    q = _rms(q, p['mla_qnorm'])
    if pos is not None:
        q = jnp.concatenate([q[..., :MLA_NOPE], _rope_2d(q[..., MLA_NOPE:], pos)], axis=-1)
    ckv_n = _rms(c_kv, p['mla_kv_norm'])
    k_m, v_m = _mla_keys(ckv_n, k_rope, p['w_ukv'], p['mla_knorm'], pos)
    if ctx is not None:
        k_c, v_c = _mla_keys(ctx['ckv'], ctx['krope'], p['w_ukv'], p['mla_knorm'], None)
        k_m = jnp.concatenate([k_c, k_m], axis=1)
        v_m = jnp.concatenate([v_c, v_m], axis=1)
    out_d = _softmax_attention(q, k_m, v_m).reshape(B, T, MLA_HEADS * MLA_V)

    branches = jnp.stack([out_a, out_b, out_c, out_d], axis=2)
    proj = jnp.einsum('btnw,nwd->btnd', branches, p['w_branch'])
    gsig = jax.nn.sigmoid(gates.reshape(B, T, N_BRANCH, D_MODEL).astype(jnp.float32)).astype(x.dtype)
    merged = jnp.sum(gsig * proj, axis=2)
    x = x + g1 * (merged @ p['w_out'])

    h2 = _rms(x, p['g_norm2']) * (1 + sc2) + sh2
    x = x + g2 * _conv_ffn(h2, p['w_up'], p['conv_w'], p['conv_b'], p['w_down'])
    return x, (k_cache_form, v_da, ckv_n, k_rope)


def _lambda_init(l):
    return 0.8 - 0.6 * math.exp(-0.3 * l)


def setup_inputs(seed: int = 0) -> dict:
    key = jax.random.key(seed)
    ks = jax.random.split(key, 32)
    f32 = jnp.float32

    def nrm(k, shape, scale=1.0):
        return jax.random.normal(k, shape, f32) * scale

    def gain(k, shape):
        return 1.0 + 0.05 * jax.random.normal(k, shape, f32)

    F2 = 2 * FFN_HIDDEN
    return {
        'x_prompt': nrm(ks[0], (BATCH, SEQ, D_MODEL)),
        'x_sample': nrm(ks[1], (DEC_BATCH, DEC_SEQ, D_MODEL)),
        'c': nrm(ks[2], (DEC_BATCH, D_MODEL)),
        'c_ctx': nrm(ks[3], (D_MODEL,)),
        'cache_diff_k': nrm(ks[4], (DEC_BATCH, DEPTH, PAST_LEN, DA_HEADS, DA_HD)),
        'cache_diff_v': nrm(ks[5], (DEC_BATCH, DEPTH, PAST_LEN, DA_HEADS, DA_HD)),
        'cache_mla_ckv': nrm(ks[6], (DEC_BATCH, DEPTH, PAST_LEN, KV_LORA)),
        'cache_mla_krope': nrm(ks[7], (DEC_BATCH, DEPTH, PAST_LEN, MLA_ROPE)),
        'w_ada': nrm(ks[8], (DEPTH, D_MODEL, 6 * D_MODEL), 0.5 * D_MODEL ** -0.5),
        'b_ada': nrm(ks[9], (DEPTH, 6 * D_MODEL), 0.01),
        'g_norm1': gain(ks[10], (DEPTH, D_MODEL)),
        'g_norm2': gain(ks[11], (DEPTH, D_MODEL)),
        'w_in': nrm(ks[12], (DEPTH, D_MODEL, IN_COLS), D_MODEL ** -0.5),
        'pool_w': nrm(ks[13], (DEPTH, POOL_GROUPS, POOL_GC, POOL_GC), POOL_GC ** -0.5),
        'pool_scale': gain(ks[14], (DEPTH, BRANCH_W)),
        'diff_qnorm': gain(ks[15], (DEPTH, DA_D)),
        'diff_knorm': gain(ks[16], (DEPTH, DA_D)),
        'diff_lambda': nrm(ks[17], (DEPTH, 4, DA_D), 0.1),
        'diff_subln': gain(ks[18], (DEPTH, DA_HD)),
        'mla_qa_norm': gain(ks[19], (DEPTH, Q_LORA)),
        'w_uq': nrm(ks[20], (DEPTH, Q_LORA, MLA_HEADS * MLA_QK), Q_LORA ** -0.5),
        'mla_kv_norm': gain(ks[21], (DEPTH, KV_LORA)),
        'w_ukv': nrm(ks[22], (DEPTH, KV_LORA, MLA_HEADS * (MLA_NOPE + MLA_V)), KV_LORA ** -0.5),
        'mla_qnorm': gain(ks[23], (DEPTH, MLA_QK)),
        'mla_knorm': gain(ks[24], (DEPTH, MLA_QK)),
        'w_branch': nrm(ks[25], (DEPTH, N_BRANCH, BRANCH_W, D_MODEL), BRANCH_W ** -0.5),
        'w_out': nrm(ks[26], (DEPTH, D_MODEL, D_MODEL), D_MODEL ** -0.5),
        'w_up': nrm(ks[27], (DEPTH, D_MODEL, F2), D_MODEL ** -0.5),
        'conv_w': nrm(ks[28], (DEPTH, CONV_W, F2), CONV_W ** -0.5),
        'conv_b': nrm(ks[29], (DEPTH, F2), 0.01),
        'w_down': nrm(ks[30], (DEPTH, FFN_HIDDEN, D_MODEL), FFN_HIDDEN ** -0.5),
    }


def reference(x_prompt, x_sample, c, c_ctx, cache_diff_k, cache_diff_v, cache_mla_ckv, cache_mla_krope,
              w_ada, b_ada, g_norm1, g_norm2, w_in, pool_w, pool_scale, diff_qnorm, diff_knorm,
              diff_lambda, diff_subln, mla_qa_norm, w_uq, mla_kv_norm, w_ukv, mla_qnorm, mla_knorm,
              w_branch, w_out, w_up, conv_w, conv_b, w_down):
    def params(l):
        return {
            'w_ada': w_ada[l], 'b_ada': b_ada[l], 'g_norm1': g_norm1[l], 'g_norm2': g_norm2[l],
            'w_in': w_in[l], 'pool_w': pool_w[l], 'pool_scale': pool_scale[l],
            'diff_qnorm': diff_qnorm[l], 'diff_knorm': diff_knorm[l], 'diff_lambda': diff_lambda[l],
            'diff_subln': diff_subln[l], 'mla_qa_norm': mla_qa_norm[l], 'w_uq': w_uq[l],
            'mla_kv_norm': mla_kv_norm[l], 'w_ukv': w_ukv[l], 'mla_qnorm': mla_qnorm[l],
            'mla_knorm': mla_knorm[l], 'w_branch': w_branch[l], 'w_out': w_out[l],
            'w_up': w_up[l], 'conv_w': conv_w[l], 'conv_b': conv_b[l], 'w_down': w_down[l],
        }

    y = x_prompt
    ks_, vs_, cs_, rs_ = [], [], [], []
    for l in range(DEPTH):
        y, (kc, vc, ckv, kr) = _layer(y, c_ctx[None, :], params(l), _lambda_init(l), None, None)
        ks_.append(kc)
        vs_.append(vc)
        cs_.append(ckv)
        rs_.append(kr)
    y_prompt = y
    new_diff_k = jnp.stack(ks_, axis=1)
    new_diff_v = jnp.stack(vs_, axis=1)
    new_mla_ckv = jnp.stack(cs_, axis=1)
    new_mla_krope = jnp.stack(rs_, axis=1)

    n_tok = x_sample.shape[1]
    n_rows = n_tok // GRID_W
    rows = jnp.repeat(jnp.arange(n_rows), GRID_W)
    cols = jnp.tile(jnp.arange(GRID_W), n_rows)
    pos = (rows, cols)
    z = x_sample
    for l in range(DEPTH):
        ctx = {'diff_k': cache_diff_k[:, l], 'diff_v': cache_diff_v[:, l],
               'ckv': cache_mla_ckv[:, l], 'krope': cache_mla_krope[:, l]}
        z, _ = _layer(z, c, params(l), _lambda_init(l), pos, ctx)
    y_sample = z

    return (y_prompt, y_sample, new_diff_k, new_diff_v, new_mla_ckv, new_mla_krope)
```

```cpp
#include <hip/hip_runtime.h>
#include <hip/hip_cooperative_groups.h>
#include <cstdio>
namespace cg = cooperative_groups;

#define DI __device__ __forceinline__
#define LAS __attribute__((address_space(3)))
typedef unsigned short bf16_t;
typedef short bf16x8 __attribute__((ext_vector_type(8)));
typedef short s16x4 __attribute__((ext_vector_type(4)));
typedef float f32x4 __attribute__((ext_vector_type(4)));
typedef unsigned u32x4 __attribute__((ext_vector_type(4)));
typedef unsigned u32x2 __attribute__((ext_vector_type(2)));

constexpr int DM = 1024, MC = 4096, ML = 8192, MT = 12288, NLAY = 4;
constexpr int INC = 5728, INP = 5888, USW = 1792, F2 = 5632, FH = 2816;
constexpr float EPSV = 1e-6f;
constexpr int NTHR = 512;
constexpr int LDS_BYTES = 131072;
constexpr int US_POOL = 0, US_Q = 256, US_K = 512, US_V = 768, US_FT = 1024, US_CQ = 1280, US_CKV = 1472, US_KR = 1600;

constexpr size_t al256(size_t x) { return (x + 255) & ~(size_t)255; }
constexpr size_t WS_WIN = 4096;
constexpr size_t SZ_WIN = (size_t)INP * DM * 2;
constexpr size_t WS_WB = WS_WIN + NLAY * SZ_WIN;
constexpr size_t SZ_WB = (size_t)4096 * 256 * 2;
constexpr size_t WS_WO = WS_WB + NLAY * SZ_WB;
constexpr size_t SZ_WO = (size_t)DM * DM * 2;
constexpr size_t WS_WUP = WS_WO + NLAY * SZ_WO;
constexpr size_t SZ_WUP = (size_t)F2 * DM * 2;
constexpr size_t WS_WD = WS_WUP + NLAY * SZ_WUP;
constexpr size_t SZ_WD = (size_t)DM * FH * 2;
constexpr size_t WS_WUQ = WS_WD + NLAY * SZ_WD;
constexpr size_t SZ_SM = (size_t)512 * 256 * 2;
constexpr size_t WS_WUKV = WS_WUQ + NLAY * SZ_SM;
constexpr size_t WS_WUKVP = WS_WUKV + NLAY * SZ_SM;
constexpr size_t WS_BDFT = WS_WUKVP + NLAY * SZ_SM;
constexpr size_t WS_BDPOOL = WS_BDFT + SZ_SM;
constexpr size_t SZ_BDPOOL = (size_t)256 * 256 * 2;
constexpr size_t WS_D1024 = WS_BDPOOL + NLAY * SZ_BDPOOL;
constexpr size_t WS_D256 = WS_D1024 + (size_t)1024 * 2048 * 2;
constexpr size_t WS_MOD = WS_D256 + (size_t)256 * 512 * 2;
constexpr size_t WS_HM = al256(WS_MOD + (size_t)NLAY * 9 * 6144 * 4);
constexpr size_t SZ_HM = (size_t)MT * DM * 2;
constexpr size_t HM_QM = 0, HM_KMS = (size_t)MT * 384 * 2, HM_QD = 2 * (size_t)MT * 384 * 2;
constexpr size_t WS_R1 = WS_HM + SZ_HM;
constexpr size_t R1_SG = 0, R1_US = (size_t)MT * 4096 * 2;
constexpr size_t SZ_R1 = R1_US + (size_t)MT * USW * 2;
constexpr size_t R1_AC = 0, R1_KVRC = (size_t)NLAY * 4096 * 256 * 2;
constexpr size_t WS_R2 = WS_R1 + SZ_R1;
constexpr size_t R2_BR = 0, R2_MP = (size_t)MT * DM * 2;
constexpr size_t R2_QRAW = R2_MP, R2_KVRAW = R2_QRAW + (size_t)MT * 512 * 2, R2_ZTL = R2_KVRAW + (size_t)MT * 512 * 2,
                 R2_ZTC = R2_ZTL + (size_t)2048 * 2048 * 2, R2_POOLED = R2_ZTC + (size_t)16 * 256 * 512 * 2;
constexpr size_t SZ_R2 = R2_MP + (size_t)MT * DM * 4;
constexpr size_t WS_KDS = WS_R2 + SZ_R2;
constexpr size_t SZ_S64 = (size_t)MT * 256 * 2;
constexpr size_t WS_VDTS = WS_KDS + SZ_S64;
constexpr size_t WS_VMTS = WS_VDTS + SZ_S64;
constexpr size_t WS_KDC = WS_VMTS + SZ_S64;
constexpr size_t SZ_C64 = (size_t)NLAY * 8 * 4 * 512 * 64 * 2;
constexpr size_t WS_VDTC = WS_KDC + SZ_C64;
constexpr size_t WS_KMC = WS_VDTC + SZ_C64;
constexpr size_t WS_VMTC = WS_KMC + (size_t)NLAY * 8 * 4 * 512 * 96 * 2;
constexpr size_t WS_END = WS_VMTC + SZ_C64;
static_assert(R2_POOLED + (size_t)MT * 256 * 2 <= SZ_R2, "r2 overlay");
static_assert((size_t)MT * F2 * 2 <= SZ_R1, "u2 fits r1");
static_assert((size_t)MT * FH * 2 <= SZ_R2, "act fits r2");
static_assert(HM_QD + (size_t)MT * 256 * 2 <= SZ_HM, "hm overlay");

constexpr size_t O_X = 0, O_DK = 12582912, O_DV = 16777216, O_CKV = 20971520, O_KR = 23068672;

DI bf16_t f2bf(float f) { unsigned u = __float_as_uint(f); u += 0x7FFFu + ((u >> 16) & 1u); return (bf16_t)(u >> 16); }
DI float bf2f(bf16_t b) { return __uint_as_float(((unsigned)b) << 16); }
DI float bflo(unsigned w) { return __uint_as_float(w << 16); }
DI float bfhi(unsigned w) { return __uint_as_float(w & 0xffff0000u); }
DI unsigned pk2(float lo, float hi) { return (unsigned)f2bf(lo) | ((unsigned)f2bf(hi) << 16); }
DI unsigned cvt_pk_bf16(float lo, float hi) { unsigned r; asm volatile("v_cvt_pk_bf16_f32 %0, %1, %2" : "=v"(r) : "v"(lo), "v"(hi)); return r; }
DI float wave_sum(float v) { for (int o = 32; o >= 1; o >>= 1) v += __shfl_xor(v, o); return v; }
DI int cond_row(int row) { return row < MC ? 0 : 1 + ((row - MC) >> 10); }
DI float sigmoidf_(float x) { return __builtin_amdgcn_rcpf(1.0f + __expf(-x)); }
DI void sincos_rev(float ang, float& s, float& c) { float f = ang * 0.15915494309189535f; f -= rintf(f); s = __builtin_amdgcn_sinf(f); c = __builtin_amdgcn_cosf(f); }
__device__ const float ROPE_INV[8] = {1.0f, 0.31622776601683794f, 0.1f, 0.031622776601683794f, 0.01f, 0.0031622776601683794f, 0.001f, 0.00031622776601683794f};
#define ROPE32(y, base, prow, pcol) do { _Pragma("unroll") for (int _i = 0; _i < 8; ++_i) { float _s, _c; \
    sincos_rev((prow) * ROPE_INV[_i], _s, _c); { const float _a = y[(base) + _i], _b = y[(base) + 8 + _i]; y[(base) + _i] = _a * _c - _b * _s; y[(base) + 8 + _i] = _a * _s + _b * _c; } \
    sincos_rev((pcol) * ROPE_INV[_i], _s, _c); { const float _a = y[(base) + 16 + _i], _b = y[(base) + 24 + _i]; y[(base) + 16 + _i] = _a * _c - _b * _s; y[(base) + 24 + _i] = _a * _s + _b * _c; } } } while (0)

namespace pg8 {
constexpr int BM = 256, BK = 64, HALF = 128, HTB = HALF * BK * 2, STAGE_BYTES = 8 * HTB, NXCD = 8, WGM = 8;
DI int lds_byte(int r, int c) { const int st = (r >> 4) * 2 + (c >> 5), rr = r & 15, cc = c & 31, ob = rr * 64 + cc * 2; return st * 1024 + (ob ^ (((ob >> 9) & 1) << 5)); }
DI void stage_rc(int b, int& R, int& C) { const int st = b / 1024, sb = b % 1024, swz = sb ^ (((sb >> 9) & 1) << 5); R = (st >> 1) * 16 + swz / 64; C = (st & 1) * 32 + (swz % 64) / 2; }
DI int perm32(int rho) { const int n = rho >> 4, i = rho & 15; return 8 * (i >> 2) + 4 * n + (i & 3); }
struct Unit { const char* a; const char* b; int pm, pn, z; };
struct Gemm { int lda, ldb, K; };
struct TileOrder {
    int nM, nN, nwg, G, c;
    DI void init(int nM_, int nN_, int G_, int c_) { nM = nM_; nN = nN_; nwg = nM * nN; G = G_; c = c_; }
    DI bool tile(int i, int& pm, int& pn) const {
        const long L = (long)i * G + c; if (L >= nwg) return false;
        int wgid = (int)L; { const int q = nwg / NXCD, r = nwg % NXCD, xcd = wgid % NXCD, off = wgid / NXCD; wgid = (xcd < r ? xcd * (q + 1) : r * (q + 1) + (xcd - r) * q) + off; }
        const int nig = WGM * nN, gid = wgid / nig, fm = gid * WGM, gsz = (nM - fm) < WGM ? (nM - fm) : WGM;
        pm = fm + ((wgid % nig) % gsz); pn = (wgid % nig) / gsz; return true;
    }
};
struct SchedPlain : TileOrder {
    const char* A; const char* B; size_t tA, tB, zB; int amask, zshift;
    DI void set(const void* A_, const void* B_, int lda, int ldb, int nM_, int nN_, int G_, int c_, int amask_ = -1, int zshift_ = 31, size_t zB_ = 0) {
        A = (const char*)A_; B = (const char*)B_; tA = (size_t)BM * lda * 2; tB = (size_t)BM * ldb * 2; amask = amask_; zshift = zshift_; zB = zB_; init(nM_, nN_, G_, c_); }
    DI bool next(int i, Unit& u) const { if (!tile(i, u.pm, u.pn)) return false; u.z = u.pm >> zshift;
        u.a = A + (size_t)(u.pm & amask) * tA; u.b = B + (size_t)u.z * zB + (size_t)u.pn * tB; return true; }
};
struct SchedProj : TileOrder {
    const char* A; const char* B;
    DI bool next(int i, Unit& u) const { if (!tile(i >> 2, u.pm, u.pn)) return false; const int n = i & 3; u.z = n;
        u.a = A + (size_t)u.pm * (BM * 1024 * 2) + n * 512; u.b = B + ((size_t)n * 1024 + u.pn * 256) * 512; return true; }
};

template <class Epi, class Sched>
DI void gemm_phase(LAS unsigned char* lds, const Gemm g, const Sched& S, const Epi& E) {
    int tid = threadIdx.x; asm volatile("" : "+v"(tid));
    const int wid = __builtin_amdgcn_readfirstlane(tid >> 6), lane = tid & 63, wr = wid >> 2, wc = wid & 3, fr = lane & 15, fq = lane >> 4;
    int K = g.K; asm volatile("" : "+s"(K)); const int nt = K / BK;
    unsigned voffA[2], voffB[2];
#pragma unroll
    for (int i = 0; i < 2; ++i) { int R, C; stage_rc(tid * 16 + i * 8192, R, C); const int Rb = Epi::PERM ? ((R & ~31) + perm32(R & 31)) : R;
        voffA[i] = (unsigned)(R * g.lda + C) * 2u; voffB[i] = (unsigned)(Rb * g.ldb + C) * 2u; }
    const size_t kstep = (size_t)(BK * 2);
    const size_t hstepA = (size_t)HALF * g.lda * 2, hstepB = (size_t)HALF * g.ldb * 2;
    const unsigned ldsw = (unsigned)wid * 1024u;
    const int aoff = lds_byte(wr * 64 + fr, fq * 8), boff = lds_byte(wc * 32 + fr, fq * 8);
#define PG8_SA(b, h) (((b) * 2 + (h)) * HTB)
#define PG8_SB(b, h) ((4 + (b) * 2 + (h)) * HTB)
#define PG8_STAGE(bufoff, gbase, voff) do { _Pragma("unroll") for (int _i = 0; _i < 2; ++_i) \
        __builtin_amdgcn_global_load_lds((const unsigned*)((const char*)(gbase) + (voff)[_i]), (LAS unsigned*)(lds + (bufoff) + ldsw + _i * 8192), 16, 0, 0); } while (0)
#define PG8_LDA(dst, b, h) do { _Pragma("unroll") for (int m = 0; m < 4; ++m) _Pragma("unroll") for (int k = 0; k < 2; ++k) dst[m][k] = *(const LAS bf16x8*)(lds + PG8_SA(b, h) + aoff + m * 2048 + k * 1024); } while (0)
#define PG8_LDB(dst, b, h) do { _Pragma("unroll") for (int n = 0; n < 2; ++n) _Pragma("unroll") for (int k = 0; k < 2; ++k) dst[n][k] = *(const LAS bf16x8*)(lds + PG8_SB(b, h) + boff + n * 2048 + k * 1024); } while (0)
#define PG8_MMA(ai, bj, At, Bt) do { __builtin_amdgcn_s_setprio(1); _Pragma("unroll") for (int m = 0; m < 4; ++m) _Pragma("unroll") for (int n = 0; n < 2; ++n) _Pragma("unroll") for (int k = 0; k < 2; ++k) \
        acc[ai][bj][m][n] = __builtin_amdgcn_mfma_f32_16x16x32_bf16(Bt[n][k], At[m][k], acc[ai][bj][m][n], 0, 0, 0); __builtin_amdgcn_s_setprio(0); } while (0)
#define PG8_WAIT_V(n) asm volatile("s_waitcnt vmcnt(" #n ")" ::: "memory")
#define PG8_WAIT_L(n) asm volatile("s_waitcnt lgkmcnt(" #n ")" ::: "memory")
#define PG8_BAR __builtin_amdgcn_s_barrier()
#define PG8_SCHED __builtin_amdgcn_sched_barrier(0)
    Unit cur, nxt; int ui = 0;
    if (!S.next(0, cur)) return;
    f32x4 acc[2][2][4][2];
#pragma unroll
    for (int a = 0; a < 2; ++a)
#pragma unroll
        for (int b = 0; b < 2; ++b)
#pragma unroll
            for (int m = 0; m < 4; ++m)
#pragma unroll
                for (int n = 0; n < 2; ++n) acc[a][b][m][n] = (f32x4){0.f, 0.f, 0.f, 0.f};
    bf16x8 At[4][2], B0[2][2], B1[2][2];
    const char* cA = cur.a; const char* cB = cur.b;
    PG8_STAGE(PG8_SB(0, 0), cB, voffB); PG8_STAGE(PG8_SA(0, 0), cA, voffA); PG8_STAGE(PG8_SB(0, 1), cB + hstepB, voffB); PG8_STAGE(PG8_SA(0, 1), cA + hstepA, voffA);
    if (wr == 1) PG8_BAR;
    PG8_WAIT_V(4); PG8_BAR;
    PG8_STAGE(PG8_SB(1, 0), cB + kstep, voffB); PG8_STAGE(PG8_SA(1, 0), cA + kstep, voffA); PG8_STAGE(PG8_SB(1, 1), cB + hstepB + kstep, voffB);
    PG8_WAIT_V(6); PG8_BAR;
    for (;;) {
        const bool has_next = S.next(ui + 1, nxt);
        const char* nA = has_next ? nxt.a : cA; const char* nB = has_next ? nxt.b : cB;
#pragma unroll 1
        for (int t = 0; t < nt; t += 2) {
            const bool last = (t == nt - 2);
            const char* a1 = cA + (size_t)(t + 1) * kstep;
            const char* a2 = last ? nA : cA + (size_t)(t + 2) * kstep; const char* b2 = last ? nB : cB + (size_t)(t + 2) * kstep;
            const char* a3 = a2 + kstep; const char* b3 = b2 + kstep;
            PG8_LDB(B0, 0, 0); PG8_SCHED; PG8_LDA(At, 0, 0); PG8_STAGE(PG8_SA(1, 1), a1 + hstepA, voffA);
            PG8_WAIT_L(8); PG8_BAR; PG8_WAIT_L(0); PG8_MMA(0, 0, At, B0); PG8_BAR; PG8_SCHED;
            PG8_LDB(B1, 0, 1); PG8_STAGE(PG8_SB(0, 0), b2, voffB);
            PG8_BAR; PG8_WAIT_L(0); PG8_MMA(0, 1, At, B1); PG8_BAR;
            PG8_LDA(At, 0, 1); PG8_STAGE(PG8_SA(0, 0), a2, voffA);
            PG8_BAR; PG8_WAIT_L(0); PG8_MMA(1, 0, At, B0); PG8_BAR; PG8_SCHED;
            PG8_STAGE(PG8_SB(0, 1), b2 + hstepB, voffB);
            PG8_WAIT_V(6); PG8_BAR; PG8_MMA(1, 1, At, B1); PG8_BAR;
            PG8_LDB(B0, 1, 0); PG8_SCHED; PG8_LDA(At, 1, 0); PG8_STAGE(PG8_SA(0, 1), a2 + hstepA, voffA);
            PG8_WAIT_L(8); PG8_BAR; PG8_WAIT_L(0); PG8_MMA(0, 0, At, B0); PG8_BAR; PG8_SCHED;
            PG8_LDB(B1, 1, 1); PG8_STAGE(PG8_SB(1, 0), b3, voffB);
            PG8_BAR; PG8_WAIT_L(0); PG8_MMA(0, 1, At, B1); PG8_BAR;
            PG8_LDA(At, 1, 1); PG8_STAGE(PG8_SA(1, 0), a3, voffA);
            PG8_BAR; PG8_WAIT_L(0); PG8_MMA(1, 0, At, B0); PG8_BAR; PG8_SCHED;
            PG8_STAGE(PG8_SB(1, 1), b3 + hstepB, voffB);
            PG8_WAIT_V(6); PG8_BAR; PG8_MMA(1, 1, At, B1); PG8_BAR;
        }
        { int fr_ = fr, fq_ = fq; asm volatile("" : "+v"(fr_), "+v"(fq_)); E(acc, cur, wr, wc, fr_, fq_); }
        if (!has_next) break;
#pragma unroll
        for (int a = 0; a < 2; ++a)
#pragma unroll
            for (int b = 0; b < 2; ++b)
#pragma unroll
                for (int m = 0; m < 4; ++m)
#pragma unroll
                    for (int n = 0; n < 2; ++n) acc[a][b][m][n] = (f32x4){0.f, 0.f, 0.f, 0.f};
        cur = nxt; cA = nA; cB = nB; ++ui;
    }
    PG8_WAIT_V(0);
    if (wr == 0) PG8_BAR;
    PG8_BAR;
#undef PG8_SA
#undef PG8_SB
#undef PG8_STAGE
#undef PG8_LDA
#undef PG8_LDB
#undef PG8_MMA
#undef PG8_WAIT_V
#undef PG8_WAIT_L
#undef PG8_BAR
#undef PG8_SCHED
}

typedef const f32x4 (&AccRef)[2][2][4][2];
#define EPI_PERM_LOOP(...) _Pragma("unroll") for (int ai = 0; ai < 2; ++ai) _Pragma("unroll") for (int m = 0; m < 4; ++m) { const int lr = ai * 128 + wr * 64 + m * 16 + fr; \
    _Pragma("unroll") for (int bj = 0; bj < 2; ++bj) { const int lc = bj * 128 + wc * 32 + 8 * fq; f32x4 v0 = acc[ai][bj][m][0], v1 = acc[ai][bj][m][1]; __VA_ARGS__ } }
#define EPI_PACK(w, v0, v1) u32x4 w; w.x = cvt_pk_bf16(v0[0], v0[1]); w.y = cvt_pk_bf16(v0[2], v0[3]); w.z = cvt_pk_bf16(v1[0], v1[1]); w.w = cvt_pk_bf16(v1[2], v1[3]);

struct EpiIn {
    static constexpr bool PERM = true;
    bf16_t* sg; bf16_t* us;
    DI void operator()(AccRef acc, const Unit& u, int wr, int wc, int fr, int fq) const {
        const int row0 = u.pm * BM;
        if (u.pn < 16) { bf16_t* base = sg + (size_t)row0 * 4096 + u.pn * BM;
            EPI_PERM_LOOP({ _Pragma("unroll") for (int j = 0; j < 4; ++j) { v0[j] = sigmoidf_(v0[j]); v1[j] = sigmoidf_(v1[j]); } u32x4 w; w.x = pk2(v0[0], v0[1]); w.y = pk2(v0[2], v0[3]); w.z = pk2(v1[0], v1[1]); w.w = pk2(v1[2], v1[3]); *(u32x4*)(base + (size_t)lr * 4096 + lc) = w; }) }
        else { bf16_t* base = us + (size_t)row0 * USW + (u.pn - 16) * BM;
            EPI_PERM_LOOP({ EPI_PACK(w, v0, v1); *(u32x4*)(base + (size_t)lr * USW + lc) = w; }) }
    }
};
struct EpiStore {
    static constexpr bool PERM = true;
    bf16_t* O; int ldc; const float* cscale; int mode;
    DI void operator()(AccRef acc, const Unit& u, int wr, int wc, int fr, int fq) const {
        size_t rb, cb;
        if (mode == 0) { rb = (size_t)u.pm * BM; cb = (size_t)u.pn * BM; }
        else if (mode == 1) { rb = (size_t)MC + u.pn * 1024 + u.pm * BM; cb = 512; }
        else { rb = (size_t)u.pm * BM; cb = 512; }
        bf16_t* base = O + rb * ldc + cb;
        if (cscale) { const float* cs = cscale + u.pn * BM;
            EPI_PERM_LOOP({ const f32x4 s0 = *(const f32x4*)(cs + lc), s1 = *(const f32x4*)(cs + lc + 4); v0 = v0 * s0; v1 = v1 * s1; EPI_PACK(w, v0, v1); *(u32x4*)(base + (size_t)lr * ldc + lc) = w; }) }
        else { EPI_PERM_LOOP({ EPI_PACK(w, v0, v1); *(u32x4*)(base + (size_t)lr * ldc + lc) = w; }) }
    }
};
struct EpiZt {
    static constexpr bool PERM = false;
    bf16_t* ztl; bf16_t* ztc;
    DI void operator()(AccRef acc, const Unit& u, int wr, int wc, int fr, int fq) const {
        const int row0 = u.pm * BM; bf16_t* base; int T, t0;
        if (row0 < MC) { T = 256; t0 = 0; base = ztc + (size_t)(row0 >> 8) * 256 * 512; } else { const int rr = row0 - MC; T = 1024; t0 = rr & 1023; base = ztl + (size_t)(rr >> 10) * 256 * 2048; }
        const int ldz = 2 * T;
#pragma unroll
        for (int ai = 0; ai < 2; ++ai)
#pragma unroll
            for (int m = 0; m < 4; ++m) { const int t = t0 + ai * 128 + wr * 64 + m * 16 + fr;
#pragma unroll
                for (int bj = 0; bj < 2; ++bj)
#pragma unroll
                    for (int n = 0; n < 2; ++n) { const int j = u.pn * BM + bj * 128 + wc * 32 + n * 16 + 4 * fq; const int g = j >> 7, hf = (j >> 6) & 1, cp = j & 63;
                        bf16_t* d = base + (size_t)(g * 64 + cp) * ldz + hf * T + t; const f32x4 v = acc[ai][bj][m][n];
                        d[0] = f2bf(v[0]); d[ldz] = f2bf(v[1]); d[2 * ldz] = f2bf(v[2]); d[3 * ldz] = f2bf(v[3]); } }
    }
};
struct EpiProj {
    static constexpr bool PERM = true;
    const bf16_t* sg; float* mp; bf16_t* mg;
    DI void operator()(AccRef acc, const Unit& u, int wr, int wc, int fr, int fq) const {
        const int n = u.z; const size_t row0 = (size_t)u.pm * BM; const int col0 = u.pn * BM;
        const bf16_t* sgb = sg + row0 * 4096 + n * 1024 + col0; float* mpb = mp + row0 * DM + col0; bf16_t* mgb = mg + row0 * DM + col0;
        EPI_PERM_LOOP({ const u32x4 gw = *(const u32x4*)(sgb + (size_t)lr * 4096 + lc);
            v0[0] *= bflo(gw.x); v0[1] *= bfhi(gw.x); v0[2] *= bflo(gw.y); v0[3] *= bfhi(gw.y); v1[0] *= bflo(gw.z); v1[1] *= bfhi(gw.z); v1[2] *= bflo(gw.w); v1[3] *= bfhi(gw.w);
            float* p = mpb + (size_t)lr * DM + lc;
            if (n > 0) { v0 = v0 + *(const f32x4*)p; v1 = v1 + *(const f32x4*)(p + 4); }
            if (n < 3) { *(f32x4*)p = v0; *(f32x4*)(p + 4) = v1; }
            else { EPI_PACK(w, v0, v1); *(u32x4*)(mgb + (size_t)lr * DM + lc) = w; } })
    }
};
struct EpiResid {
    static constexpr bool PERM = false;
    const float* xp; const float* xs; float* out; const float* gate;
    DI void operator()(AccRef acc, const Unit& u, int wr, int wc, int fr, int fq) const {
        const int row0 = u.pm * BM; const float* bs = xp ? (row0 < MC ? xp + (size_t)row0 * DM : xs + (size_t)(row0 - MC) * DM) : out + (size_t)row0 * DM;
        float* ob = out + (size_t)row0 * DM; const float* gp = gate + (size_t)cond_row(row0) * 6144;
#pragma unroll
        for (int bj = 0; bj < 2; ++bj)
#pragma unroll
            for (int n = 0; n < 2; ++n) { const int col = u.pn * BM + bj * 128 + wc * 32 + n * 16 + 4 * fq; const f32x4 gv = *(const f32x4*)(gp + col);
#pragma unroll
                for (int ai = 0; ai < 2; ++ai)
#pragma unroll
                    for (int m = 0; m < 4; ++m) { const size_t off = (size_t)(ai * 128 + wr * 64 + m * 16 + fr) * DM + col;
                        const f32x4 b = *(const f32x4*)(bs + off); *(f32x4*)(ob + off) = b + gv * acc[ai][bj][m][n]; } }
    }
};
}

struct Params {
    const float* in[31];
    float* out; unsigned char* ws;
    int lo, hi;
};
enum { I_XP = 0, I_XS, I_C, I_CCTX, I_CDK, I_CDV, I_CCKV, I_CKR, I_WADA, I_BADA, I_GN1, I_GN2, I_WIN, I_POOLW, I_POOLS, I_DQN, I_DKN, I_DLAM, I_DSUB,
       I_QAN, I_WUQ, I_KVN, I_WUKV, I_MQN, I_MKN, I_WBR, I_WOUT, I_WUP, I_CONVW, I_CONVB, I_WDOWN };

DI void tr_tile(LAS unsigned char* lds, const float* src, bf16_t* dst, int R, int C, int tile) {
    LAS float* T = (LAS float*)lds;
    const int ntk = R / 64, tk = tile % ntk, tn = tile / ntk, k0 = tk * 64, n0 = tn * 256; int tid = threadIdx.x; asm volatile("" : "+v"(tid));
    __syncthreads();
#pragma unroll
    for (int i = 0; i < 8; ++i) { const int k = (tid >> 6) + 8 * i, n = n0 + (tid & 63) * 4; f32x4 v = (f32x4){0.f, 0.f, 0.f, 0.f};
        if (n < C) v = *(const f32x4*)(src + (size_t)(k0 + k) * C + n);
        LAS float* t = T + k * 257 + (tid & 63) * 4; t[0] = v[0]; t[1] = v[1]; t[2] = v[2]; t[3] = v[3]; }
    __syncthreads();
#pragma unroll
    for (int j = 0; j < 4; ++j) { const int n = (tid >> 3) + 64 * j, kc = (tid & 7) * 8; u32x4 w;
        w.x = pk2(T[(kc + 0) * 257 + n], T[(kc + 1) * 257 + n]); w.y = pk2(T[(kc + 2) * 257 + n], T[(kc + 3) * 257 + n]);
        w.z = pk2(T[(kc + 4) * 257 + n], T[(kc + 5) * 257 + n]); w.w = pk2(T[(kc + 6) * 257 + n], T[(kc + 7) * 257 + n]);
        *(u32x4*)(dst + (size_t)(n0 + n) * R + k0 + kc) = w; }
}
DI void tr_job(LAS unsigned char* lds, const float* src, bf16_t* dst, int R, int C, int Cpad, int& base, int G, int c) {
    const int nt = (R / 64) * (Cpad / 256);
    for (int t = (c + G - (base % G)) % G; t < nt; t += G) tr_tile(lds, src, dst, R, C, t);
    base += nt;
}

DI void phase_prepass(const Params& p, LAS unsigned char* lds, int G, int c) {
    unsigned char* ws = p.ws; int tid = threadIdx.x; asm volatile("" : "+v"(tid));
    int base = 0;
    for (int l = 0; l < NLAY; ++l) {
        tr_job(lds, p.in[I_WIN] + (size_t)l * DM * INC, (bf16_t*)(ws + WS_WIN + l * SZ_WIN), DM, INC, INP, base, G, c);
        tr_job(lds, p.in[I_WUP] + (size_t)l * DM * F2, (bf16_t*)(ws + WS_WUP + l * SZ_WUP), DM, F2, F2, base, G, c);
        tr_job(lds, p.in[I_WDOWN] + (size_t)l * FH * DM, (bf16_t*)(ws + WS_WD + l * SZ_WD), FH, DM, DM, base, G, c);
        tr_job(lds, p.in[I_WOUT] + (size_t)l * DM * DM, (bf16_t*)(ws + WS_WO + l * SZ_WO), DM, DM, DM, base, G, c);
        for (int n = 0; n < 4; ++n)
            tr_job(lds, p.in[I_WBR] + ((size_t)l * 4 + n) * 256 * DM, (bf16_t*)(ws + WS_WB + l * SZ_WB) + (size_t)n * 1024 * 256, 256, DM, DM, base, G, c);
    }
    __syncthreads();
    {
        LAS float* sc = (LAS float*)lds;
        for (int i = tid; i < 9 * 1024; i += NTHR) { const int r = i >> 10, k = i & 1023; const float v = r == 0 ? p.in[I_CCTX][k] : p.in[I_C][(r - 1) * 1024 + k]; sc[i] = v * sigmoidf_(v); }
        __syncthreads();
        LAS float* red = (LAS float*)(lds + 9 * 1024 * 4);
        float* mod = (float*)(ws + WS_MOD);
        for (int it = c; it < 192; it += G) {
            const int l = it / 48, col = (it % 48) * 128 + (tid & 127), kq = tid >> 7;
            const float* w = p.in[I_WADA] + (size_t)l * DM * 6144 + col;
            float a[9];
#pragma unroll
            for (int r = 0; r < 9; ++r) a[r] = 0.f;
            for (int k = kq * 256; k < kq * 256 + 256; ++k) { const float wv = w[(size_t)k * 6144];
#pragma unroll
                for (int r = 0; r < 9; ++r) a[r] += sc[r * 1024 + k] * wv; }
            __syncthreads();
#pragma unroll
            for (int r = 0; r < 9; ++r) red[(kq * 9 + r) * 128 + (tid & 127)] = a[r];
            __syncthreads();
            for (int i = tid; i < 9 * 128; i += NTHR) { const int r = i >> 7, cc = i & 127, colo = (it % 48) * 128 + cc;
                mod[((size_t)l * 9 + r) * 6144 + colo] = red[(0 * 9 + r) * 128 + cc] + red[(1 * 9 + r) * 128 + cc] + red[(2 * 9 + r) * 128 + cc] + red[(3 * 9 + r) * 128 + cc] + p.in[I_BADA][l * 6144 + colo]; }
        }
        __syncthreads();
    }
    const size_t gt = (size_t)c * NTHR + tid, gs = (size_t)G * NTHR;
    for (size_t i = gt; i < (size_t)NLAY * 512 * 256; i += gs) {
        const int l = (int)(i >> 17), n = (int)(i >> 8) & 511, k = (int)i & 255;
        { const int h = n >> 7, d = n & 127; float v = 0.f; if (d < 96 && k < 192) v = p.in[I_WUQ][((size_t)l * 192 + k) * 384 + h * 96 + d] * p.in[I_QAN][l * 192 + k];
          ((bf16_t*)(ws + WS_WUQ))[i] = f2bf(v); }
        { float v = 0.f, vp = 0.f; if (k < 128) { vp = p.in[I_WUKV][((size_t)l * 128 + k) * 512 + n]; v = vp * p.in[I_KVN][l * 128 + k]; }
          ((bf16_t*)(ws + WS_WUKV))[i] = f2bf(v); ((bf16_t*)(ws + WS_WUKVP))[i] = f2bf(vp); }
    }
    for (size_t i = gt; i < (size_t)512 * 256; i += gs) {
        const int j = (int)(i >> 8), k = (int)i & 255, g = j >> 7, hf = (j >> 6) & 1, cp = j & 63, g2 = k >> 6, cc = k & 63; float v = 0.f;
        if (g == g2) { const int m = (cp * cc) & 63; const float a = (float)m * (1.0f / 32.0f); v = (hf ? -sinpif(a) : cospif(a)) * 0.125f; }
        ((bf16_t*)(ws + WS_BDFT))[i] = f2bf(v);
    }
    for (size_t i = gt; i < (size_t)NLAY * 256 * 256; i += gs) {
        const int l = (int)(i >> 16), e = (int)(i >> 8) & 255, k = (int)i & 255; float v = 0.f;
        if ((e >> 6) == (k >> 6)) v = p.in[I_POOLW][(((size_t)l * 4 + (e >> 6)) * 64 + (k & 63)) * 64 + (e & 63)];
        ((bf16_t*)(ws + WS_BDPOOL))[i] = f2bf(v);
    }
    for (size_t i = gt; i < (size_t)1024 * 2048; i += gs) {
        const int kt = (int)(i >> 11), t = (int)i & 2047, tt = t & 1023; const int m = (kt * tt) & 1023; const float a = (float)m * (1.0f / 512.0f);
        ((bf16_t*)(ws + WS_D1024))[i] = f2bf((t < 1024 ? cospif(a) : sinpif(a)) * (1.0f / 32.0f));
    }
    for (size_t i = gt; i < (size_t)256 * 512; i += gs) {
        const int kt = (int)(i >> 9), t = (int)i & 511, tt = t & 255; const int m = (kt * tt) & 255; const float a = (float)m * (1.0f / 128.0f);
        ((bf16_t*)(ws + WS_D256))[i] = f2bf((t < 256 ? cospif(a) : sinpif(a)) * (1.0f / 16.0f));
    }
    for (size_t i = gt; i < (size_t)NLAY * 8 * 4 * 512 * 64; i += gs) {
        const int d = (int)i & 63, key = (int)(i >> 6) & 511, h = (int)(i >> 15) & 3, b = (int)(i >> 17) & 7, l = (int)(i >> 20);
        ((bf16_t*)(ws + WS_KDC))[i] = f2bf(p.in[I_CDK][((((size_t)b * 4 + l) * 512 + key) * 4 + h) * 64 + d]);
    }
    for (size_t i = gt; i < (size_t)NLAY * 8 * 4 * 64 * 512; i += gs) {
        const int key = (int)i & 511, dv = (int)(i >> 9) & 63, h = (int)(i >> 15) & 3, b = (int)(i >> 17) & 7, l = (int)(i >> 20);
        ((bf16_t*)(ws + WS_VDTC))[i] = f2bf(p.in[I_CDV][((((size_t)b * 4 + l) * 512 + key) * 4 + h) * 64 + dv]);
    }
    for (size_t i = gt; i < (size_t)NLAY * 4096 * 256; i += gs) {
        const int k = (int)i & 255, key = (int)(i >> 8) & 511, b = (int)(i >> 17) & 7, l = (int)(i >> 20);
        ((bf16_t*)(ws + WS_R1 + R1_AC))[i] = k < 128 ? f2bf(p.in[I_CCKV][(((size_t)b * 4 + l) * 512 + key) * 128 + k]) : (bf16_t)0;
    }
}

DI void phase_norm(const Params& p, int l, int which, bool from_input, int G, int c) {
    int tid_ = threadIdx.x; asm volatile("" : "+v"(tid_)); const int lane = tid_ & 63, wid = tid_ >> 6;
    const float* gn = p.in[which ? I_GN2 : I_GN1] + l * DM; const float* mod = (const float*)(p.ws + WS_MOD) + (size_t)l * 9 * 6144 + which * 3072;
    bf16_t* h = (bf16_t*)(p.ws + WS_HM);
    for (int row = c * 8 + wid; row < MT; row += G * 8) {
        const float* x = from_input ? (row < MC ? p.in[I_XP] + (size_t)row * DM : p.in[I_XS] + (size_t)(row - MC) * DM) : p.out + (size_t)row * DM;
        f32x4 v[4]; float ss = 0.f;
#pragma unroll
        for (int i = 0; i < 4; ++i) { v[i] = *(const f32x4*)(x + i * 256 + lane * 4); ss += v[i][0] * v[i][0] + v[i][1] * v[i][1] + v[i][2] * v[i][2] + v[i][3] * v[i][3]; }
        ss = wave_sum(ss); const float rs = rsqrtf(ss * (1.0f / DM) + EPSV);
        const float* mr = mod + (size_t)cond_row(row) * 6144;
#pragma unroll
        for (int i = 0; i < 4; ++i) { const int col = i * 256 + lane * 4; const f32x4 g = *(const f32x4*)(gn + col), sh = *(const f32x4*)(mr + col), sc = *(const f32x4*)(mr + 1024 + col);
            f32x4 o = v[i] * rs * g * (sc + 1.0f) + sh; u32x2 w; w.x = pk2(o[0], o[1]); w.y = pk2(o[2], o[3]); *(u32x2*)(h + (size_t)row * DM + col) = w; }
    }
}

DI void phase_c1_rows(const Params& p, LAS unsigned char* lds, int l, int G, int c) {
    int tid = threadIdx.x; asm volatile("" : "+v"(tid)); unsigned char* ws = p.ws;
    const bf16_t* us = (const bf16_t*)(ws + WS_R1 + R1_US);
    bf16_t* Qd = (bf16_t*)(ws + WS_HM + HM_QD); bf16_t* Kds = (bf16_t*)(ws + WS_KDS); bf16_t* VdTs = (bf16_t*)(ws + WS_VDTS); bf16_t* pooled = (bf16_t*)(ws + WS_R2 + R2_POOLED);
    const float* qn = p.in[I_DQN] + l * 32; const float* kn = p.in[I_DKN] + l * 32;
    LAS bf16_t* VT = (LAS bf16_t*)lds;
    LAS bf16_t* PT = (LAS bf16_t*)(lds + 64 * 264 * 2);
    for (int it = G - 1 - c; it < MT / 64; it += G) {
        const int r0 = it * 64; const bool lat = r0 >= MC; const int T = lat ? 1024 : 256, t0 = lat ? ((r0 - MC) & 1023) : (r0 & 255), sb = r0 - t0;
        __syncthreads();
        for (int q = tid; q < 64 * 32; q += NTHR) { const int t = q >> 5, ch = q & 31; *(LAS u32x4*)(VT + t * 264 + ch * 8) = *(const u32x4*)(us + (size_t)(r0 + t) * USW + US_V + ch * 8); }
        for (int q = tid; q < 80 * 32; q += NTHR) { const int tr = q >> 5, ch = q & 31, t = t0 - 8 + tr; u32x4 v = (u32x4){0u, 0u, 0u, 0u};
            if (t >= 0 && t < T) v = *(const u32x4*)(us + (size_t)(sb + t) * USW + US_POOL + ch * 8); *(LAS u32x4*)(PT + tr * 264 + ch * 8) = v; }
#pragma unroll 1
        for (int j = 0; j < 2; ++j) {
            const int vid = tid + NTHR * j, tl = vid >> 4, w = vid & 15, row = r0 + tl, t = t0 + tl; const bool isk = w >= 8; const int h = (w & 7) >> 1, hf = w & 1;
            const bf16_t* src = us + (size_t)row * USW + US_Q + w * 32;
            float y[32]; float ss = 0.f;
#pragma unroll
            for (int q = 0; q < 4; ++q) { const u32x4 v = *(const u32x4*)(src + q * 8);
                y[q * 8 + 0] = bflo(v.x); y[q * 8 + 1] = bfhi(v.x); y[q * 8 + 2] = bflo(v.y); y[q * 8 + 3] = bfhi(v.y); y[q * 8 + 4] = bflo(v.z); y[q * 8 + 5] = bfhi(v.z); y[q * 8 + 6] = bflo(v.w); y[q * 8 + 7] = bfhi(v.w); }
#pragma unroll
            for (int d = 0; d < 32; ++d) ss += y[d] * y[d];
            const float rs = rsqrtf(ss * (1.0f / 32.0f) + EPSV); const float* gnp = isk ? kn : qn;
#pragma unroll
            for (int d = 0; d < 32; ++d) y[d] = y[d] * rs * gnp[d];
            if (isk && !lat) { float* o = p.out + O_DK + ((size_t)((r0 >> 8) * 4 + l) * 256 + t) * 256 + h * 64 + hf * 32;
#pragma unroll
                for (int q = 0; q < 8; ++q) *(f32x4*)(o + q * 4) = (f32x4){y[q * 4], y[q * 4 + 1], y[q * 4 + 2], y[q * 4 + 3]}; }
            if (lat) { const float prow = (float)(t >> 6), pcol = (float)(t & 63); ROPE32(y, 0, prow, pcol); }
            bf16_t* dst = isk ? Kds + (size_t)sb * 256 + ((size_t)h * T + t) * 64 + hf * 32 : Qd + (size_t)row * 256 + h * 64 + hf * 32;
#pragma unroll
            for (int q = 0; q < 4; ++q) { u32x4 wv; wv.x = pk2(y[q * 8], y[q * 8 + 1]); wv.y = pk2(y[q * 8 + 2], y[q * 8 + 3]); wv.z = pk2(y[q * 8 + 4], y[q * 8 + 5]); wv.w = pk2(y[q * 8 + 6], y[q * 8 + 7]); *(u32x4*)(dst + q * 8) = wv; }
        }
        __syncthreads();
        if (!lat) { float* o = p.out + O_DV + ((size_t)((r0 >> 8) * 4 + l) * 256 + t0) * 256;
            for (int q = tid; q < 64 * 256; q += NTHR) o[q] = bf2f(VT[(q >> 8) * 264 + (q & 255)]); }
        { const int cidx = tid & 255, th = tid >> 8; bf16_t* dst = VdTs + (size_t)sb * 256 + ((size_t)(cidx >> 6) * 64 + (cidx & 63)) * T + t0 + th * 32;
#pragma unroll
          for (int q = 0; q < 4; ++q) { u32x4 wv; const LAS bf16_t* s = VT + (th * 32 + q * 8) * 264 + cidx;
              wv.x = (unsigned)s[0] | ((unsigned)s[264] << 16); wv.y = (unsigned)s[2 * 264] | ((unsigned)s[3 * 264] << 16); wv.z = (unsigned)s[4 * 264] | ((unsigned)s[5 * 264] << 16); wv.w = (unsigned)s[6 * 264] | ((unsigned)s[7 * 264] << 16);
              *(u32x4*)(dst + q * 8) = wv; } }
        { const int cidx = tid & 255, th = tid >> 8, hw = 1 << (cidx >> 6);
          for (int q = 0; q < 32; ++q) { const int tl = th * 32 + q, t = t0 + tl; const int lo = max(t - hw, 0), hi = min(t + hw, T); float s = 0.f;
              for (int tt = lo; tt < hi; ++tt) s += bf2f(PT[(tt - t0 + 8) * 264 + cidx]);
              const float v = s / (float)(hi - lo) - bf2f(PT[(tl + 8) * 264 + cidx]); pooled[(size_t)(r0 + tl) * 256 + cidx] = f2bf(v); } }
    }
    __syncthreads();
}

DI float sumsq8(const u32x4 v) { const float a0 = bflo(v.x), a1 = bfhi(v.x), a2 = bflo(v.y), a3 = bfhi(v.y), a4 = bflo(v.z), a5 = bfhi(v.z), a6 = bflo(v.w), a7 = bfhi(v.w);
    return a0 * a0 + a1 * a1 + a2 * a2 + a3 * a3 + a4 * a4 + a5 * a5 + a6 * a6 + a7 * a7; }
DI u32x4 scale8(const u32x4 v, float sc, const float* g) { const f32x4 g0 = *(const f32x4*)g, g1 = *(const f32x4*)(g + 4); u32x4 w;
    w.x = pk2(bflo(v.x) * sc * g0[0], bfhi(v.x) * sc * g0[1]); w.y = pk2(bflo(v.y) * sc * g0[2], bfhi(v.y) * sc * g0[3]);
    w.z = pk2(bflo(v.z) * sc * g1[0], bfhi(v.z) * sc * g1[1]); w.w = pk2(bflo(v.w) * sc * g1[2], bfhi(v.w) * sc * g1[3]); return w; }
DI u32x4 scale8n(const u32x4 v, float sc) { u32x4 w; w.x = pk2(bflo(v.x) * sc, bfhi(v.x) * sc); w.y = pk2(bflo(v.y) * sc, bfhi(v.y) * sc); w.z = pk2(bflo(v.z) * sc, bfhi(v.z) * sc); w.w = pk2(bflo(v.w) * sc, bfhi(v.w) * sc); return w; }
#define UNPK8(y, o, v) do { y[(o) + 0] = bflo(v.x); y[(o) + 1] = bfhi(v.x); y[(o) + 2] = bflo(v.y); y[(o) + 3] = bfhi(v.y); y[(o) + 4] = bflo(v.z); y[(o) + 5] = bfhi(v.z); y[(o) + 6] = bflo(v.w); y[(o) + 7] = bfhi(v.w); } while (0)
template <bool CACHE>
DI void phase_mla_finish(const Params& p, LAS unsigned char* lds, int l, int G, int c) {
    int tid = threadIdx.x; asm volatile("" : "+v"(tid)); unsigned char* ws = p.ws;
    const bf16_t* us = (const bf16_t*)(ws + WS_R1 + R1_US);
    LAS bf16_t* VT = (LAS bf16_t*)lds;
    const int nitems = CACHE ? NLAY * 4096 / 64 : MT / 64;
    for (int it = CACHE ? c : G - 1 - c; it < nitems; it += G) {
        int r0, T, t0, sb, lay; bool lat;
        if (CACHE) { lay = it >> 6; r0 = (it & 63) * 64; lat = false; T = 512; t0 = r0 & 511; sb = r0 - t0; }
        else { lay = l; r0 = it * 64; lat = r0 >= MC; T = lat ? 1024 : 256; t0 = lat ? ((r0 - MC) & 1023) : (r0 & 255); sb = r0 - t0; }
        const int role = tid >> 8, tl = (tid & 255) >> 2, h = tid & 3, row = r0 + tl, t = t0 + tl;
        const float prow = (float)(t >> 6), pcol = (float)(t & 63);
        __syncthreads();
        if (role == 0 && !CACHE) {
            const bf16_t* cq = us + (size_t)row * USW + US_CQ + h * 48; float ss = 0.f;
#pragma unroll
            for (int q = 0; q < 6; ++q) ss += sumsq8(*(const u32x4*)(cq + q * 8));
            ss += __shfl_xor(ss, 1); ss += __shfl_xor(ss, 2);
            const float rq = rsqrtf(ss * (1.0f / 192.0f) + EPSV);
            const bf16_t* src = (const bf16_t*)(ws + WS_R2 + R2_QRAW) + (size_t)row * 512 + h * 128;
            float s2 = 0.f;
#pragma unroll
            for (int q = 0; q < 12; ++q) s2 += sumsq8(*(const u32x4*)(src + q * 8));
            s2 *= rq * rq;
            const float r2 = rsqrtf(s2 * (1.0f / 96.0f) + EPSV) * rq; const float* gq = p.in[I_MQN] + lay * 96;
            bf16_t* dst = (bf16_t*)(ws + WS_HM + HM_QM) + (size_t)row * 384 + h * 96;
#pragma unroll
            for (int q = 0; q < 8; ++q) *(u32x4*)(dst + q * 8) = scale8(*(const u32x4*)(src + q * 8), r2, gq + q * 8);
            float y[32];
#pragma unroll
            for (int q = 0; q < 4; ++q) { const u32x4 v = *(const u32x4*)(src + 64 + q * 8); UNPK8(y, q * 8, v); }
#pragma unroll
            for (int d = 0; d < 32; ++d) y[d] = y[d] * r2 * gq[64 + d];
            if (lat) ROPE32(y, 0, prow, pcol);
#pragma unroll
            for (int q = 0; q < 4; ++q) { u32x4 wv; wv.x = pk2(y[q * 8], y[q * 8 + 1]); wv.y = pk2(y[q * 8 + 2], y[q * 8 + 3]); wv.z = pk2(y[q * 8 + 4], y[q * 8 + 5]); wv.w = pk2(y[q * 8 + 6], y[q * 8 + 7]); *(u32x4*)(dst + 64 + q * 8) = wv; }
        }
        if (role == 1) {
            float rkv = 1.0f;
            const int b = r0 >> (CACHE ? 9 : 8);
            if (!CACHE) {
                const bf16_t* ck = us + (size_t)row * USW + US_CKV + h * 32; float ss = 0.f;
#pragma unroll
                for (int q = 0; q < 4; ++q) ss += sumsq8(*(const u32x4*)(ck + q * 8));
                ss += __shfl_xor(ss, 1); ss += __shfl_xor(ss, 2);
                rkv = rsqrtf(ss * (1.0f / 128.0f) + EPSV);
                if (!lat) { const float* gk = p.in[I_KVN] + lay * 128 + h * 32; float* o = p.out + O_CKV + ((size_t)(b * 4 + lay) * 256 + t) * 128 + h * 32;
#pragma unroll
                    for (int q = 0; q < 4; ++q) { const u32x4 v = *(const u32x4*)(ck + q * 8); const f32x4 g0 = *(const f32x4*)(gk + q * 8), g1 = *(const f32x4*)(gk + q * 8 + 4);
                        *(f32x4*)(o + q * 8) = (f32x4){bflo(v.x) * rkv * g0[0], bfhi(v.x) * rkv * g0[1], bflo(v.y) * rkv * g0[2], bfhi(v.y) * rkv * g0[3]};
                        *(f32x4*)(o + q * 8 + 4) = (f32x4){bflo(v.z) * rkv * g1[0], bfhi(v.z) * rkv * g1[1], bflo(v.w) * rkv * g1[2], bfhi(v.w) * rkv * g1[3]}; } }
            }
            float y[32];
            if (CACHE) { const float* krp = p.in[I_CKR] + ((size_t)(b * 4 + lay) * 512 + t) * 32;
#pragma unroll
                for (int q = 0; q < 8; ++q) { const f32x4 v = *(const f32x4*)(krp + q * 4); y[q * 4] = v[0]; y[q * 4 + 1] = v[1]; y[q * 4 + 2] = v[2]; y[q * 4 + 3] = v[3]; } }
            else { const bf16_t* krp = us + (size_t)row * USW + US_KR;
#pragma unroll
                for (int q = 0; q < 4; ++q) { const u32x4 v = *(const u32x4*)(krp + q * 8); UNPK8(y, q * 8, v); }
                if (!lat) { float* o = p.out + O_KR + ((size_t)(b * 4 + lay) * 256 + t) * 32 + h * 8; const u32x4 v = *(const u32x4*)(krp + h * 8);
                    *(f32x4*)o = (f32x4){bflo(v.x), bfhi(v.x), bflo(v.y), bfhi(v.y)}; *(f32x4*)(o + 4) = (f32x4){bflo(v.z), bfhi(v.z), bflo(v.w), bfhi(v.w)}; } }
            const bf16_t* src = CACHE ? (const bf16_t*)(ws + WS_R1 + R1_KVRC) + ((size_t)lay * 4096 + row) * 512 + h * 128 : (const bf16_t*)(ws + WS_R2 + R2_KVRAW) + (size_t)row * 512 + h * 128;
            float s2 = 0.f, s3 = 0.f;
#pragma unroll
            for (int q = 0; q < 8; ++q) s2 += sumsq8(*(const u32x4*)(src + q * 8));
#pragma unroll
            for (int d = 0; d < 32; ++d) s3 += y[d] * y[d];
            s2 = s2 * rkv * rkv + s3;
            const float r2 = rsqrtf(s2 * (1.0f / 96.0f) + EPSV); const float* gk2 = p.in[I_MKN] + lay * 96;
            bf16_t* dst = CACHE ? (bf16_t*)(ws + WS_KMC) + ((((size_t)lay * 8 + b) * 4 + h) * 512 + t) * 96 : (bf16_t*)(ws + WS_HM + HM_KMS) + (size_t)sb * 384 + ((size_t)h * T + t) * 96;
#pragma unroll
            for (int q = 0; q < 8; ++q) *(u32x4*)(dst + q * 8) = scale8(*(const u32x4*)(src + q * 8), r2 * rkv, gk2 + q * 8);
#pragma unroll
            for (int q = 0; q < 8; ++q) *(LAS u32x4*)(VT + tl * 264 + h * 64 + q * 8) = scale8n(*(const u32x4*)(src + 64 + q * 8), rkv);
#pragma unroll
            for (int d = 0; d < 32; ++d) y[d] = y[d] * r2 * gk2[64 + d];
            if (lat) ROPE32(y, 0, prow, pcol);
#pragma unroll
            for (int q = 0; q < 4; ++q) { u32x4 wv; wv.x = pk2(y[q * 8], y[q * 8 + 1]); wv.y = pk2(y[q * 8 + 2], y[q * 8 + 3]); wv.z = pk2(y[q * 8 + 4], y[q * 8 + 5]); wv.w = pk2(y[q * 8 + 6], y[q * 8 + 7]); *(u32x4*)(dst + 64 + q * 8) = wv; }
        }
        __syncthreads();
        { const int cidx = tid & 255, th = tid >> 8; const int b = r0 >> 9;
          bf16_t* dst = CACHE ? (bf16_t*)(ws + WS_VMTC) + ((((size_t)lay * 8 + b) * 4 + (cidx >> 6)) * 64 + (cidx & 63)) * 512 + t0 + th * 32
                              : (bf16_t*)(ws + WS_VMTS) + (size_t)sb * 256 + ((size_t)(cidx >> 6) * 64 + (cidx & 63)) * T + t0 + th * 32;
#pragma unroll
          for (int q = 0; q < 4; ++q) { u32x4 wv; const LAS bf16_t* s = VT + (th * 32 + q * 8) * 264 + cidx;
              wv.x = (unsigned)s[0] | ((unsigned)s[264] << 16); wv.y = (unsigned)s[2 * 264] | ((unsigned)s[3 * 264] << 16); wv.z = (unsigned)s[4 * 264] | ((unsigned)s[5 * 264] << 16); wv.w = (unsigned)s[6 * 264] | ((unsigned)s[7 * 264] << 16);
              *(u32x4*)(dst + q * 8) = wv; } }
    }
    __syncthreads();
}

template <bool DIFF>
DI void attn_item(LAS unsigned char* lds, const bf16_t* Qp, int qstride, const bf16_t* K0, const bf16_t* VT0, int n0, int vts0, const bf16_t* K1, const bf16_t* VT1, int n1, int vts1,
                  bf16_t* outp, float cscale, float lam, const float* subln, float oscale) {
    constexpr int KD = DIFF ? 64 : 96, KP = KD + 8, NP = KD / 32, CPK = KD / 8;
    LAS bf16_t* Kt = (LAS bf16_t*)lds; LAS bf16_t* Vt = (LAS bf16_t*)(lds + 64 * KP * 2);
    int tid = threadIdx.x; asm volatile("" : "+v"(tid)); const int lane = tid & 63, wid = tid >> 6, fr = lane & 15, g = lane >> 4;
    bf16x8 qf[NP];
#pragma unroll
    for (int pi = 0; pi < NP; ++pi) qf[pi] = *(const bf16x8*)(Qp + (size_t)(wid * 16 + fr) * qstride + pi * 32 + g * 8);
    f32x4 O1[4], O2[4];
#pragma unroll
    for (int i = 0; i < 4; ++i) { O1[i] = (f32x4){0.f, 0.f, 0.f, 0.f}; O2[i] = (f32x4){0.f, 0.f, 0.f, 0.f}; }
    float l1 = 0.f, l2 = 0.f;
    const int nt0 = n0 >> 6, ntt = nt0 + (n1 >> 6);
    u32x4 pk0, pk1 = (u32x4){0u, 0u, 0u, 0u}, pv;
#define ATT_PREFETCH(ti) do { const bool s_ = (ti) >= nt0; const bf16_t* Kb = s_ ? K1 + (size_t)((ti) - nt0) * 64 * KD : K0 + (size_t)(ti) * 64 * KD; \
        const bf16_t* Vb = s_ ? VT1 + ((ti) - nt0) * 64 : VT0 + (ti) * 64; const int vs = s_ ? vts1 : vts0; \
        pk0 = *(const u32x4*)(Kb + tid * 8); if (!DIFF && tid < 256) pk1 = *(const u32x4*)(Kb + (512 + tid) * 8); pv = *(const u32x4*)(Vb + (size_t)(tid >> 3) * vs + (tid & 7) * 8); } while (0)
    ATT_PREFETCH(0);
    for (int ti = 0; ti < ntt; ++ti) {
        __syncthreads();
        *(LAS u32x4*)(Kt + (tid / CPK) * KP + (tid % CPK) * 8) = pk0;
        if (!DIFF && tid < 256) { const int q = 512 + tid; *(LAS u32x4*)(Kt + (q / CPK) * KP + (q % CPK) * 8) = pk1; }
        *(LAS u32x4*)(Vt + (tid >> 3) * 72 + (tid & 7) * 8) = pv;
        __syncthreads();
        if (ti + 1 < ntt) ATT_PREFETCH(ti + 1);
        f32x4 s1[4], s2[4];
#pragma unroll
        for (int kb = 0; kb < 4; ++kb) {
            const LAS bf16_t* kr = Kt + (kb * 16 + fr) * KP + g * 8; const f32x4 z = (f32x4){0.f, 0.f, 0.f, 0.f};
            if (DIFF) { s1[kb] = __builtin_amdgcn_mfma_f32_16x16x32_bf16(*(const LAS bf16x8*)kr, qf[0], z, 0, 0, 0); s2[kb] = __builtin_amdgcn_mfma_f32_16x16x32_bf16(*(const LAS bf16x8*)(kr + 32), qf[NP > 1 ? 1 : 0], z, 0, 0, 0); }
            else { f32x4 a = __builtin_amdgcn_mfma_f32_16x16x32_bf16(*(const LAS bf16x8*)kr, qf[0], z, 0, 0, 0); a = __builtin_amdgcn_mfma_f32_16x16x32_bf16(*(const LAS bf16x8*)(kr + 32), qf[NP > 1 ? 1 : 0], a, 0, 0, 0);
                   s1[kb] = __builtin_amdgcn_mfma_f32_16x16x32_bf16(*(const LAS bf16x8*)(kr + 64), qf[NP > 2 ? 2 : 0], a, 0, 0, 0); s2[kb] = z; }
        }
#pragma unroll
        for (int kb = 0; kb < 4; ++kb)
#pragma unroll
            for (int r = 0; r < 4; ++r) { const float e1 = __builtin_amdgcn_exp2f(fminf(s1[kb][r] * cscale, 80.0f)); s1[kb][r] = e1; l1 += e1;
                if (DIFF) { const float e2 = __builtin_amdgcn_exp2f(fminf(s2[kb][r] * cscale, 80.0f)); s2[kb][r] = e2; l2 += e2; } }
        bf16x8 pb1[2], pb2[2];
#pragma unroll
        for (int pp = 0; pp < 2; ++pp) { u32x4 w; w.x = pk2(s1[2 * pp][0], s1[2 * pp][1]); w.y = pk2(s1[2 * pp][2], s1[2 * pp][3]); w.z = pk2(s1[2 * pp + 1][0], s1[2 * pp + 1][1]); w.w = pk2(s1[2 * pp + 1][2], s1[2 * pp + 1][3]);
            pb1[pp] = __builtin_bit_cast(bf16x8, w);
            if (DIFF) { u32x4 w2; w2.x = pk2(s2[2 * pp][0], s2[2 * pp][1]); w2.y = pk2(s2[2 * pp][2], s2[2 * pp][3]); w2.z = pk2(s2[2 * pp + 1][0], s2[2 * pp + 1][1]); w2.w = pk2(s2[2 * pp + 1][2], s2[2 * pp + 1][3]); pb2[pp] = __builtin_bit_cast(bf16x8, w2); } }
#pragma unroll
        for (int dvb = 0; dvb < 4; ++dvb)
#pragma unroll
            for (int pp = 0; pp < 2; ++pp) { const LAS bf16_t* vr = Vt + (dvb * 16 + fr) * 72 + pp * 32 + g * 4;
                const u32x2 lo = *(const LAS u32x2*)vr, hi = *(const LAS u32x2*)(vr + 16); const u32x4 vv = (u32x4){lo.x, lo.y, hi.x, hi.y}; const bf16x8 vf = __builtin_bit_cast(bf16x8, vv);
                O1[dvb] = __builtin_amdgcn_mfma_f32_16x16x32_bf16(vf, pb1[pp], O1[dvb], 0, 0, 0);
                if (DIFF) O2[dvb] = __builtin_amdgcn_mfma_f32_16x16x32_bf16(vf, pb2[pp], O2[dvb], 0, 0, 0); }
    }
#undef ATT_PREFETCH
    l1 += __shfl_xor(l1, 16); l1 += __shfl_xor(l1, 32);
    const float i1 = 1.0f / l1; float o[4][4];
    if (DIFF) { l2 += __shfl_xor(l2, 16); l2 += __shfl_xor(l2, 32); const float i2 = lam / l2; float ss = 0.f;
#pragma unroll
        for (int dvb = 0; dvb < 4; ++dvb)
#pragma unroll
            for (int r = 0; r < 4; ++r) { o[dvb][r] = O1[dvb][r] * i1 - O2[dvb][r] * i2; ss += o[dvb][r] * o[dvb][r]; }
        ss += __shfl_xor(ss, 16); ss += __shfl_xor(ss, 32);
        const float rn = rsqrtf(ss * (1.0f / 64.0f) + EPSV) * oscale;
#pragma unroll
        for (int dvb = 0; dvb < 4; ++dvb)
#pragma unroll
            for (int r = 0; r < 4; ++r) o[dvb][r] = o[dvb][r] * rn * subln[dvb * 16 + g * 4 + r];
    } else {
#pragma unroll
        for (int dvb = 0; dvb < 4; ++dvb)
#pragma unroll
            for (int r = 0; r < 4; ++r) o[dvb][r] = O1[dvb][r] * i1;
    }
    bf16_t* orow = outp + (size_t)(wid * 16 + fr) * DM + g * 4;
#pragma unroll
    for (int dvb = 0; dvb < 4; ++dvb) { u32x2 w; w.x = pk2(o[dvb][0], o[dvb][1]); w.y = pk2(o[dvb][2], o[dvb][3]); *(u32x2*)(orow + dvb * 16) = w; }
}

DI void phase_attn(const Params& p, LAS unsigned char* lds, int l, int G, int c) {
    unsigned char* ws = p.ws;
    const float* lq = p.in[I_DLAM] + l * 128; float d01 = 0.f, d23 = 0.f;
    for (int i = 0; i < 32; ++i) { d01 += lq[i] * lq[32 + i]; d23 += lq[64 + i] * lq[96 + i]; }
    const float lam_init = 0.8f - 0.6f * expf(-0.3f * (float)l), lam = expf(d01) - expf(d23) + lam_init;
    const bf16_t* Qd = (const bf16_t*)(ws + WS_HM + HM_QD); const bf16_t* Qm = (const bf16_t*)(ws + WS_HM + HM_QM);
    const bf16_t* Kds = (const bf16_t*)(ws + WS_KDS); const bf16_t* VdTs = (const bf16_t*)(ws + WS_VDTS); const bf16_t* Kms = (const bf16_t*)(ws + WS_HM + HM_KMS); const bf16_t* VmTs = (const bf16_t*)(ws + WS_VMTS);
    const bf16_t* Kdc = (const bf16_t*)(ws + WS_KDC); const bf16_t* VdTc = (const bf16_t*)(ws + WS_VDTC); const bf16_t* Kmc = (const bf16_t*)(ws + WS_KMC); const bf16_t* VmTc = (const bf16_t*)(ws + WS_VMTC);
    bf16_t* br = (bf16_t*)(ws + WS_R2 + R2_BR);
    const float cs_da = 0.17677669529663687f * 1.4426950408889634f, cs_ml = 0.10206207261596577f * 1.4426950408889634f;
    for (int L = c; L < 768; L += G) {
        bool mla, lat; int b, h, qb;
        if (L < 512) { lat = true; mla = L >= 256; const int i = L & 255; b = i >> 5; h = (i >> 3) & 3; qb = i & 7; }
        else { lat = false; const int i = L - 512; mla = i >= 128; const int j = i & 127; b = j >> 3; h = (j >> 1) & 3; qb = j & 1; }
        const int T = lat ? 1024 : 256, sb = lat ? MC + b * 1024 : b * 256, row0 = sb + qb * 128, n0 = lat ? 512 : 0;
        const size_t cidx = ((size_t)(l * 8 + b) * 4 + h);
        if (!mla) attn_item<true>(lds, Qd + (size_t)row0 * 256 + h * 64, 256, Kdc + cidx * 512 * 64, VdTc + cidx * 64 * 512, n0, 512, Kds + (size_t)sb * 256 + (size_t)h * T * 64, VdTs + (size_t)sb * 256 + (size_t)h * 64 * T, T, T,
                                  br + (size_t)row0 * DM + 256 + h * 64, cs_da, lam, p.in[I_DSUB] + l * 64, 1.0f - lam_init);
        else attn_item<false>(lds, Qm + (size_t)row0 * 384 + h * 96, 384, Kmc + cidx * 512 * 96, VmTc + cidx * 64 * 512, n0, 512, Kms + (size_t)sb * 384 + (size_t)h * T * 96, VmTs + (size_t)sb * 256 + (size_t)h * 64 * T, T, T,
                              br + (size_t)row0 * DM + 768 + h * 64, cs_ml, 0.f, nullptr, 1.0f);
    }
    __syncthreads();
}

DI void phase_convact(const Params& p, int l, int G, int c) {
    const bf16_t* u2 = (const bf16_t*)(p.ws + WS_R1); bf16_t* act = (bf16_t*)(p.ws + WS_R2);
    const float* cw = p.in[I_CONVW] + (size_t)l * 3 * F2; const float* cbp = p.in[I_CONVB] + (size_t)l * F2;
    int tidc = threadIdx.x; asm volatile("" : "+v"(tidc));
    for (size_t idx = (size_t)c * NTHR + tidc; idx < (size_t)(MT / 32) * 352; idx += (size_t)G * NTHR) {
        const int ch = (int)(idx % 352), seg = (int)(idx / 352), f = ch * 8, r0 = seg * 32;
        const bool lat = r0 >= MC; const int T = lat ? 1024 : 256, t0 = lat ? ((r0 - MC) & 1023) : (r0 & 255);
        float wg[3][8], wv[3][8], bg[8], bv[8];
#pragma unroll
        for (int j = 0; j < 3; ++j)
#pragma unroll
            for (int q = 0; q < 2; ++q) { const f32x4 a = *(const f32x4*)(cw + j * F2 + f + q * 4), b = *(const f32x4*)(cw + j * F2 + FH + f + q * 4);
#pragma unroll
                for (int e = 0; e < 4; ++e) { wg[j][q * 4 + e] = a[e]; wv[j][q * 4 + e] = b[e]; } }
#pragma unroll
        for (int q = 0; q < 2; ++q) { const f32x4 a = *(const f32x4*)(cbp + f + q * 4), b = *(const f32x4*)(cbp + FH + f + q * 4);
#pragma unroll
            for (int e = 0; e < 4; ++e) { bg[q * 4 + e] = a[e]; bv[q * 4 + e] = b[e]; } }
        const u32x4 zz = (u32x4){0u, 0u, 0u, 0u};
        u32x4 pg = t0 > 0 ? *(const u32x4*)(u2 + (size_t)(r0 - 1) * F2 + f) : zz, pvv = t0 > 0 ? *(const u32x4*)(u2 + (size_t)(r0 - 1) * F2 + FH + f) : zz;
        u32x4 cg_ = *(const u32x4*)(u2 + (size_t)r0 * F2 + f), cv_ = *(const u32x4*)(u2 + (size_t)r0 * F2 + FH + f);
#pragma unroll 1
        for (int i = 0; i < 32; ++i) {
            const bool hn = (t0 + i + 1) < T;
            const u32x4 ng = hn ? *(const u32x4*)(u2 + (size_t)(r0 + i + 1) * F2 + f) : zz, nv = hn ? *(const u32x4*)(u2 + (size_t)(r0 + i + 1) * F2 + FH + f) : zz;
            float o[8];
#define CA_ONE(e, PW, CW, NW, PV, CV, NV, HI) { const float gp = HI ? bfhi(PW) : bflo(PW), gc = HI ? bfhi(CW) : bflo(CW), gn = HI ? bfhi(NW) : bflo(NW); \
                const float vp = HI ? bfhi(PV) : bflo(PV), vc = HI ? bfhi(CV) : bflo(CV), vn = HI ? bfhi(NV) : bflo(NV); \
                const float Gv = wg[0][e] * gp + wg[1][e] * gc + wg[2][e] * gn + bg[e], Vv = wv[0][e] * vp + wv[1][e] * vc + wv[2][e] * vn + bv[e]; o[e] = Gv * sigmoidf_(Gv) * Vv; }
            CA_ONE(0, pg.x, cg_.x, ng.x, pvv.x, cv_.x, nv.x, 0) CA_ONE(1, pg.x, cg_.x, ng.x, pvv.x, cv_.x, nv.x, 1)
            CA_ONE(2, pg.y, cg_.y, ng.y, pvv.y, cv_.y, nv.y, 0) CA_ONE(3, pg.y, cg_.y, ng.y, pvv.y, cv_.y, nv.y, 1)
            CA_ONE(4, pg.z, cg_.z, ng.z, pvv.z, cv_.z, nv.z, 0) CA_ONE(5, pg.z, cg_.z, ng.z, pvv.z, cv_.z, nv.z, 1)
            CA_ONE(6, pg.w, cg_.w, ng.w, pvv.w, cv_.w, nv.w, 0) CA_ONE(7, pg.w, cg_.w, ng.w, pvv.w, cv_.w, nv.w, 1)
#undef CA_ONE
            u32x4 w; w.x = pk2(o[0], o[1]); w.y = pk2(o[2], o[3]); w.z = pk2(o[4], o[5]); w.w = pk2(o[6], o[7]);
            *(u32x4*)(act + (size_t)(r0 + i) * FH + f) = w;
            pg = cg_; pvv = cv_; cg_ = ng; cv_ = nv;
        }
    }
}

#ifndef PHMASK
#define PHMASK 0xFFFF
#endif
#define PHM(k) ((PHMASK >> (k)) & 1)
__global__ void __launch_bounds__(NTHR) mega(Params p) {
    extern __shared__ __attribute__((aligned(16))) unsigned char lds_raw[];
    LAS unsigned char* lds = (LAS unsigned char*)lds_raw;
    cg::grid_group grid = cg::this_grid();
    const int G = gridDim.x, c = blockIdx.x;
    unsigned char* ws = p.ws;
    bf16_t* hm = (bf16_t*)(ws + WS_HM); bf16_t* sg = (bf16_t*)(ws + WS_R1 + R1_SG); bf16_t* us = (bf16_t*)(ws + WS_R1 + R1_US);
    bf16_t* br = (bf16_t*)(ws + WS_R2 + R2_BR); float* mod = (float*)(ws + WS_MOD);
    for (int ph = p.lo; ph < p.hi; ++ph) {
        if (ph == 0) { if (PHM(12)) phase_prepass(p, lds, G, c); }
        else if (ph == 1 && PHM(11)) {
            pg8::Gemm g{256, 256, 256}; pg8::SchedPlain S; S.set(ws + WS_R1 + R1_AC, ws + WS_WUKVP, 256, 256, 64, 2, G, c, -1, 4, SZ_SM);
            pg8::EpiStore E{(bf16_t*)(ws + WS_R1 + R1_KVRC), 512, nullptr, 0}; pg8::gemm_phase(lds, g, S, E);
        } else {
            const int l = (ph - 2) / 11, s = (ph - 2) % 11;
            if (s == 0 && PHM(0)) { if (l == 0) phase_mla_finish<true>(p, lds, 0, G, c); phase_norm(p, l, 0, l == 0, G, c); }
            else if (s == 1 && PHM(1)) { pg8::Gemm g{DM, DM, DM}; pg8::SchedPlain S; S.set(hm, ws + WS_WIN + l * SZ_WIN, DM, DM, MT / 256, INP / 256, G, c); pg8::EpiIn E{sg, us}; pg8::gemm_phase(lds, g, S, E); }
            else if (s == 2 && PHM(2)) {
                { pg8::Gemm g{USW, 256, 256}; pg8::SchedPlain S; S.set(us + US_FT, ws + WS_BDFT, USW, 256, MT / 256, 2, G, c); pg8::EpiZt E{(bf16_t*)(ws + WS_R2 + R2_ZTL), (bf16_t*)(ws + WS_R2 + R2_ZTC)}; pg8::gemm_phase(lds, g, S, E); }
                __syncthreads();
                { pg8::Gemm g{USW, 256, 256}; pg8::SchedPlain S; S.set(us + US_CQ, ws + WS_WUQ + l * SZ_SM, USW, 256, MT / 256, 2, G, (c + G - 96 % G) % G); pg8::EpiStore E{(bf16_t*)(ws + WS_R2 + R2_QRAW), 512, nullptr, 0}; pg8::gemm_phase(lds, g, S, E); }
                __syncthreads();
                { pg8::Gemm g{USW, 256, 256}; pg8::SchedPlain S; S.set(us + US_CKV, ws + WS_WUKV + l * SZ_SM, USW, 256, MT / 256, 2, G, (c + G - 192 % G) % G); pg8::EpiStore E{(bf16_t*)(ws + WS_R2 + R2_KVRAW), 512, nullptr, 0}; pg8::gemm_phase(lds, g, S, E); }
                __syncthreads();
                phase_c1_rows(p, lds, l, G, c);
            } else if (s == 3 && PHM(3)) {
                { pg8::Gemm g{256, 256, 256}; pg8::SchedPlain S; S.set(ws + WS_R2 + R2_POOLED, ws + WS_BDPOOL + l * SZ_BDPOOL, 256, 256, MT / 256, 1, G, c); pg8::EpiStore E{br, DM, p.in[I_POOLS] + l * 256, 0}; pg8::gemm_phase(lds, g, S, E); }
                __syncthreads();
                { pg8::Gemm g{2048, 2048, 2048}; pg8::SchedPlain S; S.set(ws + WS_D1024, ws + WS_R2 + R2_ZTL, 2048, 2048, 4, 8, G, (c + G - 48 % G) % G); pg8::EpiStore E{br, DM, nullptr, 1}; pg8::gemm_phase(lds, g, S, E); }
                __syncthreads();
                { pg8::Gemm g{512, 512, 512}; pg8::SchedPlain S; S.set(ws + WS_D256, ws + WS_R2 + R2_ZTC, 512, 512, 16, 1, G, (c + G - 80 % G) % G, 0, 0, (size_t)256 * 512 * 2); pg8::EpiStore E{br, DM, nullptr, 2}; pg8::gemm_phase(lds, g, S, E); }
                __syncthreads();
                phase_mla_finish<false>(p, lds, l, G, c);
            } else if (s == 4 && PHM(4)) phase_attn(p, lds, l, G, c);
            else if (s == 5 && PHM(5)) { pg8::Gemm g{DM, 256, 256}; pg8::SchedProj S; S.init(MT / 256, 4, G, c); S.A = (const char*)br; S.B = (const char*)(ws + WS_WB + l * SZ_WB);
                pg8::EpiProj E{sg, (float*)(ws + WS_R2 + R2_MP), hm}; pg8::gemm_phase(lds, g, S, E); }
            else if (s == 6 && PHM(6)) { pg8::Gemm g{DM, DM, DM}; pg8::SchedPlain S; S.set(hm, ws + WS_WO + l * SZ_WO, DM, DM, MT / 256, 4, G, c);
                pg8::EpiResid E{l == 0 ? p.in[I_XP] : nullptr, p.in[I_XS], p.out, mod + (size_t)l * 9 * 6144 + 2 * 1024}; pg8::gemm_phase(lds, g, S, E); }
            else if (s == 7 && PHM(7)) phase_norm(p, l, 1, false, G, c);
            else if (s == 8 && PHM(8)) { pg8::Gemm g{DM, DM, DM}; pg8::SchedPlain S; S.set(hm, ws + WS_WUP + l * SZ_WUP, DM, DM, MT / 256, F2 / 256, G, c); pg8::EpiStore E{(bf16_t*)(ws + WS_R1), F2, nullptr, 0}; pg8::gemm_phase(lds, g, S, E); }
            else if (s == 9 && PHM(9)) phase_convact(p, l, G, c);
            else if (PHM(10)) { pg8::Gemm g{FH, FH, FH}; pg8::SchedPlain S; S.set(ws + WS_R2, ws + WS_WD + l * SZ_WD, FH, FH, MT / 256, 4, G, c);
                pg8::EpiResid E{nullptr, nullptr, p.out, mod + (size_t)l * 9 * 6144 + 5 * 1024}; pg8::gemm_phase(lds, g, S, E); }
        }
        if (ph + 1 < p.hi) { __threadfence(); grid.sync(); __threadfence(); asm volatile("s_waitcnt vmcnt(0) lgkmcnt(0)" ::: "memory"); __syncthreads(); }
    }
}

constexpr int N_PHASES = 2 + NLAY * 11;

extern "C" void kernel_launch(void* const* d_in, const int* in_sizes, int n_in, void* d_out, int out_size, void* d_ws, size_t ws_size, hipStream_t stream) {
    static int grid = 0;
    if (grid == 0) {
        if (n_in != 31 || ws_size < WS_END) { fprintf(stderr, "kernel_launch: need 31 inputs and %zu bytes of workspace; got %d, %zu\n", (size_t)WS_END, n_in, ws_size); grid = -1; return; }
        int dev = 0, cus = 0, per_cu = 0;
        (void)hipGetDevice(&dev); (void)hipDeviceGetAttribute(&cus, hipDeviceAttributeMultiprocessorCount, dev);
        if (hipFuncSetAttribute((const void*)mega, hipFuncAttributeMaxDynamicSharedMemorySize, LDS_BYTES) != hipSuccess) { fprintf(stderr, "kernel_launch: hipFuncSetAttribute failed\n"); grid = -1; return; }
        if (hipOccupancyMaxActiveBlocksPerMultiprocessor(&per_cu, (const void*)mega, NTHR, LDS_BYTES) != hipSuccess || per_cu < 1) { fprintf(stderr, "kernel_launch: occupancy query failed (%d)\n", per_cu); grid = -1; return; }
        grid = cus * per_cu;
    }
    if (grid < 0) return;
    Params p{};
    for (int i = 0; i < 31; ++i) p.in[i] = (const float*)d_in[i];
    p.out = (float*)d_out; p.ws = (unsigned char*)d_ws; p.lo = 0; p.hi = N_PHASES;
    void* args[] = {&p};
    hipError_t e = hipLaunchCooperativeKernel((const void*)mega, dim3(grid), dim3(NTHR), args, LDS_BYTES, stream);
    if (e != hipSuccess) fprintf(stderr, "cooperative launch failed: %s (grid %d)\n", hipGetErrorString(e), grid);
}
```

```cpp
#include <hip/hip_runtime.h>
#include <hip/hip_cooperative_groups.h>
#include <cstdio>
namespace cg = cooperative_groups;

#define DI __device__ __forceinline__
#define LAS __attribute__((address_space(3)))
typedef unsigned short bf16_t;
typedef short bf16x8 __attribute__((ext_vector_type(8)));
typedef short s16x4 __attribute__((ext_vector_type(4)));
typedef float f32x4 __attribute__((ext_vector_type(4)));
typedef unsigned u32x4 __attribute__((ext_vector_type(4)));
typedef unsigned u32x2 __attribute__((ext_vector_type(2)));

constexpr int DM = 1024, MC = 4096, ML = 8192, MT = 12288, NLAY = 4;
constexpr int INC = 5728, INP = 5888, USW = 1792, F2 = 5632, FH = 2816;
constexpr float EPSV = 1e-6f;
constexpr int NTHR = 512;
constexpr int LDS_BYTES = 131072 + 256;
constexpr int US_POOL = 0, US_Q = 256, US_K = 512, US_V = 768, US_FT = 1024, US_CQ = 1280, US_CKV = 1472, US_KR = 1600;

constexpr size_t al256(size_t x) { return (x + 255) & ~(size_t)255; }
constexpr size_t WS_WIN = 32768;
constexpr size_t SZ_WIN = (size_t)INP * DM * 2;
constexpr size_t WS_WB = WS_WIN + NLAY * SZ_WIN;
constexpr size_t SZ_WB = (size_t)4096 * 256 * 2;
constexpr size_t WS_WO = WS_WB + NLAY * SZ_WB;
constexpr size_t SZ_WO = (size_t)DM * DM * 2;
constexpr size_t WS_WUP = WS_WO + NLAY * SZ_WO;
constexpr size_t SZ_WUP = (size_t)F2 * DM * 2;
constexpr size_t WS_WD = WS_WUP + NLAY * SZ_WUP;
constexpr size_t SZ_WD = (size_t)DM * FH * 2;
constexpr size_t WS_WUQ = WS_WD + NLAY * SZ_WD;
constexpr size_t SZ_SM = (size_t)512 * 256 * 2;
constexpr size_t WS_WUKV = WS_WUQ + NLAY * SZ_SM;
constexpr size_t WS_WUKVP = WS_WUKV + NLAY * SZ_SM;
constexpr size_t WS_BDFT = WS_WUKVP + NLAY * SZ_SM;
constexpr size_t WS_BDPOOL = WS_BDFT + SZ_SM;
constexpr size_t SZ_BDPOOL = (size_t)256 * 256 * 2;
constexpr size_t WS_D1024 = WS_BDPOOL + NLAY * SZ_BDPOOL;
constexpr size_t WS_D256 = WS_D1024 + (size_t)1024 * 2048 * 2;
constexpr size_t WS_MOD = WS_D256 + (size_t)256 * 512 * 2;
constexpr size_t WS_HM = al256(WS_MOD + (size_t)NLAY * 9 * 6144 * 4);
constexpr size_t SZ_HM = (size_t)MT * DM * 2;
constexpr size_t HM_QM = 0, HM_KMS = (size_t)MT * 384 * 2, HM_QD = 2 * (size_t)MT * 384 * 2;
constexpr size_t WS_R1 = WS_HM + SZ_HM;
constexpr size_t R1_SG = 0, R1_US = (size_t)MT * 4096 * 2;
constexpr size_t SZ_R1 = R1_US + (size_t)MT * USW * 2;
constexpr size_t R1_AC = 0, R1_KVRC = (size_t)NLAY * 4096 * 256 * 2;
constexpr size_t WS_R2 = WS_R1 + SZ_R1;
constexpr size_t R2_BR = 0, R2_MP = (size_t)MT * DM * 2;
constexpr size_t R2_QRAW = R2_MP, R2_KVRAW = R2_QRAW + (size_t)MT * 512 * 2, R2_ZTL = R2_KVRAW + (size_t)MT * 512 * 2,
                 R2_ZTC = R2_ZTL + (size_t)2048 * 2048 * 2, R2_POOLED = R2_ZTC + (size_t)16 * 256 * 512 * 2;
constexpr size_t SZ_R2 = R2_MP + (size_t)MT * DM * 4;
constexpr size_t WS_KDS = WS_R2 + SZ_R2;
constexpr size_t SZ_S64 = (size_t)MT * 256 * 2;
constexpr size_t WS_VDTS = WS_KDS + SZ_S64;
constexpr size_t WS_VMTS = WS_VDTS + SZ_S64;
constexpr size_t WS_KDC = WS_VMTS + SZ_S64;
constexpr size_t SZ_C64 = (size_t)NLAY * 8 * 4 * 512 * 64 * 2;
constexpr size_t WS_VDTC = WS_KDC + SZ_C64;
constexpr size_t WS_KMC = WS_VDTC + SZ_C64;
constexpr size_t WS_VMTC = WS_KMC + (size_t)NLAY * 8 * 4 * 512 * 96 * 2;
constexpr size_t WS_END = WS_VMTC + SZ_C64;
static_assert(R2_POOLED + (size_t)MT * 256 * 2 <= SZ_R2, "r2 overlay");
static_assert((size_t)MT * F2 * 2 <= SZ_R1, "u2 fits r1");
static_assert((size_t)MT * FH * 2 <= SZ_R2, "act fits r2");
static_assert(HM_QD + (size_t)MT * 256 * 2 <= SZ_HM, "hm overlay");

constexpr size_t O_X = 0, O_DK = 12582912, O_DV = 16777216, O_CKV = 20971520, O_KR = 23068672;

DI bf16_t f2bf(float f) { const __bf16 r = (__bf16)f; return __builtin_bit_cast(bf16_t, r); }
DI float bf2f(bf16_t b) { return __uint_as_float(((unsigned)b) << 16); }
DI float bflo(unsigned w) { return __uint_as_float(w << 16); }
DI float bfhi(unsigned w) { return __uint_as_float(w & 0xffff0000u); }
typedef float f32x2_ __attribute__((ext_vector_type(2)));
typedef __bf16 bf16x2_ __attribute__((ext_vector_type(2)));
DI unsigned pk2(float lo, float hi) { const f32x2_ v = {lo, hi}; const bf16x2_ r = __builtin_convertvector(v, bf16x2_); return __builtin_bit_cast(unsigned, r); }
DI unsigned cvt_pk_bf16(float lo, float hi) { return pk2(lo, hi); }
DI float wave_sum(float v) { for (int o = 32; o >= 1; o >>= 1) v += __shfl_xor(v, o); return v; }
DI int cond_row(int row) { return row < MC ? 0 : 1 + ((row - MC) >> 10); }
DI float sigmoidf_(float x) { return __builtin_amdgcn_rcpf(1.0f + __expf(-x)); }
DI void sincos_rev(float ang, float& s, float& c) { float f = ang * 0.15915494309189535f; f -= rintf(f); s = __builtin_amdgcn_sinf(f); c = __builtin_amdgcn_cosf(f); }
__device__ const float ROPE_INV[8] = {1.0f, 0.31622776601683794f, 0.1f, 0.031622776601683794f, 0.01f, 0.0031622776601683794f, 0.001f, 0.00031622776601683794f};
#define ROPE32(y, base, prow, pcol) do { _Pragma("unroll") for (int _i = 0; _i < 8; ++_i) { float _s, _c; \
    sincos_rev((prow) * ROPE_INV[_i], _s, _c); { const float _a = y[(base) + _i], _b = y[(base) + 8 + _i]; y[(base) + _i] = _a * _c - _b * _s; y[(base) + 8 + _i] = _a * _s + _b * _c; } \
    sincos_rev((pcol) * ROPE_INV[_i], _s, _c); { const float _a = y[(base) + 16 + _i], _b = y[(base) + 24 + _i]; y[(base) + 16 + _i] = _a * _c - _b * _s; y[(base) + 24 + _i] = _a * _s + _b * _c; } } } while (0)

namespace pg8 {
constexpr int BM = 256, BK = 64, HALF = 128, HTB = HALF * BK * 2, STAGE_BYTES = 8 * HTB, NXCD = 8, WGM = 4;
DI int lds_byte(int r, int c) { const int st = (r >> 4) * 2 + (c >> 5), rr = r & 15, cc = c & 31, ob = rr * 64 + cc * 2; return st * 1024 + (ob ^ (((ob >> 9) & 1) << 5)); }
DI void stage_rc(int b, int& R, int& C) { const int st = b / 1024, sb = b % 1024, swz = sb ^ (((sb >> 9) & 1) << 5); R = (st >> 1) * 16 + swz / 64; C = (st & 1) * 32 + (swz % 64) / 2; }
DI int perm32(int rho) { const int n = rho >> 4, i = rho & 15; return 8 * (i >> 2) + 4 * n + (i & 3); }
struct Unit { const char* a; const char* b; int pm, pn, z; };
struct Gemm { int lda, ldb, K; };
struct TileOrder {
    int nM, nN, nwg, G, c;
    DI void init(int nM_, int nN_, int G_, int c_) { nM = nM_; nN = nN_; nwg = nM * nN; G = G_; c = c_; }
    DI bool tile(int i, int& pm, int& pn) const {
        const long L = (long)i * G + c; if (L >= nwg) return false;
        int wgid = (int)L; { const int q = nwg / NXCD, r = nwg % NXCD, xcd = wgid % NXCD, off = wgid / NXCD; wgid = (xcd < r ? xcd * (q + 1) : r * (q + 1) + (xcd - r) * q) + off; }
        const int nig = WGM * nN, gid = wgid / nig, fm = gid * WGM, gsz = (nM - fm) < WGM ? (nM - fm) : WGM;
        pm = fm + ((wgid % nig) % gsz); pn = (wgid % nig) / gsz; return true;
    }
};
struct SchedPlain : TileOrder {
    const char* A; const char* B; size_t tA, tB, zB; int amask, zshift;
    DI void set(const void* A_, const void* B_, int lda, int ldb, int nM_, int nN_, int G_, int c_, int amask_ = -1, int zshift_ = 31, size_t zB_ = 0) {
        A = (const char*)A_; B = (const char*)B_; tA = (size_t)BM * lda * 2; tB = (size_t)BM * ldb * 2; amask = amask_; zshift = zshift_; zB = zB_; init(nM_, nN_, G_, c_); }
    DI bool next(int i, Unit& u) const { if (!tile(i, u.pm, u.pn)) return false; u.z = u.pm >> zshift;
        u.a = A + (size_t)(u.pm & amask) * tA; u.b = B + (size_t)u.z * zB + (size_t)u.pn * tB; return true; }
};
struct SchedGate : TileOrder {
    const char* A; const char* B;
    DI bool next(int i, Unit& u) const { if (!tile(i, u.pm, u.pn)) return false; u.z = u.pn >> 2;
        u.a = A + (size_t)u.pm * (BM * 1024 * 2) + u.z * 512; u.b = B + (size_t)u.pn * 256 * 512; return true; }
};
struct SchedProj : TileOrder {
    const char* A; const char* B;
    DI bool next(int i, Unit& u) const { if (!tile(i >> 2, u.pm, u.pn)) return false; const int n = i & 3; u.z = n;
        u.a = A + (size_t)u.pm * (BM * 1024 * 2) + n * 512; u.b = B + ((size_t)n * 1024 + u.pn * 256) * 512; return true; }
};

template <class Epi, class Sched>
DI void gemm_phase(LAS unsigned char* lds, const Gemm g, const Sched& S, const Epi& E) {
    int tid = threadIdx.x; asm volatile("" : "+v"(tid));
    const int wid = __builtin_amdgcn_readfirstlane(tid >> 6), lane = tid & 63, wr = wid >> 2, wc = wid & 3, fr = lane & 15, fq = lane >> 4;
    int K = g.K; asm volatile("" : "+s"(K)); const int nt = K / BK;
    unsigned voffA[2], voffB[2];
#pragma unroll
    for (int i = 0; i < 2; ++i) { int R, C; stage_rc(tid * 16 + i * 8192, R, C); const int Rb = Epi::PERM ? ((R & ~31) + perm32(R & 31)) : R;
        voffA[i] = (unsigned)(R * g.lda + C) * 2u; voffB[i] = (unsigned)(Rb * g.ldb + C) * 2u; }
    const size_t kstep = (size_t)(BK * 2);
    const size_t hstepA = (size_t)HALF * g.lda * 2, hstepB = (size_t)HALF * g.ldb * 2;
    const unsigned ldsw = (unsigned)wid * 1024u;
    const int aoff = lds_byte(wr * 64 + fr, fq * 8), boff = lds_byte(wc * 32 + fr, fq * 8);
#define PG8_SA(b, h) (((b) * 2 + (h)) * HTB)
#define PG8_SB(b, h) ((4 + (b) * 2 + (h)) * HTB)
#define PG8_STAGE(bufoff, gbase, voff) do { _Pragma("unroll") for (int _i = 0; _i < 2; ++_i) \
        __builtin_amdgcn_global_load_lds((const unsigned*)((const char*)(gbase) + (voff)[_i]), (LAS unsigned*)(lds + (bufoff) + ldsw + _i * 8192), 16, 0, 0); } while (0)
#define PG8_LDA(dst, b, h) do { _Pragma("unroll") for (int m = 0; m < 4; ++m) _Pragma("unroll") for (int k = 0; k < 2; ++k) dst[m][k] = *(const LAS bf16x8*)(lds + PG8_SA(b, h) + aoff + m * 2048 + k * 1024); } while (0)
#define PG8_LDB(dst, b, h) do { _Pragma("unroll") for (int n = 0; n < 2; ++n) _Pragma("unroll") for (int k = 0; k < 2; ++k) dst[n][k] = *(const LAS bf16x8*)(lds + PG8_SB(b, h) + boff + n * 2048 + k * 1024); } while (0)
#define PG8_MMA(ai, bj, At, Bt) do { __builtin_amdgcn_s_setprio(1); _Pragma("unroll") for (int m = 0; m < 4; ++m) _Pragma("unroll") for (int n = 0; n < 2; ++n) _Pragma("unroll") for (int k = 0; k < 2; ++k) \
        acc[ai][bj][m][n] = __builtin_amdgcn_mfma_f32_16x16x32_bf16(Bt[n][k], At[m][k], acc[ai][bj][m][n], 0, 0, 0); __builtin_amdgcn_s_setprio(0); } while (0)
#define PG8_WAIT_V(n) asm volatile("s_waitcnt vmcnt(" #n ")" ::: "memory")
#define PG8_WAIT_L(n) asm volatile("s_waitcnt lgkmcnt(" #n ")" ::: "memory")
#define PG8_BAR __builtin_amdgcn_s_barrier()
#define PG8_SCHED __builtin_amdgcn_sched_barrier(0)
    Unit cur, nxt; int ui = 0;
    if (!S.next(0, cur)) return;
    f32x4 acc[2][2][4][2];
#pragma unroll
    for (int a = 0; a < 2; ++a)
#pragma unroll
        for (int b = 0; b < 2; ++b)
#pragma unroll
            for (int m = 0; m < 4; ++m)
#pragma unroll
                for (int n = 0; n < 2; ++n) acc[a][b][m][n] = (f32x4){0.f, 0.f, 0.f, 0.f};
    bf16x8 At[4][2], B0[2][2], B1[2][2];
    const char* cA = cur.a; const char* cB = cur.b;
    PG8_STAGE(PG8_SB(0, 0), cB, voffB); PG8_STAGE(PG8_SA(0, 0), cA, voffA); PG8_STAGE(PG8_SB(0, 1), cB + hstepB, voffB); PG8_STAGE(PG8_SA(0, 1), cA + hstepA, voffA);
    if (wr == 1) PG8_BAR;
    PG8_WAIT_V(4); PG8_BAR;
    PG8_STAGE(PG8_SB(1, 0), cB + kstep, voffB); PG8_STAGE(PG8_SA(1, 0), cA + kstep, voffA); PG8_STAGE(PG8_SB(1, 1), cB + hstepB + kstep, voffB);
    PG8_WAIT_V(6); PG8_BAR;
    for (;;) {
        const bool has_next = S.next(ui + 1, nxt);
        const char* nA = has_next ? nxt.a : cA; const char* nB = has_next ? nxt.b : cB;
#pragma unroll 1
        for (int t = 0; t < nt; t += 2) {
            const bool last = (t == nt - 2);
            const char* a1 = cA + (size_t)(t + 1) * kstep;
            const char* a2 = last ? nA : cA + (size_t)(t + 2) * kstep; const char* b2 = last ? nB : cB + (size_t)(t + 2) * kstep;
            const char* a3 = a2 + kstep; const char* b3 = b2 + kstep;
            PG8_LDB(B0, 0, 0); PG8_SCHED; PG8_LDA(At, 0, 0); PG8_STAGE(PG8_SA(1, 1), a1 + hstepA, voffA);
            PG8_WAIT_L(8); PG8_BAR; PG8_WAIT_L(0); PG8_MMA(0, 0, At, B0); PG8_BAR; PG8_SCHED;
            PG8_LDB(B1, 0, 1); PG8_STAGE(PG8_SB(0, 0), b2, voffB);
            PG8_BAR; PG8_WAIT_L(0); PG8_MMA(0, 1, At, B1); PG8_BAR;
            PG8_LDA(At, 0, 1); PG8_STAGE(PG8_SA(0, 0), a2, voffA);
            PG8_BAR; PG8_WAIT_L(0); PG8_MMA(1, 0, At, B0); PG8_BAR; PG8_SCHED;
            PG8_STAGE(PG8_SB(0, 1), b2 + hstepB, voffB);
            PG8_WAIT_V(6); PG8_BAR; PG8_MMA(1, 1, At, B1); PG8_BAR;
            PG8_LDB(B0, 1, 0); PG8_SCHED; PG8_LDA(At, 1, 0); PG8_STAGE(PG8_SA(0, 1), a2 + hstepA, voffA);
            PG8_WAIT_L(8); PG8_BAR; PG8_WAIT_L(0); PG8_MMA(0, 0, At, B0); PG8_BAR; PG8_SCHED;
            PG8_LDB(B1, 1, 1); PG8_STAGE(PG8_SB(1, 0), b3, voffB);
            PG8_BAR; PG8_WAIT_L(0); PG8_MMA(0, 1, At, B1); PG8_BAR;
            PG8_LDA(At, 1, 1); PG8_STAGE(PG8_SA(1, 0), a3, voffA);
            PG8_BAR; PG8_WAIT_L(0); PG8_MMA(1, 0, At, B0); PG8_BAR; PG8_SCHED;
            PG8_STAGE(PG8_SB(1, 1), b3 + hstepB, voffB);
            PG8_WAIT_V(6); PG8_BAR; PG8_MMA(1, 1, At, B1); PG8_BAR;
        }
        { int fr_ = fr, fq_ = fq; asm volatile("" : "+v"(fr_), "+v"(fq_)); E(acc, cur, wr, wc, fr_, fq_); }
        if (!has_next) break;
#pragma unroll
        for (int a = 0; a < 2; ++a)
#pragma unroll
            for (int b = 0; b < 2; ++b)
#pragma unroll
                for (int m = 0; m < 4; ++m)
#pragma unroll
                    for (int n = 0; n < 2; ++n) acc[a][b][m][n] = (f32x4){0.f, 0.f, 0.f, 0.f};
        cur = nxt; cA = nA; cB = nB; ++ui;
    }
    PG8_WAIT_V(0);
    if (wr == 0) PG8_BAR;
    PG8_BAR;
#undef PG8_SA
#undef PG8_SB
#undef PG8_STAGE
#undef PG8_LDA
#undef PG8_LDB
#undef PG8_MMA
#undef PG8_WAIT_V
#undef PG8_WAIT_L
#undef PG8_BAR
#undef PG8_SCHED
}

typedef const f32x4 (&AccRef)[2][2][4][2];
#define EPI_PERM_LOOP(...) _Pragma("unroll") for (int ai = 0; ai < 2; ++ai) _Pragma("unroll") for (int m = 0; m < 4; ++m) { const int lr = ai * 128 + wr * 64 + m * 16 + fr; \
    _Pragma("unroll") for (int bj = 0; bj < 2; ++bj) { const int lc = bj * 128 + wc * 32 + 8 * fq; f32x4 v0 = acc[ai][bj][m][0], v1 = acc[ai][bj][m][1]; __VA_ARGS__ } }
#define EPI_PACK(w, v0, v1) u32x4 w; w.x = cvt_pk_bf16(v0[0], v0[1]); w.y = cvt_pk_bf16(v0[2], v0[3]); w.z = cvt_pk_bf16(v1[0], v1[1]); w.w = cvt_pk_bf16(v1[2], v1[3]);

struct EpiIn {
    static constexpr bool PERM = true;
    bf16_t* sg; bf16_t* us;
    DI void operator()(AccRef acc, const Unit& u, int wr, int wc, int fr, int fq) const {
        const int row0 = u.pm * BM;
        if (u.pn < 16) { bf16_t* base = sg + (size_t)row0 * 4096 + u.pn * BM;
            EPI_PERM_LOOP({ _Pragma("unroll") for (int j = 0; j < 4; ++j) { v0[j] = sigmoidf_(v0[j]); v1[j] = sigmoidf_(v1[j]); } u32x4 w; w.x = pk2(v0[0], v0[1]); w.y = pk2(v0[2], v0[3]); w.z = pk2(v1[0], v1[1]); w.w = pk2(v1[2], v1[3]); *(u32x4*)(base + (size_t)lr * 4096 + lc) = w; }) }
        else { bf16_t* base = us + (size_t)row0 * USW + (u.pn - 16) * BM;
            EPI_PERM_LOOP({ EPI_PACK(w, v0, v1); *(u32x4*)(base + (size_t)lr * USW + lc) = w; }) }
    }
};
struct EpiStore {
    static constexpr bool PERM = true;
    bf16_t* O; int ldc; const float* cscale; int mode;
    DI void operator()(AccRef acc, const Unit& u, int wr, int wc, int fr, int fq) const {
        size_t rb, cb;
        if (mode == 0) { rb = (size_t)u.pm * BM; cb = (size_t)u.pn * BM; }
        else if (mode == 1) { rb = (size_t)MC + u.pn * 1024 + u.pm * BM; cb = 512; }
        else { rb = (size_t)u.pm * BM; cb = 512; }
        bf16_t* base = O + rb * ldc + cb;
        if (cscale) { const float* cs = cscale + u.pn * BM;
            EPI_PERM_LOOP({ const f32x4 s0 = *(const f32x4*)(cs + lc), s1 = *(const f32x4*)(cs + lc + 4); v0 = v0 * s0; v1 = v1 * s1; EPI_PACK(w, v0, v1); *(u32x4*)(base + (size_t)lr * ldc + lc) = w; }) }
        else { EPI_PERM_LOOP({ EPI_PACK(w, v0, v1); *(u32x4*)(base + (size_t)lr * ldc + lc) = w; }) }
    }
};
struct EpiZt {
    static constexpr bool PERM = false;
    bf16_t* ztl; bf16_t* ztc;
    DI void operator()(AccRef acc, const Unit& u, int wr, int wc, int fr, int fq) const {
        const int row0 = u.pm * BM; bf16_t* base; int T, t0;
        if (row0 < MC) { T = 256; t0 = 0; base = ztc + (size_t)(row0 >> 8) * 256 * 512; } else { const int rr = row0 - MC; T = 1024; t0 = rr & 1023; base = ztl + (size_t)(rr >> 10) * 256 * 2048; }
        const int ldz = 2 * T;
#pragma unroll
        for (int ai = 0; ai < 2; ++ai)
#pragma unroll
            for (int m = 0; m < 4; ++m) { const int t = t0 + ai * 128 + wr * 64 + m * 16 + fr;
#pragma unroll
                for (int bj = 0; bj < 2; ++bj)
#pragma unroll
                    for (int n = 0; n < 2; ++n) { const int j = u.pn * BM + bj * 128 + wc * 32 + n * 16 + 4 * fq; const int g = j >> 7, hf = (j >> 6) & 1, cp = j & 63;
                        bf16_t* d = base + (size_t)(g * 64 + cp) * ldz + hf * T + t; const f32x4 v = acc[ai][bj][m][n];
                        d[0] = f2bf(v[0]); d[ldz] = f2bf(v[1]); d[2 * ldz] = f2bf(v[2]); d[3 * ldz] = f2bf(v[3]); } }
    }
};
struct EpiProj {
    static constexpr bool PERM = true;
    const bf16_t* sg; float* mp; bf16_t* mg;
    DI void operator()(AccRef acc, const Unit& u, int wr, int wc, int fr, int fq) const {
        const int n = u.z; const size_t row0 = (size_t)u.pm * BM; const int col0 = u.pn * BM;
        const bf16_t* sgb = sg + row0 * 4096 + n * 1024 + col0; float* mpb = mp + row0 * DM + col0; bf16_t* mgb = mg + row0 * DM + col0;
        EPI_PERM_LOOP({ const u32x4 gw = *(const u32x4*)(sgb + (size_t)lr * 4096 + lc);
            v0[0] *= bflo(gw.x); v0[1] *= bfhi(gw.x); v0[2] *= bflo(gw.y); v0[3] *= bfhi(gw.y); v1[0] *= bflo(gw.z); v1[1] *= bfhi(gw.z); v1[2] *= bflo(gw.w); v1[3] *= bfhi(gw.w);
            float* p = mpb + (size_t)lr * DM + lc;
            if (n > 0) { v0 = v0 + *(const f32x4*)p; v1 = v1 + *(const f32x4*)(p + 4); }
            if (n < 3) { *(f32x4*)p = v0; *(f32x4*)(p + 4) = v1; }
            else { EPI_PACK(w, v0, v1); *(u32x4*)(mgb + (size_t)lr * DM + lc) = w; } })
    }
};
struct EpiGate {
    static constexpr bool PERM = true;
    bf16_t* sg;
    DI void operator()(AccRef acc, const Unit& u, int wr, int wc, int fr, int fq) const {
        bf16_t* base = sg + (size_t)u.pm * BM * 4096 + u.pn * BM;
        EPI_PERM_LOOP({ bf16_t* p = base + (size_t)lr * 4096 + lc; const u32x4 gw = *(const u32x4*)p;
            v0[0] *= bflo(gw.x); v0[1] *= bfhi(gw.x); v0[2] *= bflo(gw.y); v0[3] *= bfhi(gw.y); v1[0] *= bflo(gw.z); v1[1] *= bfhi(gw.z); v1[2] *= bflo(gw.w); v1[3] *= bfhi(gw.w);
            EPI_PACK(w, v0, v1); *(u32x4*)p = w; })
    }
};
struct EpiResid {
    static constexpr bool PERM = false;
    const float* xp; const float* xs; float* out; const float* gate;
    DI void operator()(AccRef acc, const Unit& u, int wr, int wc, int fr, int fq) const {
        const int row0 = u.pm * BM; const float* bs = xp ? (row0 < MC ? xp + (size_t)row0 * DM : xs + (size_t)(row0 - MC) * DM) : out + (size_t)row0 * DM;
        float* ob = out + (size_t)row0 * DM; const float* gp = gate + (size_t)cond_row(row0) * 6144;
#pragma unroll
        for (int bj = 0; bj < 2; ++bj)
#pragma unroll
            for (int n = 0; n < 2; ++n) { const int col = u.pn * BM + bj * 128 + wc * 32 + n * 16 + 4 * fq; const f32x4 gv = *(const f32x4*)(gp + col);
#pragma unroll
                for (int ai = 0; ai < 2; ++ai)
#pragma unroll
                    for (int m = 0; m < 4; ++m) { const size_t off = (size_t)(ai * 128 + wr * 64 + m * 16 + fr) * DM + col;
                        const f32x4 b = *(const f32x4*)(bs + off); *(f32x4*)(ob + off) = b + gv * acc[ai][bj][m][n]; } }
    }
};
}

struct Params {
    const float* in[31];
    float* out; unsigned char* ws;
    int lo, hi;
};
enum { I_XP = 0, I_XS, I_C, I_CCTX, I_CDK, I_CDV, I_CCKV, I_CKR, I_WADA, I_BADA, I_GN1, I_GN2, I_WIN, I_POOLW, I_POOLS, I_DQN, I_DKN, I_DLAM, I_DSUB,
       I_QAN, I_WUQ, I_KVN, I_WUKV, I_MQN, I_MKN, I_WBR, I_WOUT, I_WUP, I_CONVW, I_CONVB, I_WDOWN };

DI void tr_load(const float* src, int R, int C, int tile, int tid, f32x4 (&v)[8]) {
    const int ntk = R / 64, tk = tile % ntk, tn = tile / ntk, k0 = tk * 64, n0 = tn * 256;
#pragma unroll
    for (int i = 0; i < 8; ++i) { const int k = (tid >> 6) + 8 * i, n = n0 + (tid & 63) * 4; v[i] = (f32x4){0.f, 0.f, 0.f, 0.f};
        if (n < C) v[i] = *(const f32x4*)(src + (size_t)(k0 + k) * C + n); }
}
DI void tr_store(LAS unsigned char* lds, bf16_t* dst, int R, int tile, int tid, const f32x4 (&v)[8]) {
    LAS float* T = (LAS float*)lds;
    const int ntk = R / 64, tk = tile % ntk, tn = tile / ntk, k0 = tk * 64, n0 = tn * 256;
    __syncthreads();
#pragma unroll
    for (int i = 0; i < 8; ++i) { const int k = (tid >> 6) + 8 * i; LAS float* t = T + k * 257 + (tid & 63) * 4; t[0] = v[i][0]; t[1] = v[i][1]; t[2] = v[i][2]; t[3] = v[i][3]; }
    __syncthreads();
#pragma unroll
    for (int j = 0; j < 4; ++j) { const int n = (tid >> 3) + 64 * j, kc = (tid & 7) * 8; u32x4 w;
        w.x = pk2(T[(kc + 0) * 257 + n], T[(kc + 1) * 257 + n]); w.y = pk2(T[(kc + 2) * 257 + n], T[(kc + 3) * 257 + n]);
        w.z = pk2(T[(kc + 4) * 257 + n], T[(kc + 5) * 257 + n]); w.w = pk2(T[(kc + 6) * 257 + n], T[(kc + 7) * 257 + n]);
        *(u32x4*)(dst + (size_t)(n0 + n) * R + k0 + kc) = w; }
}
DI void tr_job(LAS unsigned char* lds, const float* src, bf16_t* dst, int R, int C, int Cpad, int& base, int G, int c) {
    const int nt = (R / 64) * (Cpad / 256); int tid = threadIdx.x; asm volatile("" : "+v"(tid));
    int t = (c + G - (base % G)) % G; base += nt;
    if (t >= nt) return;
    f32x4 nx[8]; tr_load(src, R, C, t, tid, nx);
    for (; t < nt; t += G) {
        f32x4 cur[8];
#pragma unroll
        for (int i = 0; i < 8; ++i) cur[i] = nx[i];
        if (t + G < nt) tr_load(src, R, C, t + G, tid, nx);
        tr_store(lds, dst, R, t, tid, cur);
    }
}

DI void convert_layer_weights(const Params& p, LAS unsigned char* lds, int l, int G, int c) {
    unsigned char* ws = p.ws; int base = 0;
    tr_job(lds, p.in[I_WIN] + (size_t)l * DM * INC, (bf16_t*)(ws + WS_WIN + l * SZ_WIN), DM, INC, INP, base, G, c);
    tr_job(lds, p.in[I_WUP] + (size_t)l * DM * F2, (bf16_t*)(ws + WS_WUP + l * SZ_WUP), DM, F2, F2, base, G, c);
    tr_job(lds, p.in[I_WDOWN] + (size_t)l * FH * DM, (bf16_t*)(ws + WS_WD + l * SZ_WD), FH, DM, DM, base, G, c);
    tr_job(lds, p.in[I_WOUT] + (size_t)l * DM * DM, (bf16_t*)(ws + WS_WO + l * SZ_WO), DM, DM, DM, base, G, c);
    for (int n = 0; n < 4; ++n)
        tr_job(lds, p.in[I_WBR] + ((size_t)l * 4 + n) * 256 * DM, (bf16_t*)(ws + WS_WB + l * SZ_WB) + (size_t)n * 1024 * 256, 256, DM, DM, base, G, c);
    __syncthreads();
}

DI void phase_prepass(const Params& p, LAS unsigned char* lds, int G, int c) {
    unsigned char* ws = p.ws; int tid = threadIdx.x; asm volatile("" : "+v"(tid));
    convert_layer_weights(p, lds, 0, G, c);
    {
        LAS float* sc = (LAS float*)lds;
        for (int i = tid; i < 9 * 1024; i += NTHR) { const int r = i >> 10, k = i & 1023; const float v = r == 0 ? p.in[I_CCTX][k] : p.in[I_C][(r - 1) * 1024 + k]; sc[i] = v * sigmoidf_(v); }
        __syncthreads();
        LAS float* red = (LAS float*)(lds + 9 * 1024 * 4);
        float* mod = (float*)(ws + WS_MOD);
        for (int it = c; it < 192; it += G) {
            const int l = it / 48, col = (it % 48) * 128 + (tid & 127), kq = tid >> 7;
            const float* w = p.in[I_WADA] + (size_t)l * DM * 6144 + col;
            float a[9];
#pragma unroll
            for (int r = 0; r < 9; ++r) a[r] = 0.f;
#pragma unroll 8
            for (int k = kq * 256; k < kq * 256 + 256; ++k) { const float wv = w[(size_t)k * 6144];
#pragma unroll
                for (int r = 0; r < 9; ++r) a[r] += sc[r * 1024 + k] * wv; }
            __syncthreads();
#pragma unroll
            for (int r = 0; r < 9; ++r) red[(kq * 9 + r) * 128 + (tid & 127)] = a[r];
            __syncthreads();
            for (int i = tid; i < 9 * 128; i += NTHR) { const int r = i >> 7, cc = i & 127, colo = (it % 48) * 128 + cc;
                mod[((size_t)l * 9 + r) * 6144 + colo] = red[(0 * 9 + r) * 128 + cc] + red[(1 * 9 + r) * 128 + cc] + red[(2 * 9 + r) * 128 + cc] + red[(3 * 9 + r) * 128 + cc] + p.in[I_BADA][l * 6144 + colo]; }
        }
        __syncthreads();
    }
    const size_t gt = (size_t)c * NTHR + tid, gs = (size_t)G * NTHR;
    for (size_t i = gt; i < (size_t)NLAY * 512 * 256; i += gs) {
        const int l = (int)(i >> 17), n = (int)(i >> 8) & 511, k = (int)i & 255;
        { const int h = n >> 7, d = n & 127; float v = 0.f; if (d < 96 && k < 192) v = p.in[I_WUQ][((size_t)l * 192 + k) * 384 + h * 96 + d] * p.in[I_QAN][l * 192 + k];
          ((bf16_t*)(ws + WS_WUQ))[i] = f2bf(v); }
        { float v = 0.f, vp = 0.f; if (k < 128) { vp = p.in[I_WUKV][((size_t)l * 128 + k) * 512 + n]; v = vp * p.in[I_KVN][l * 128 + k]; }
          ((bf16_t*)(ws + WS_WUKV))[i] = f2bf(v); ((bf16_t*)(ws + WS_WUKVP))[i] = f2bf(vp); }
    }
    for (size_t i = gt; i < (size_t)512 * 256; i += gs) {
        const int j = (int)(i >> 8), k = (int)i & 255, g = j >> 7, hf = (j >> 6) & 1, cp = j & 63, g2 = k >> 6, cc = k & 63; float v = 0.f;
        if (g == g2) { const int m = (cp * cc) & 63; const float a = (float)m * (1.0f / 32.0f); v = (hf ? -sinpif(a) : cospif(a)) * 0.125f; }
        ((bf16_t*)(ws + WS_BDFT))[i] = f2bf(v);
    }
    for (size_t i = gt; i < (size_t)NLAY * 256 * 256; i += gs) {
        const int l = (int)(i >> 16), e = (int)(i >> 8) & 255, k = (int)i & 255; float v = 0.f;
        if ((e >> 6) == (k >> 6)) v = p.in[I_POOLW][(((size_t)l * 4 + (e >> 6)) * 64 + (k & 63)) * 64 + (e & 63)];
        ((bf16_t*)(ws + WS_BDPOOL))[i] = f2bf(v);
    }
    for (size_t i = gt; i < (size_t)1024 * 2048; i += gs) {
        const int kt = (int)(i >> 11), t = (int)i & 2047, tt = t & 1023; const int m = (kt * tt) & 1023; const float a = (float)m * (1.0f / 512.0f);
        ((bf16_t*)(ws + WS_D1024))[i] = f2bf((t < 1024 ? cospif(a) : sinpif(a)) * (1.0f / 32.0f));
    }
    for (size_t i = gt; i < (size_t)256 * 512; i += gs) {
        const int kt = (int)(i >> 9), t = (int)i & 511, tt = t & 255; const int m = (kt * tt) & 255; const float a = (float)m * (1.0f / 128.0f);
        ((bf16_t*)(ws + WS_D256))[i] = f2bf((t < 256 ? cospif(a) : sinpif(a)) * (1.0f / 16.0f));
    }
    for (size_t i = gt; i < (size_t)NLAY * 8 * 4 * 512 * 64; i += gs) {
        const int d = (int)i & 63, key = (int)(i >> 6) & 511, h = (int)(i >> 15) & 3, b = (int)(i >> 17) & 7, l = (int)(i >> 20);
        ((bf16_t*)(ws + WS_KDC))[i] = f2bf(p.in[I_CDK][((((size_t)b * 4 + l) * 512 + key) * 4 + h) * 64 + d]);
    }
    for (size_t i = gt; i < (size_t)NLAY * 8 * 4 * 64 * 512; i += gs) {
        const int key = (int)i & 511, dv = (int)(i >> 9) & 63, h = (int)(i >> 15) & 3, b = (int)(i >> 17) & 7, l = (int)(i >> 20);
        ((bf16_t*)(ws + WS_VDTC))[i] = f2bf(p.in[I_CDV][((((size_t)b * 4 + l) * 512 + key) * 4 + h) * 64 + dv]);
    }
    for (size_t i = gt; i < (size_t)NLAY * 4096 * 256; i += gs) {
        const int k = (int)i & 255, key = (int)(i >> 8) & 511, b = (int)(i >> 17) & 7, l = (int)(i >> 20);
        ((bf16_t*)(ws + WS_R1 + R1_AC))[i] = k < 128 ? f2bf(p.in[I_CCKV][(((size_t)b * 4 + l) * 512 + key) * 128 + k]) : (bf16_t)0;
    }
}

DI void phase_norm(const Params& p, int l, int which, bool from_input, int G, int c) {
    int tid_ = threadIdx.x; asm volatile("" : "+v"(tid_)); const int lane = tid_ & 63, wid = tid_ >> 6;
    const float* gn = p.in[which ? I_GN2 : I_GN1] + l * DM; const float* mod = (const float*)(p.ws + WS_MOD) + (size_t)l * 9 * 6144 + which * 3072;
    bf16_t* h = (bf16_t*)(p.ws + WS_HM);
    for (int rowa = c * 8 + wid; rowa < MT; rowa += 2 * G * 8) {
        const int rowb = rowa + G * 8; const bool hb = rowb < MT;
        const float* xa = from_input ? (rowa < MC ? p.in[I_XP] + (size_t)rowa * DM : p.in[I_XS] + (size_t)(rowa - MC) * DM) : p.out + (size_t)rowa * DM;
        const int rb = hb ? rowb : rowa;
        const float* xb = from_input ? (rb < MC ? p.in[I_XP] + (size_t)rb * DM : p.in[I_XS] + (size_t)(rb - MC) * DM) : p.out + (size_t)rb * DM;
        f32x4 va[4], vb[4]; float sa = 0.f, sb2 = 0.f;
#pragma unroll
        for (int i = 0; i < 4; ++i) { va[i] = *(const f32x4*)(xa + i * 256 + lane * 4); vb[i] = *(const f32x4*)(xb + i * 256 + lane * 4); }
#pragma unroll
        for (int i = 0; i < 4; ++i) { sa += va[i][0] * va[i][0] + va[i][1] * va[i][1] + va[i][2] * va[i][2] + va[i][3] * va[i][3]; sb2 += vb[i][0] * vb[i][0] + vb[i][1] * vb[i][1] + vb[i][2] * vb[i][2] + vb[i][3] * vb[i][3]; }
        for (int o = 32; o >= 1; o >>= 1) { sa += __shfl_xor(sa, o); sb2 += __shfl_xor(sb2, o); }
        const float rsa = rsqrtf(sa * (1.0f / DM) + EPSV), rsb = rsqrtf(sb2 * (1.0f / DM) + EPSV);
        const float* mra = mod + (size_t)cond_row(rowa) * 6144; const float* mrb = mod + (size_t)cond_row(rb) * 6144;
#pragma unroll
        for (int i = 0; i < 4; ++i) { const int col = i * 256 + lane * 4; const f32x4 g = *(const f32x4*)(gn + col);
            { const f32x4 sh = *(const f32x4*)(mra + col), sc = *(const f32x4*)(mra + 1024 + col); const f32x4 o = va[i] * rsa * g * (sc + 1.0f) + sh; u32x2 w; w.x = pk2(o[0], o[1]); w.y = pk2(o[2], o[3]); *(u32x2*)(h + (size_t)rowa * DM + col) = w; }
            if (hb) { const f32x4 sh = *(const f32x4*)(mrb + col), sc = *(const f32x4*)(mrb + 1024 + col); const f32x4 o = vb[i] * rsb * g * (sc + 1.0f) + sh; u32x2 w; w.x = pk2(o[0], o[1]); w.y = pk2(o[2], o[3]); *(u32x2*)(h + (size_t)rowb * DM + col) = w; } }
    }
}

DI void phase_c1_rows(const Params& p, LAS unsigned char* lds, int l, int G, int c) {
    int tid = threadIdx.x; asm volatile("" : "+v"(tid)); unsigned char* ws = p.ws;
    const bf16_t* us = (const bf16_t*)(ws + WS_R1 + R1_US);
    bf16_t* Qd = (bf16_t*)(ws + WS_HM + HM_QD); bf16_t* Kds = (bf16_t*)(ws + WS_KDS); bf16_t* VdTs = (bf16_t*)(ws + WS_VDTS); bf16_t* pooled = (bf16_t*)(ws + WS_R2 + R2_POOLED);
    const float* qn = p.in[I_DQN] + l * 32; const float* kn = p.in[I_DKN] + l * 32;
    LAS bf16_t* VT = (LAS bf16_t*)lds;
    LAS bf16_t* PT = (LAS bf16_t*)(lds + 64 * 264 * 2);
    for (int it = G - 1 - c; it < MT / 64; it += G) {
        const int r0 = it * 64; const bool lat = r0 >= MC; const int T = lat ? 1024 : 256, t0 = lat ? ((r0 - MC) & 1023) : (r0 & 255), sb = r0 - t0;
        __syncthreads();
        for (int q = tid; q < 64 * 32; q += NTHR) { const int t = q >> 5, ch = q & 31; *(LAS u32x4*)(VT + t * 264 + ch * 8) = *(const u32x4*)(us + (size_t)(r0 + t) * USW + US_V + ch * 8); }
        for (int q = tid; q < 80 * 32; q += NTHR) { const int tr = q >> 5, ch = q & 31, t = t0 - 8 + tr; u32x4 v = (u32x4){0u, 0u, 0u, 0u};
            if (t >= 0 && t < T) v = *(const u32x4*)(us + (size_t)(sb + t) * USW + US_POOL + ch * 8); *(LAS u32x4*)(PT + tr * 264 + ch * 8) = v; }
#pragma unroll
        for (int j = 0; j < 2; ++j) {
            const int vid = tid + NTHR * j, tl = vid >> 4, w = vid & 15, row = r0 + tl, t = t0 + tl; const bool isk = w >= 8; const int h = (w & 7) >> 1, hf = w & 1;
            const bf16_t* src = us + (size_t)row * USW + US_Q + w * 32;
            float y[32]; float ss = 0.f;
#pragma unroll
            for (int q = 0; q < 4; ++q) { const u32x4 v = *(const u32x4*)(src + q * 8);
                y[q * 8 + 0] = bflo(v.x); y[q * 8 + 1] = bfhi(v.x); y[q * 8 + 2] = bflo(v.y); y[q * 8 + 3] = bfhi(v.y); y[q * 8 + 4] = bflo(v.z); y[q * 8 + 5] = bfhi(v.z); y[q * 8 + 6] = bflo(v.w); y[q * 8 + 7] = bfhi(v.w); }
#pragma unroll
            for (int d = 0; d < 32; ++d) ss += y[d] * y[d];
            const float rs = rsqrtf(ss * (1.0f / 32.0f) + EPSV); const float* gnp = isk ? kn : qn;
#pragma unroll
            for (int d = 0; d < 32; ++d) y[d] = y[d] * rs * gnp[d];
            if (isk && !lat) { float* o = p.out + O_DK + ((size_t)((r0 >> 8) * 4 + l) * 256 + t) * 256 + h * 64 + hf * 32;
#pragma unroll
                for (int q = 0; q < 8; ++q) *(f32x4*)(o + q * 4) = (f32x4){y[q * 4], y[q * 4 + 1], y[q * 4 + 2], y[q * 4 + 3]}; }
            if (lat) { const float prow = (float)(t >> 6), pcol = (float)(t & 63); ROPE32(y, 0, prow, pcol); }
            bf16_t* dst = isk ? Kds + (size_t)sb * 256 + ((size_t)h * T + t) * 64 + hf * 32 : Qd + (size_t)row * 256 + h * 64 + hf * 32;
#pragma unroll
            for (int q = 0; q < 4; ++q) { u32x4 wv; wv.x = pk2(y[q * 8], y[q * 8 + 1]); wv.y = pk2(y[q * 8 + 2], y[q * 8 + 3]); wv.z = pk2(y[q * 8 + 4], y[q * 8 + 5]); wv.w = pk2(y[q * 8 + 6], y[q * 8 + 7]); *(u32x4*)(dst + q * 8) = wv; }
        }
        __syncthreads();
        if (!lat) { float* o = p.out + O_DV + ((size_t)((r0 >> 8) * 4 + l) * 256 + t0) * 256;
            for (int q = tid; q < 64 * 256; q += NTHR) o[q] = bf2f(VT[(q >> 8) * 264 + (q & 255)]); }
        { const int cidx = tid & 255, th = tid >> 8; bf16_t* dst = VdTs + (size_t)sb * 256 + ((size_t)(cidx >> 6) * 64 + (cidx & 63)) * T + t0 + th * 32;
#pragma unroll
          for (int q = 0; q < 4; ++q) { u32x4 wv; const LAS bf16_t* s = VT + (th * 32 + q * 8) * 264 + cidx;
              wv.x = (unsigned)s[0] | ((unsigned)s[264] << 16); wv.y = (unsigned)s[2 * 264] | ((unsigned)s[3 * 264] << 16); wv.z = (unsigned)s[4 * 264] | ((unsigned)s[5 * 264] << 16); wv.w = (unsigned)s[6 * 264] | ((unsigned)s[7 * 264] << 16);
              *(u32x4*)(dst + q * 8) = wv; } }
        { const int cidx = tid & 255, th = tid >> 8, hw = 1 << (cidx >> 6);
          const int tf = t0 + th * 32; float s = 0.f;
          { const int lo = max(tf - hw, 0), hi = min(tf + hw, T); for (int tt = lo; tt < hi; ++tt) s += bf2f(PT[(tt - t0 + 8) * 264 + cidx]); }
          for (int q = 0; q < 32; ++q) { const int tl = th * 32 + q, t = t0 + tl; const int lo = max(t - hw, 0), hi = min(t + hw, T);
              const float v = s * __builtin_amdgcn_rcpf((float)(hi - lo)) - bf2f(PT[(tl + 8) * 264 + cidx]); pooled[(size_t)(r0 + tl) * 256 + cidx] = f2bf(v);
              if (t + hw < T) s += bf2f(PT[(t + hw - t0 + 8) * 264 + cidx]);
              if (t - hw >= 0) s -= bf2f(PT[(t - hw - t0 + 8) * 264 + cidx]); } }
    }
    __syncthreads();
}

DI float sumsq8(const u32x4 v) { const float a0 = bflo(v.x), a1 = bfhi(v.x), a2 = bflo(v.y), a3 = bfhi(v.y), a4 = bflo(v.z), a5 = bfhi(v.z), a6 = bflo(v.w), a7 = bfhi(v.w);
    return a0 * a0 + a1 * a1 + a2 * a2 + a3 * a3 + a4 * a4 + a5 * a5 + a6 * a6 + a7 * a7; }
DI u32x4 scale8(const u32x4 v, float sc, const float* g) { const f32x4 g0 = *(const f32x4*)g, g1 = *(const f32x4*)(g + 4); u32x4 w;
    w.x = pk2(bflo(v.x) * sc * g0[0], bfhi(v.x) * sc * g0[1]); w.y = pk2(bflo(v.y) * sc * g0[2], bfhi(v.y) * sc * g0[3]);
    w.z = pk2(bflo(v.z) * sc * g1[0], bfhi(v.z) * sc * g1[1]); w.w = pk2(bflo(v.w) * sc * g1[2], bfhi(v.w) * sc * g1[3]); return w; }
DI u32x4 scale8n(const u32x4 v, float sc) { u32x4 w; w.x = pk2(bflo(v.x) * sc, bfhi(v.x) * sc); w.y = pk2(bflo(v.y) * sc, bfhi(v.y) * sc); w.z = pk2(bflo(v.z) * sc, bfhi(v.z) * sc); w.w = pk2(bflo(v.w) * sc, bfhi(v.w) * sc); return w; }
#define UNPK8(y, o, v) do { y[(o) + 0] = bflo(v.x); y[(o) + 1] = bfhi(v.x); y[(o) + 2] = bflo(v.y); y[(o) + 3] = bfhi(v.y); y[(o) + 4] = bflo(v.z); y[(o) + 5] = bfhi(v.z); y[(o) + 6] = bflo(v.w); y[(o) + 7] = bfhi(v.w); } while (0)
template <bool CACHE>
DI void phase_mla_finish(const Params& p, LAS unsigned char* lds, int l, int G, int c) {
    int tid = threadIdx.x; asm volatile("" : "+v"(tid)); unsigned char* ws = p.ws;
    const bf16_t* us = (const bf16_t*)(ws + WS_R1 + R1_US);
    LAS bf16_t* VT = (LAS bf16_t*)lds;
    const int nitems = CACHE ? NLAY * 4096 / 64 : MT / 64;
    const int it_first = CACHE ? c : (G == 256 ? (c >= 96 ? c - 96 : (c < 32 ? 160 + c : nitems)) : G - 1 - c);
    for (int it = it_first; it < nitems; it += G) {
        int r0, T, t0, sb, lay; bool lat;
        if (CACHE) { lay = it >> 6; r0 = (it & 63) * 64; lat = false; T = 512; t0 = r0 & 511; sb = r0 - t0; }
        else { lay = l; r0 = it * 64; lat = r0 >= MC; T = lat ? 1024 : 256; t0 = lat ? ((r0 - MC) & 1023) : (r0 & 255); sb = r0 - t0; }
        const int role = tid >> 8, tl = (tid & 255) >> 2, h = tid & 3, row = r0 + tl, t = t0 + tl;
        const float prow = (float)(t >> 6), pcol = (float)(t & 63);
        __syncthreads();
        if (role == 0 && !CACHE) {
            const bf16_t* cq = us + (size_t)row * USW + US_CQ + h * 48; float ss = 0.f;
#pragma unroll
            for (int q = 0; q < 6; ++q) ss += sumsq8(*(const u32x4*)(cq + q * 8));
            ss += __shfl_xor(ss, 1); ss += __shfl_xor(ss, 2);
            const float rq = rsqrtf(ss * (1.0f / 192.0f) + EPSV);
            const bf16_t* src = (const bf16_t*)(ws + WS_R2 + R2_QRAW) + (size_t)row * 512 + h * 128;
            float s2 = 0.f;
#pragma unroll
            for (int q = 0; q < 12; ++q) s2 += sumsq8(*(const u32x4*)(src + q * 8));
            s2 *= rq * rq;
            const float r2 = rsqrtf(s2 * (1.0f / 96.0f) + EPSV) * rq; const float* gq = p.in[I_MQN] + lay * 96;
            bf16_t* dst = (bf16_t*)(ws + WS_HM + HM_QM) + (size_t)row * 384 + h * 96;
#pragma unroll
            for (int q = 0; q < 8; ++q) *(u32x4*)(dst + q * 8) = scale8(*(const u32x4*)(src + q * 8), r2, gq + q * 8);
            float y[32];
#pragma unroll
            for (int q = 0; q < 4; ++q) { const u32x4 v = *(const u32x4*)(src + 64 + q * 8); UNPK8(y, q * 8, v); }
#pragma unroll
            for (int d = 0; d < 32; ++d) y[d] = y[d] * r2 * gq[64 + d];
            if (lat) ROPE32(y, 0, prow, pcol);
#pragma unroll
            for (int q = 0; q < 4; ++q) { u32x4 wv; wv.x = pk2(y[q * 8], y[q * 8 + 1]); wv.y = pk2(y[q * 8 + 2], y[q * 8 + 3]); wv.z = pk2(y[q * 8 + 4], y[q * 8 + 5]); wv.w = pk2(y[q * 8 + 6], y[q * 8 + 7]); *(u32x4*)(dst + 64 + q * 8) = wv; }
        }
        if (role == 1) {
            float rkv = 1.0f;
            const int b = r0 >> (CACHE ? 9 : 8);
            if (!CACHE) {
                const bf16_t* ck = us + (size_t)row * USW + US_CKV + h * 32; float ss = 0.f;
#pragma unroll
                for (int q = 0; q < 4; ++q) ss += sumsq8(*(const u32x4*)(ck + q * 8));
                ss += __shfl_xor(ss, 1); ss += __shfl_xor(ss, 2);
                rkv = rsqrtf(ss * (1.0f / 128.0f) + EPSV);
                if (!lat) { const float* gk = p.in[I_KVN] + lay * 128 + h * 32; float* o = p.out + O_CKV + ((size_t)(b * 4 + lay) * 256 + t) * 128 + h * 32;
#pragma unroll
                    for (int q = 0; q < 4; ++q) { const u32x4 v = *(const u32x4*)(ck + q * 8); const f32x4 g0 = *(const f32x4*)(gk + q * 8), g1 = *(const f32x4*)(gk + q * 8 + 4);
                        *(f32x4*)(o + q * 8) = (f32x4){bflo(v.x) * rkv * g0[0], bfhi(v.x) * rkv * g0[1], bflo(v.y) * rkv * g0[2], bfhi(v.y) * rkv * g0[3]};
                        *(f32x4*)(o + q * 8 + 4) = (f32x4){bflo(v.z) * rkv * g1[0], bfhi(v.z) * rkv * g1[1], bflo(v.w) * rkv * g1[2], bfhi(v.w) * rkv * g1[3]}; } }
            }
            float y[32];
            if (CACHE) { const float* krp = p.in[I_CKR] + ((size_t)(b * 4 + lay) * 512 + t) * 32;
#pragma unroll
                for (int q = 0; q < 8; ++q) { const f32x4 v = *(const f32x4*)(krp + q * 4); y[q * 4] = v[0]; y[q * 4 + 1] = v[1]; y[q * 4 + 2] = v[2]; y[q * 4 + 3] = v[3]; } }
            else { const bf16_t* krp = us + (size_t)row * USW + US_KR;
#pragma unroll
                for (int q = 0; q < 4; ++q) { const u32x4 v = *(const u32x4*)(krp + q * 8); UNPK8(y, q * 8, v); }
                if (!lat) { float* o = p.out + O_KR + ((size_t)(b * 4 + lay) * 256 + t) * 32 + h * 8; const u32x4 v = *(const u32x4*)(krp + h * 8);
                    *(f32x4*)o = (f32x4){bflo(v.x), bfhi(v.x), bflo(v.y), bfhi(v.y)}; *(f32x4*)(o + 4) = (f32x4){bflo(v.z), bfhi(v.z), bflo(v.w), bfhi(v.w)}; } }
            const bf16_t* src = CACHE ? (const bf16_t*)(ws + WS_R1 + R1_KVRC) + ((size_t)lay * 4096 + row) * 512 + h * 128 : (const bf16_t*)(ws + WS_R2 + R2_KVRAW) + (size_t)row * 512 + h * 128;
            float s2 = 0.f, s3 = 0.f;
#pragma unroll
            for (int q = 0; q < 8; ++q) s2 += sumsq8(*(const u32x4*)(src + q * 8));
#pragma unroll
            for (int d = 0; d < 32; ++d) s3 += y[d] * y[d];
            s2 = s2 * rkv * rkv + s3;
            const float r2 = rsqrtf(s2 * (1.0f / 96.0f) + EPSV); const float* gk2 = p.in[I_MKN] + lay * 96;
            bf16_t* dst = CACHE ? (bf16_t*)(ws + WS_KMC) + ((((size_t)lay * 8 + b) * 4 + h) * 512 + t) * 96 : (bf16_t*)(ws + WS_HM + HM_KMS) + (size_t)sb * 384 + ((size_t)h * T + t) * 96;
#pragma unroll
            for (int q = 0; q < 8; ++q) *(u32x4*)(dst + q * 8) = scale8(*(const u32x4*)(src + q * 8), r2 * rkv, gk2 + q * 8);
#pragma unroll
            for (int q = 0; q < 8; ++q) *(LAS u32x4*)(VT + tl * 264 + h * 64 + q * 8) = scale8n(*(const u32x4*)(src + 64 + q * 8), rkv);
#pragma unroll
            for (int d = 0; d < 32; ++d) y[d] = y[d] * r2 * gk2[64 + d];
            if (lat) ROPE32(y, 0, prow, pcol);
#pragma unroll
            for (int q = 0; q < 4; ++q) { u32x4 wv; wv.x = pk2(y[q * 8], y[q * 8 + 1]); wv.y = pk2(y[q * 8 + 2], y[q * 8 + 3]); wv.z = pk2(y[q * 8 + 4], y[q * 8 + 5]); wv.w = pk2(y[q * 8 + 6], y[q * 8 + 7]); *(u32x4*)(dst + 64 + q * 8) = wv; }
        }
        __syncthreads();
        { const int cidx = tid & 255, th = tid >> 8; const int b = r0 >> 9;
          bf16_t* dst = CACHE ? (bf16_t*)(ws + WS_VMTC) + ((((size_t)lay * 8 + b) * 4 + (cidx >> 6)) * 64 + (cidx & 63)) * 512 + t0 + th * 32
                              : (bf16_t*)(ws + WS_VMTS) + (size_t)sb * 256 + ((size_t)(cidx >> 6) * 64 + (cidx & 63)) * T + t0 + th * 32;
#pragma unroll
          for (int q = 0; q < 4; ++q) { u32x4 wv; const LAS bf16_t* s = VT + (th * 32 + q * 8) * 264 + cidx;
              wv.x = (unsigned)s[0] | ((unsigned)s[264] << 16); wv.y = (unsigned)s[2 * 264] | ((unsigned)s[3 * 264] << 16); wv.z = (unsigned)s[4 * 264] | ((unsigned)s[5 * 264] << 16); wv.w = (unsigned)s[6 * 264] | ((unsigned)s[7 * 264] << 16);
              *(u32x4*)(dst + q * 8) = wv; } }
    }
    __syncthreads();
}

template <bool DIFF>
DI void attn_item(LAS unsigned char* lds, const bf16_t* Qp, int qstride, const bf16_t* K0, const bf16_t* VT0, int n0, int vts0, const bf16_t* K1, const bf16_t* VT1, int n1, int vts1,
                  bf16_t* outp, float cscale, float lam, const float* subln, float oscale) {
    constexpr int KD = DIFF ? 64 : 96, KP = KD + 8, NP = KD / 32, CPK = KD / 8;
    int tid = threadIdx.x; asm volatile("" : "+v"(tid)); const int lane = tid & 63, wid = tid >> 6, fr = lane & 15, g = lane >> 4;
    bf16x8 qf[NP];
#pragma unroll
    for (int pi = 0; pi < NP; ++pi) { u32x4 w = *(const u32x4*)(Qp + (size_t)(wid * 16 + fr) * qstride + pi * 32 + g * 8);
        w.x = pk2(bflo(w.x) * cscale, bfhi(w.x) * cscale); w.y = pk2(bflo(w.y) * cscale, bfhi(w.y) * cscale); w.z = pk2(bflo(w.z) * cscale, bfhi(w.z) * cscale); w.w = pk2(bflo(w.w) * cscale, bfhi(w.w) * cscale);
        qf[pi] = __builtin_bit_cast(bf16x8, w); }
    f32x4 O1[4], O2[4];
#pragma unroll
    for (int i = 0; i < 4; ++i) { O1[i] = (f32x4){0.f, 0.f, 0.f, 0.f}; O2[i] = (f32x4){0.f, 0.f, 0.f, 0.f}; }
    float l1 = 0.f, l2 = 0.f;
    const int nt0 = n0 >> 6, ntt = nt0 + (n1 >> 6);
    u32x4 pk0, pk1 = (u32x4){0u, 0u, 0u, 0u}, pv;
#define ATT_PREFETCH(ti) do { const bool s_ = (ti) >= nt0; const bf16_t* Kb = s_ ? K1 + (size_t)((ti) - nt0) * 64 * KD : K0 + (size_t)(ti) * 64 * KD; \
        const bf16_t* Vb = s_ ? VT1 + ((ti) - nt0) * 64 : VT0 + (ti) * 64; const int vs = s_ ? vts1 : vts0; \
        pk0 = *(const u32x4*)(Kb + tid * 8); if (!DIFF && tid < 256) pk1 = *(const u32x4*)(Kb + (512 + tid) * 8); pv = *(const u32x4*)(Vb + (size_t)(tid >> 3) * vs + (tid & 7) * 8); } while (0)
    constexpr int TILE_B = 64 * KP * 2 + 64 * 72 * 2;
#define ATT_STORE(buf) do { LAS bf16_t* Kt_ = (LAS bf16_t*)(lds + (buf) * TILE_B); LAS bf16_t* Vt_ = (LAS bf16_t*)(lds + (buf) * TILE_B + 64 * KP * 2); \
        *(LAS u32x4*)(Kt_ + (tid / CPK) * KP + (tid % CPK) * 8) = pk0; \
        if (!DIFF && tid < 256) { const int q_ = 512 + tid; *(LAS u32x4*)(Kt_ + (q_ / CPK) * KP + (q_ % CPK) * 8) = pk1; } \
        *(LAS u32x4*)(Vt_ + (tid >> 3) * 72 + (tid & 7) * 8) = pv; } while (0)
    ATT_PREFETCH(0);
    __syncthreads();
    ATT_STORE(0);
    if (ntt > 1) ATT_PREFETCH(1);
    __syncthreads();
    for (int ti = 0; ti < ntt; ++ti) {
        const LAS bf16_t* Kt = (const LAS bf16_t*)(lds + (ti & 1) * TILE_B); const LAS bf16_t* Vt = (const LAS bf16_t*)(lds + (ti & 1) * TILE_B + 64 * KP * 2);
        if (ti + 1 < ntt) { ATT_STORE((ti + 1) & 1); if (ti + 2 < ntt) ATT_PREFETCH(ti + 2); }
        f32x4 s1[4], s2[4];
#pragma unroll
        for (int kb = 0; kb < 4; ++kb) {
            const LAS bf16_t* kr = Kt + (kb * 16 + fr) * KP + g * 8; const f32x4 z = (f32x4){0.f, 0.f, 0.f, 0.f};
            if (DIFF) { s1[kb] = __builtin_amdgcn_mfma_f32_16x16x32_bf16(*(const LAS bf16x8*)kr, qf[0], z, 0, 0, 0); s2[kb] = __builtin_amdgcn_mfma_f32_16x16x32_bf16(*(const LAS bf16x8*)(kr + 32), qf[NP > 1 ? 1 : 0], z, 0, 0, 0); }
            else { f32x4 a = __builtin_amdgcn_mfma_f32_16x16x32_bf16(*(const LAS bf16x8*)kr, qf[0], z, 0, 0, 0); a = __builtin_amdgcn_mfma_f32_16x16x32_bf16(*(const LAS bf16x8*)(kr + 32), qf[NP > 1 ? 1 : 0], a, 0, 0, 0);
                   s1[kb] = __builtin_amdgcn_mfma_f32_16x16x32_bf16(*(const LAS bf16x8*)(kr + 64), qf[NP > 2 ? 2 : 0], a, 0, 0, 0); s2[kb] = z; }
        }
#pragma unroll
        for (int kb = 0; kb < 4; ++kb)
#pragma unroll
            for (int r = 0; r < 4; ++r) { const float e1 = __builtin_amdgcn_exp2f(s1[kb][r]); s1[kb][r] = e1; l1 += e1;
                if (DIFF) { const float e2 = __builtin_amdgcn_exp2f(s2[kb][r]); s2[kb][r] = e2; l2 += e2; } }
        bf16x8 pb1[2], pb2[2];
#pragma unroll
        for (int pp = 0; pp < 2; ++pp) { u32x4 w; w.x = pk2(s1[2 * pp][0], s1[2 * pp][1]); w.y = pk2(s1[2 * pp][2], s1[2 * pp][3]); w.z = pk2(s1[2 * pp + 1][0], s1[2 * pp + 1][1]); w.w = pk2(s1[2 * pp + 1][2], s1[2 * pp + 1][3]);
            pb1[pp] = __builtin_bit_cast(bf16x8, w);
            if (DIFF) { u32x4 w2; w2.x = pk2(s2[2 * pp][0], s2[2 * pp][1]); w2.y = pk2(s2[2 * pp][2], s2[2 * pp][3]); w2.z = pk2(s2[2 * pp + 1][0], s2[2 * pp + 1][1]); w2.w = pk2(s2[2 * pp + 1][2], s2[2 * pp + 1][3]); pb2[pp] = __builtin_bit_cast(bf16x8, w2); } }
#pragma unroll
        for (int dvb = 0; dvb < 4; ++dvb)
#pragma unroll
            for (int pp = 0; pp < 2; ++pp) { const LAS bf16_t* vr = Vt + (dvb * 16 + fr) * 72 + pp * 32 + g * 4;
                const u32x2 lo = *(const LAS u32x2*)vr, hi = *(const LAS u32x2*)(vr + 16); const u32x4 vv = (u32x4){lo.x, lo.y, hi.x, hi.y}; const bf16x8 vf = __builtin_bit_cast(bf16x8, vv);
                O1[dvb] = __builtin_amdgcn_mfma_f32_16x16x32_bf16(vf, pb1[pp], O1[dvb], 0, 0, 0);
                if (DIFF) O2[dvb] = __builtin_amdgcn_mfma_f32_16x16x32_bf16(vf, pb2[pp], O2[dvb], 0, 0, 0); }
        __syncthreads();
    }
#undef ATT_PREFETCH
#undef ATT_STORE
    l1 += __shfl_xor(l1, 16); l1 += __shfl_xor(l1, 32);
    const float i1 = 1.0f / l1; float o[4][4];
    if (DIFF) { l2 += __shfl_xor(l2, 16); l2 += __shfl_xor(l2, 32); const float i2 = lam / l2; float ss = 0.f;
#pragma unroll
        for (int dvb = 0; dvb < 4; ++dvb)
#pragma unroll
            for (int r = 0; r < 4; ++r) { o[dvb][r] = O1[dvb][r] * i1 - O2[dvb][r] * i2; ss += o[dvb][r] * o[dvb][r]; }
        ss += __shfl_xor(ss, 16); ss += __shfl_xor(ss, 32);
        const float rn = rsqrtf(ss * (1.0f / 64.0f) + EPSV) * oscale;
#pragma unroll
        for (int dvb = 0; dvb < 4; ++dvb)
#pragma unroll
            for (int r = 0; r < 4; ++r) o[dvb][r] = o[dvb][r] * rn * subln[dvb * 16 + g * 4 + r];
    } else {
#pragma unroll
        for (int dvb = 0; dvb < 4; ++dvb)
#pragma unroll
            for (int r = 0; r < 4; ++r) o[dvb][r] = O1[dvb][r] * i1;
    }
    bf16_t* orow = outp + (size_t)(wid * 16 + fr) * DM + g * 4;
#pragma unroll
    for (int dvb = 0; dvb < 4; ++dvb) { u32x2 w; w.x = pk2(o[dvb][0], o[dvb][1]); w.y = pk2(o[dvb][2], o[dvb][3]); *(u32x2*)(orow + dvb * 16) = w; }
}

DI void phase_attn(const Params& p, LAS unsigned char* lds, int l, int G, int c) {
    unsigned char* ws = p.ws;
    const float* lq = p.in[I_DLAM] + l * 128; float d01 = 0.f, d23 = 0.f;
    for (int i = 0; i < 32; ++i) { d01 += lq[i] * lq[32 + i]; d23 += lq[64 + i] * lq[96 + i]; }
    const float lam_init = 0.8f - 0.6f * expf(-0.3f * (float)l), lam = expf(d01) - expf(d23) + lam_init;
    const bf16_t* Qd = (const bf16_t*)(ws + WS_HM + HM_QD); const bf16_t* Qm = (const bf16_t*)(ws + WS_HM + HM_QM);
    const bf16_t* Kds = (const bf16_t*)(ws + WS_KDS); const bf16_t* VdTs = (const bf16_t*)(ws + WS_VDTS); const bf16_t* Kms = (const bf16_t*)(ws + WS_HM + HM_KMS); const bf16_t* VmTs = (const bf16_t*)(ws + WS_VMTS);
    const bf16_t* Kdc = (const bf16_t*)(ws + WS_KDC); const bf16_t* VdTc = (const bf16_t*)(ws + WS_VDTC); const bf16_t* Kmc = (const bf16_t*)(ws + WS_KMC); const bf16_t* VmTc = (const bf16_t*)(ws + WS_VMTC);
    bf16_t* br = (bf16_t*)(ws + WS_R2 + R2_BR);
    const float cs_da = 0.17677669529663687f * 1.4426950408889634f, cs_ml = 0.10206207261596577f * 1.4426950408889634f;
    for (int L = c; L < 768; L += G) {
        bool mla, lat; int b, h, qb;
        if (L < 512) { lat = true; mla = L >= 256; const int i = L & 255; b = i >> 5; h = (i >> 3) & 3; qb = i & 7; }
        else { lat = false; const int i = L - 512; mla = i >= 128; const int j = i & 127; b = j >> 3; h = (j >> 1) & 3; qb = j & 1; }
        const int T = lat ? 1024 : 256, sb = lat ? MC + b * 1024 : b * 256, row0 = sb + qb * 128, n0 = lat ? 512 : 0;
        const size_t cidx = ((size_t)(l * 8 + b) * 4 + h);
        if (!mla) attn_item<true>(lds, Qd + (size_t)row0 * 256 + h * 64, 256, Kdc + cidx * 512 * 64, VdTc + cidx * 64 * 512, n0, 512, Kds + (size_t)sb * 256 + (size_t)h * T * 64, VdTs + (size_t)sb * 256 + (size_t)h * 64 * T, T, T,
                                  br + (size_t)row0 * DM + 256 + h * 64, cs_da, lam, p.in[I_DSUB] + l * 64, 1.0f - lam_init);
        else attn_item<false>(lds, Qm + (size_t)row0 * 384 + h * 96, 384, Kmc + cidx * 512 * 96, VmTc + cidx * 64 * 512, n0, 512, Kms + (size_t)sb * 384 + (size_t)h * T * 96, VmTs + (size_t)sb * 256 + (size_t)h * 64 * T, T, T,
                              br + (size_t)row0 * DM + 768 + h * 64, cs_ml, 0.f, nullptr, 1.0f);
    }
    __syncthreads();
}

DI void phase_convact(const Params& p, int l, int G, int c) {
    const bf16_t* u2 = (const bf16_t*)(p.ws + WS_R1); bf16_t* act = (bf16_t*)(p.ws + WS_R2);
    const float* cw = p.in[I_CONVW] + (size_t)l * 3 * F2; const float* cbp = p.in[I_CONVB] + (size_t)l * F2;
    int tidc = threadIdx.x; asm volatile("" : "+v"(tidc));
    for (size_t idx = (size_t)c * NTHR + tidc; idx < (size_t)(MT / 8) * 352; idx += (size_t)G * NTHR) {
        const int ch = (int)(idx % 352), seg = (int)(idx / 352), f = ch * 8, r0 = seg * 8;
        const bool lat = r0 >= MC; const int T = lat ? 1024 : 256, t0 = lat ? ((r0 - MC) & 1023) : (r0 & 255);
        float wg[3][8], wv[3][8], bg[8], bv[8];
#pragma unroll
        for (int j = 0; j < 3; ++j)
#pragma unroll
            for (int q = 0; q < 2; ++q) { const f32x4 a = *(const f32x4*)(cw + j * F2 + f + q * 4), b = *(const f32x4*)(cw + j * F2 + FH + f + q * 4);
#pragma unroll
                for (int e = 0; e < 4; ++e) { wg[j][q * 4 + e] = a[e]; wv[j][q * 4 + e] = b[e]; } }
#pragma unroll
        for (int q = 0; q < 2; ++q) { const f32x4 a = *(const f32x4*)(cbp + f + q * 4), b = *(const f32x4*)(cbp + FH + f + q * 4);
#pragma unroll
            for (int e = 0; e < 4; ++e) { bg[q * 4 + e] = a[e]; bv[q * 4 + e] = b[e]; } }
        const u32x4 zz = (u32x4){0u, 0u, 0u, 0u};
        u32x4 pg = t0 > 0 ? *(const u32x4*)(u2 + (size_t)(r0 - 1) * F2 + f) : zz, pvv = t0 > 0 ? *(const u32x4*)(u2 + (size_t)(r0 - 1) * F2 + FH + f) : zz;
        u32x4 cg_ = *(const u32x4*)(u2 + (size_t)r0 * F2 + f), cv_ = *(const u32x4*)(u2 + (size_t)r0 * F2 + FH + f);
#pragma unroll 2
        for (int i = 0; i < 8; ++i) {
            const bool hn = (t0 + i + 1) < T;
            const u32x4 ng = hn ? *(const u32x4*)(u2 + (size_t)(r0 + i + 1) * F2 + f) : zz, nv = hn ? *(const u32x4*)(u2 + (size_t)(r0 + i + 1) * F2 + FH + f) : zz;
            float o[8];
#define CA_ONE(e, PW, CW, NW, PV, CV, NV, HI) { const float gp = HI ? bfhi(PW) : bflo(PW), gc = HI ? bfhi(CW) : bflo(CW), gn = HI ? bfhi(NW) : bflo(NW); \
                const float vp = HI ? bfhi(PV) : bflo(PV), vc = HI ? bfhi(CV) : bflo(CV), vn = HI ? bfhi(NV) : bflo(NV); \
                const float Gv = wg[0][e] * gp + wg[1][e] * gc + wg[2][e] * gn + bg[e], Vv = wv[0][e] * vp + wv[1][e] * vc + wv[2][e] * vn + bv[e]; o[e] = Gv * sigmoidf_(Gv) * Vv; }
            CA_ONE(0, pg.x, cg_.x, ng.x, pvv.x, cv_.x, nv.x, 0) CA_ONE(1, pg.x, cg_.x, ng.x, pvv.x, cv_.x, nv.x, 1)
            CA_ONE(2, pg.y, cg_.y, ng.y, pvv.y, cv_.y, nv.y, 0) CA_ONE(3, pg.y, cg_.y, ng.y, pvv.y, cv_.y, nv.y, 1)
            CA_ONE(4, pg.z, cg_.z, ng.z, pvv.z, cv_.z, nv.z, 0) CA_ONE(5, pg.z, cg_.z, ng.z, pvv.z, cv_.z, nv.z, 1)
            CA_ONE(6, pg.w, cg_.w, ng.w, pvv.w, cv_.w, nv.w, 0) CA_ONE(7, pg.w, cg_.w, ng.w, pvv.w, cv_.w, nv.w, 1)
#undef CA_ONE
            u32x4 w; w.x = pk2(o[0], o[1]); w.y = pk2(o[2], o[3]); w.z = pk2(o[4], o[5]); w.w = pk2(o[6], o[7]);
            *(u32x4*)(act + (size_t)(r0 + i) * FH + f) = w;
            pg = cg_; pvv = cv_; cg_ = ng; cv_ = nv;
        }
    }
}


DI void gbar(unsigned* ctr, unsigned G) {
    asm volatile("s_waitcnt vmcnt(0) lgkmcnt(0)" ::: "memory");
    __syncthreads();
    if (threadIdx.x < 64) {
        if (threadIdx.x == 0) {
            __builtin_amdgcn_fence(__ATOMIC_RELEASE, "agent");
            asm volatile("s_waitcnt vmcnt(0)" ::: "memory");
            __hip_atomic_fetch_add(ctr, 1u, __ATOMIC_RELAXED, __HIP_MEMORY_SCOPE_AGENT);
            const unsigned long long t0 = __builtin_amdgcn_s_memrealtime();
            while (__hip_atomic_load(ctr, __ATOMIC_RELAXED, __HIP_MEMORY_SCOPE_AGENT) < G) {
                __builtin_amdgcn_s_sleep(2);
                if (__builtin_amdgcn_s_memrealtime() - t0 > 20000000ull) break;
            }
        }
        __builtin_amdgcn_fence(__ATOMIC_ACQUIRE, "agent");
        asm volatile("s_waitcnt vmcnt(0)" ::: "memory");
    }
    __syncthreads();
}

#define XB_TMO      128
#define XB_XCNT(j)  (256  + 64 * (j))
#define XB_XSUB(j)  (1280 + 64 * (j))
#define XB_XGEN(j)  (2304 + 64 * (j))
#define XB_TOP      3328
#define XB_TOPGEN   3392
#define XCD_BAR_WORDS 3456
#define XB_SPIN_CAP (1u << 18)
DI unsigned xb_ld(unsigned* p)              { return __hip_atomic_load(p, __ATOMIC_RELAXED, __HIP_MEMORY_SCOPE_AGENT); }
DI unsigned xb_add(unsigned* p, unsigned v) { return __hip_atomic_fetch_add(p, v, __ATOMIC_RELAXED, __HIP_MEMORY_SCOPE_AGENT); }
DI unsigned xb_xcc_id() { return (unsigned)__builtin_amdgcn_s_getreg((3 << 11) | 20) & 0xFu; }
#define XB_SPIN(cond, bar) do { unsigned _sp = 0; while (cond) { __builtin_amdgcn_s_sleep(1); \
    if ((++_sp & 255u) == 0u) { if (xb_ld(&(bar)[XB_TMO])) break; if (_sp > XB_SPIN_CAP) { atomicAdd(&(bar)[XB_TMO], 1u); break; } } } } while (0)
struct XcdBarrier { unsigned* bar; unsigned x; volatile LAS unsigned* st; };
DI XcdBarrier xcd_barrier_post(unsigned* bar, volatile LAS unsigned* st) {
    XcdBarrier b; b.bar = bar; b.x = xb_xcc_id(); b.st = st;
    if (threadIdx.x == 0) (void)xb_add(&bar[XB_XCNT(b.x)], 1u);
    return b;
}
DI void xcd_barrier_complete(unsigned* bar, unsigned x, unsigned& nloc, unsigned& nx) {
    const unsigned G = gridDim.x * gridDim.y * gridDim.z;
    unsigned sum, cnt, mine, sp = 0u;
    for (;;) {
        sum = 0u; cnt = 0u; mine = 0u;
#pragma unroll
        for (unsigned j = 0; j < 16; ++j) { const unsigned c = xb_ld(&bar[XB_XCNT(j)]); sum += c; cnt += (c > 0u) ? 1u : 0u; mine = (j == x) ? c : mine; }
        if (sum == G) break;
        __builtin_amdgcn_s_sleep(1);
        if ((++sp & 255u) == 0u) { if (xb_ld(&bar[XB_TMO])) break; if (sp > XB_SPIN_CAP) { atomicAdd(&bar[XB_TMO], 1u); break; } }
    }
    nloc = mine > 0u ? mine : 1u; nx = cnt > 0u ? cnt : 1u;
}
DI void xcd_barrier(const XcdBarrier& b) {
    asm volatile("s_waitcnt vmcnt(0) lgkmcnt(0)" ::: "memory");
    __syncthreads();
    if (threadIdx.x == 0) {
        unsigned* bar = b.bar;
        __builtin_amdgcn_s_waitcnt(0);
        unsigned nloc = b.st[0], nx = b.st[1];
        if (nloc == 0u) { xcd_barrier_complete(bar, b.x, nloc, nx); b.st[0] = nloc; b.st[1] = nx; }
        const unsigned old = xb_add(&bar[XB_XSUB(b.x)], 1u);
        const unsigned gen = old / nloc;
        if (old + 1u == (gen + 1u) * nloc) {
            __builtin_amdgcn_fence(__ATOMIC_RELEASE, "agent");
            asm volatile("s_waitcnt vmcnt(0)" ::: "memory");
            const unsigned og = xb_add(&bar[XB_TOP], 1u);
            const unsigned tg = og / nx;
            if (og + 1u == (tg + 1u) * nx) xb_add(&bar[XB_TOPGEN], 1u);
            else XB_SPIN(xb_ld(&bar[XB_TOPGEN]) == tg, bar);
            __builtin_amdgcn_fence(__ATOMIC_ACQUIRE, "agent");
            xb_add(&bar[XB_XGEN(b.x)], 1u);
            asm volatile("s_waitcnt vmcnt(0)" ::: "memory");
        } else {
            XB_SPIN(xb_ld(&bar[XB_XGEN(b.x)]) == gen, bar);
            __builtin_amdgcn_fence(__ATOMIC_ACQUIRE, "agent");
            asm volatile("s_waitcnt vmcnt(0)" ::: "memory");
        }
    }
    __syncthreads();
}
#ifndef PHMASK
#define PHMASK 0xFFFF
#endif
#define PHM(k) ((PHMASK >> (k)) & 1)
__global__ void __launch_bounds__(NTHR) mega(Params p) {
    extern __shared__ __attribute__((aligned(16))) unsigned char lds_raw[];
    LAS unsigned char* lds = (LAS unsigned char*)lds_raw;
    cg::grid_group grid = cg::this_grid();
    const int G = gridDim.x, c = blockIdx.x;
    unsigned char* ws = p.ws;
    bf16_t* hm = (bf16_t*)(ws + WS_HM); bf16_t* sg = (bf16_t*)(ws + WS_R1 + R1_SG); bf16_t* us = (bf16_t*)(ws + WS_R1 + R1_US);
    bf16_t* br = (bf16_t*)(ws + WS_R2 + R2_BR); float* mod = (float*)(ws + WS_MOD);
    volatile LAS unsigned* xst = (volatile LAS unsigned*)(lds + 131072);
    if (threadIdx.x < 4) xst[threadIdx.x] = 0u;
    __syncthreads();
    const XcdBarrier xbar = xcd_barrier_post((unsigned*)ws, xst);
    for (int ph = p.lo; ph < p.hi; ++ph) {
        if (ph == 0) { if (PHM(12)) phase_prepass(p, lds, G, c); }
        else if (ph == 1 && PHM(11)) {
            pg8::Gemm g{256, 256, 256}; pg8::SchedPlain S; S.set(ws + WS_R1 + R1_AC, ws + WS_WUKVP, 256, 256, 64, 2, G, c, -1, 4, SZ_SM);
            pg8::EpiStore E{(bf16_t*)(ws + WS_R1 + R1_KVRC), 512, nullptr, 0}; pg8::gemm_phase(lds, g, S, E);
        } else {
            const int l = (ph - 2) / 11, s = (ph - 2) % 11;
            if (s == 0 && PHM(0)) { if (l == 0) phase_mla_finish<true>(p, lds, 0, G, c); phase_norm(p, l, 0, l == 0, G, c); }
            else if (s == 1 && PHM(1)) { pg8::Gemm g{DM, DM, DM}; pg8::SchedPlain S; S.set(hm, ws + WS_WIN + l * SZ_WIN, DM, DM, MT / 256, INP / 256, G, c); pg8::EpiIn E{sg, us}; pg8::gemm_phase(lds, g, S, E); }
            else if (s == 2 && PHM(2)) {
                { pg8::Gemm g{USW, 256, 256}; pg8::SchedPlain S; S.set(us + US_FT, ws + WS_BDFT, USW, 256, MT / 256, 2, G, c); pg8::EpiZt E{(bf16_t*)(ws + WS_R2 + R2_ZTL), (bf16_t*)(ws + WS_R2 + R2_ZTC)}; pg8::gemm_phase(lds, g, S, E); }
                __syncthreads();
                { pg8::Gemm g{USW, 256, 256}; pg8::SchedPlain S; S.set(us + US_CQ, ws + WS_WUQ + l * SZ_SM, USW, 256, MT / 256, 2, G, (c + G - 96 % G) % G); pg8::EpiStore E{(bf16_t*)(ws + WS_R2 + R2_QRAW), 512, nullptr, 0}; pg8::gemm_phase(lds, g, S, E); }
                __syncthreads();
                { pg8::Gemm g{USW, 256, 256}; pg8::SchedPlain S; S.set(us + US_CKV, ws + WS_WUKV + l * SZ_SM, USW, 256, MT / 256, 2, G, (c + G - 192 % G) % G); pg8::EpiStore E{(bf16_t*)(ws + WS_R2 + R2_KVRAW), 512, nullptr, 0}; pg8::gemm_phase(lds, g, S, E); }
                __syncthreads();
                phase_c1_rows(p, lds, l, G, c);
            } else if (s == 3 && PHM(3)) {
                { pg8::Gemm g{256, 256, 256}; pg8::SchedPlain S; S.set(ws + WS_R2 + R2_POOLED, ws + WS_BDPOOL + l * SZ_BDPOOL, 256, 256, MT / 256, 1, G, c); pg8::EpiStore E{br, DM, p.in[I_POOLS] + l * 256, 0}; pg8::gemm_phase(lds, g, S, E); }
                __syncthreads();
                { pg8::Gemm g{2048, 2048, 2048}; pg8::SchedPlain S; S.set(ws + WS_D1024, ws + WS_R2 + R2_ZTL, 2048, 2048, 4, 8, G, (c + G - 48 % G) % G); pg8::EpiStore E{br, DM, nullptr, 1}; pg8::gemm_phase(lds, g, S, E); }
                __syncthreads();
                { pg8::Gemm g{512, 512, 512}; pg8::SchedPlain S; S.set(ws + WS_D256, ws + WS_R2 + R2_ZTC, 512, 512, 16, 1, G, (c + G - 80 % G) % G, 0, 0, (size_t)256 * 512 * 2); pg8::EpiStore E{br, DM, nullptr, 2}; pg8::gemm_phase(lds, g, S, E); }
                __syncthreads();
                phase_mla_finish<false>(p, lds, l, G, c);
            } else if (s == 4 && PHM(4)) phase_attn(p, lds, l, G, c);
            else if (s == 5 && PHM(5)) { pg8::Gemm g{DM, 256, 256}; pg8::SchedGate S; S.init(MT / 256, 16, G, c); S.A = (const char*)br; S.B = (const char*)(ws + WS_WB + l * SZ_WB);
                pg8::EpiGate E{sg}; pg8::gemm_phase(lds, g, S, E);
                xcd_barrier(xbar);
                int tidm = threadIdx.x; asm volatile("" : "+v"(tidm));
#pragma unroll 3
                for (size_t i = (size_t)c * NTHR + tidm; i < (size_t)MT * 128; i += (size_t)G * NTHR) { const size_t row = i >> 7; const int d = (int)(i & 127) * 8; const bf16_t* gp = sg + row * 4096 + d;
                    float a[8];
#pragma unroll
                    for (int j = 0; j < 8; ++j) a[j] = 0.f;
#pragma unroll
                    for (int n = 0; n < 4; ++n) { const u32x4 v = *(const u32x4*)(gp + n * 1024); a[0] += bflo(v.x); a[1] += bfhi(v.x); a[2] += bflo(v.y); a[3] += bfhi(v.y); a[4] += bflo(v.z); a[5] += bfhi(v.z); a[6] += bflo(v.w); a[7] += bfhi(v.w); }
                    u32x4 w; w.x = pk2(a[0], a[1]); w.y = pk2(a[2], a[3]); w.z = pk2(a[4], a[5]); w.w = pk2(a[6], a[7]); *(u32x4*)(hm + row * DM + d) = w; } }
            else if (s == 6 && PHM(6)) { pg8::Gemm g{DM, DM, DM}; pg8::SchedPlain S; S.set(hm, ws + WS_WO + l * SZ_WO, DM, DM, MT / 256, 4, G, c);
                pg8::EpiResid E{l == 0 ? p.in[I_XP] : nullptr, p.in[I_XS], p.out, mod + (size_t)l * 9 * 6144 + 2 * 1024}; pg8::gemm_phase(lds, g, S, E); }
            else if (s == 7 && PHM(7)) phase_norm(p, l, 1, false, G, c);
            else if (s == 8 && PHM(8)) { pg8::Gemm g{DM, DM, DM}; pg8::SchedPlain S; S.set(hm, ws + WS_WUP + l * SZ_WUP, DM, DM, MT / 256, F2 / 256, G, c); pg8::EpiStore E{(bf16_t*)(ws + WS_R1), F2, nullptr, 0}; pg8::gemm_phase(lds, g, S, E); }
            else if (s == 9 && PHM(9)) phase_convact(p, l, G, c);
            else if (PHM(10)) { pg8::Gemm g{FH, FH, FH}; pg8::SchedPlain S; S.set(ws + WS_R2, ws + WS_WD + l * SZ_WD, FH, FH, MT / 256, 4, G, c);
                pg8::EpiResid E{nullptr, nullptr, p.out, mod + (size_t)l * 9 * 6144 + 5 * 1024}; pg8::gemm_phase(lds, g, S, E);
                if (l + 1 < NLAY && G == 256 && c >= 192) { __syncthreads(); convert_layer_weights(p, lds, l + 1, 64, c - 192); }
                else if (l + 1 < NLAY && G != 256) { __syncthreads(); convert_layer_weights(p, lds, l + 1, G, c); } }
        }
        if (ph + 1 < p.hi) {
            if (ph == 0) { asm volatile("s_waitcnt vmcnt(0) lgkmcnt(0)" ::: "memory"); grid.sync();
                if (threadIdx.x < 64) { __builtin_amdgcn_fence(__ATOMIC_ACQUIRE, "agent"); asm volatile("s_waitcnt vmcnt(0)" ::: "memory"); }
                __syncthreads(); }
            else xcd_barrier(xbar); }
    }
}

constexpr int N_PHASES = 2 + NLAY * 11;

extern "C" void kernel_launch(void* const* d_in, const int* in_sizes, int n_in, void* d_out, int out_size, void* d_ws, size_t ws_size, hipStream_t stream) {
    static int grid = 0;
    if (grid == 0) {
        if (n_in != 31 || ws_size < WS_END) { fprintf(stderr, "kernel_launch: need 31 inputs and %zu bytes of workspace; got %d, %zu\n", (size_t)WS_END, n_in, ws_size); grid = -1; return; }
        int dev = 0, cus = 0, per_cu = 0;
        (void)hipGetDevice(&dev); (void)hipDeviceGetAttribute(&cus, hipDeviceAttributeMultiprocessorCount, dev);
        if (hipFuncSetAttribute((const void*)mega, hipFuncAttributeMaxDynamicSharedMemorySize, LDS_BYTES) != hipSuccess) { fprintf(stderr, "kernel_launch: hipFuncSetAttribute failed\n"); grid = -1; return; }
        if (hipOccupancyMaxActiveBlocksPerMultiprocessor(&per_cu, (const void*)mega, NTHR, LDS_BYTES) != hipSuccess || per_cu < 1) { fprintf(stderr, "kernel_launch: occupancy query failed (%d)\n", per_cu); grid = -1; return; }
        grid = cus * per_cu;
    }
    if (grid < 0) return;
    Params p{};
    for (int i = 0; i < 31; ++i) p.in[i] = (const float*)d_in[i];
    p.out = (float*)d_out; p.ws = (unsigned char*)d_ws; p.lo = 0; p.hi = N_PHASES;
    (void)hipMemsetAsync(d_ws, 0, 32768, stream);
    void* args[] = {&p};
    hipError_t e = hipLaunchCooperativeKernel((const void*)mega, dim3(grid), dim3(NTHR), args, LDS_BYTES, stream);
    if (e != hipSuccess) fprintf(stderr, "cooperative launch failed: %s (grid %d)\n", hipGetErrorString(e), grid);
}
```

```cpp
#include <hip/hip_runtime.h>
#include <hip/hip_cooperative_groups.h>
#include <cstdio>
namespace cg = cooperative_groups;

#define DI __device__ __forceinline__
#define LAS __attribute__((address_space(3)))
typedef unsigned short bf16_t;
typedef short bf16x8 __attribute__((ext_vector_type(8)));
typedef short s16x4 __attribute__((ext_vector_type(4)));
typedef float f32x4 __attribute__((ext_vector_type(4)));
typedef unsigned u32x4 __attribute__((ext_vector_type(4)));
typedef unsigned u32x2 __attribute__((ext_vector_type(2)));

constexpr int DM = 1024, MC = 4096, ML = 8192, MT = 12288, NLAY = 4;
constexpr int INC = 5728, INP = 5888, USW = 1792, F2 = 5632, FH = 2816;
constexpr float EPSV = 1e-6f;
constexpr int NTHR = 512;
constexpr int LDS_BYTES = 131072 + 256;
constexpr int US_POOL = 0, US_Q = 256, US_K = 512, US_V = 768, US_FT = 1024, US_CQ = 1280, US_CKV = 1472, US_KR = 1600;

constexpr size_t al256(size_t x) { return (x + 255) & ~(size_t)255; }
constexpr size_t WS_WIN = 32768;
constexpr size_t SZ_WIN = (size_t)INP * DM * 2;
constexpr size_t WS_WB = WS_WIN + NLAY * SZ_WIN;
constexpr size_t SZ_WB = (size_t)4096 * 256 * 2;
constexpr size_t WS_WO = WS_WB + NLAY * SZ_WB;
constexpr size_t SZ_WO = (size_t)DM * DM * 2;
constexpr size_t WS_WUP = WS_WO + NLAY * SZ_WO;
constexpr size_t SZ_WUP = (size_t)F2 * DM * 2;
constexpr size_t WS_WD = WS_WUP + NLAY * SZ_WUP;
constexpr size_t SZ_WD = (size_t)DM * FH * 2;
constexpr size_t WS_WUQ = WS_WD + NLAY * SZ_WD;
constexpr size_t SZ_SM = (size_t)512 * 256 * 2;
constexpr size_t WS_WUKV = WS_WUQ + NLAY * SZ_SM;
constexpr size_t WS_WUKVP = WS_WUKV + NLAY * SZ_SM;
constexpr size_t WS_BDFT = WS_WUKVP + NLAY * SZ_SM;
constexpr size_t WS_BDPOOL = WS_BDFT + SZ_SM;
constexpr size_t SZ_BDPOOL = (size_t)256 * 256 * 2;
constexpr size_t WS_D1024 = WS_BDPOOL + NLAY * SZ_BDPOOL;
constexpr size_t WS_D256 = WS_D1024 + (size_t)1024 * 2048 * 2;
constexpr size_t WS_MOD = WS_D256 + (size_t)256 * 512 * 2;
constexpr size_t WS_HM = al256(WS_MOD + (size_t)NLAY * 9 * 6144 * 4);
constexpr size_t SZ_HM = (size_t)MT * DM * 2;
constexpr size_t HM_QM = 0, HM_KMS = (size_t)MT * 384 * 2, HM_QD = 2 * (size_t)MT * 384 * 2;
constexpr size_t WS_R1 = WS_HM + SZ_HM;
constexpr size_t R1_SG = 0, R1_US = (size_t)MT * 4096 * 2;
constexpr size_t SZ_R1 = R1_US + (size_t)MT * USW * 2;
constexpr size_t R1_AC = 0, R1_KVRC = (size_t)NLAY * 4096 * 256 * 2;
constexpr size_t WS_R2 = WS_R1 + SZ_R1;
constexpr size_t R2_BR = 0, R2_MP = (size_t)MT * DM * 2;
constexpr size_t R2_QRAW = R2_MP, R2_KVRAW = R2_QRAW + (size_t)MT * 512 * 2, R2_ZTL = R2_KVRAW + (size_t)MT * 512 * 2,
                 R2_ZTC = R2_ZTL + (size_t)2048 * 2048 * 2, R2_POOLED = R2_ZTC + (size_t)16 * 256 * 512 * 2;
constexpr size_t SZ_R2 = R2_MP + (size_t)MT * DM * 4;
constexpr size_t WS_KDS = WS_R2 + SZ_R2;
constexpr size_t SZ_S64 = (size_t)MT * 256 * 2;
constexpr size_t WS_VDTS = WS_KDS + SZ_S64;
constexpr size_t WS_VMTS = WS_VDTS + SZ_S64;
constexpr size_t WS_KDC = WS_VMTS + SZ_S64;
constexpr size_t SZ_C64 = (size_t)NLAY * 8 * 4 * 512 * 64 * 2;
constexpr size_t WS_VDTC = WS_KDC + SZ_C64;
constexpr size_t WS_KMC = WS_VDTC + SZ_C64;
constexpr size_t WS_VMTC = WS_KMC + (size_t)NLAY * 8 * 4 * 512 * 96 * 2;
constexpr size_t WS_END = WS_VMTC + SZ_C64;
static_assert(R2_POOLED + (size_t)MT * 256 * 2 <= SZ_R2, "r2 overlay");
static_assert((size_t)MT * F2 * 2 <= SZ_R1, "u2 fits r1");
static_assert((size_t)MT * FH * 2 <= SZ_R2, "act fits r2");
static_assert(HM_QD + (size_t)MT * 256 * 2 <= SZ_HM, "hm overlay");

constexpr size_t O_X = 0, O_DK = 12582912, O_DV = 16777216, O_CKV = 20971520, O_KR = 23068672;

DI bf16_t f2bf(float f) { const __bf16 r = (__bf16)f; return __builtin_bit_cast(bf16_t, r); }
DI float bf2f(bf16_t b) { return __uint_as_float(((unsigned)b) << 16); }
DI float bflo(unsigned w) { return __uint_as_float(w << 16); }
DI float bfhi(unsigned w) { return __uint_as_float(w & 0xffff0000u); }
typedef float f32x2_ __attribute__((ext_vector_type(2)));
typedef __bf16 bf16x2_ __attribute__((ext_vector_type(2)));
DI unsigned pk2(float lo, float hi) { const f32x2_ v = {lo, hi}; const bf16x2_ r = __builtin_convertvector(v, bf16x2_); return __builtin_bit_cast(unsigned, r); }
DI unsigned cvt_pk_bf16(float lo, float hi) { return pk2(lo, hi); }
DI float wave_sum(float v) { for (int o = 32; o >= 1; o >>= 1) v += __shfl_xor(v, o); return v; }
DI int cond_row(int row) { return row < MC ? 0 : 1 + ((row - MC) >> 10); }
DI float sigmoidf_(float x) { return __builtin_amdgcn_rcpf(1.0f + __expf(-x)); }
DI void sincos_rev(float ang, float& s, float& c) { float f = ang * 0.15915494309189535f; f -= rintf(f); s = __builtin_amdgcn_sinf(f); c = __builtin_amdgcn_cosf(f); }
__device__ const float ROPE_INV[8] = {1.0f, 0.31622776601683794f, 0.1f, 0.031622776601683794f, 0.01f, 0.0031622776601683794f, 0.001f, 0.00031622776601683794f};
#define ROPE32(y, base, prow, pcol) do { _Pragma("unroll") for (int _i = 0; _i < 8; ++_i) { float _s, _c; \
    sincos_rev((prow) * ROPE_INV[_i], _s, _c); { const float _a = y[(base) + _i], _b = y[(base) + 8 + _i]; y[(base) + _i] = _a * _c - _b * _s; y[(base) + 8 + _i] = _a * _s + _b * _c; } \
    sincos_rev((pcol) * ROPE_INV[_i], _s, _c); { const float _a = y[(base) + 16 + _i], _b = y[(base) + 24 + _i]; y[(base) + 16 + _i] = _a * _c - _b * _s; y[(base) + 24 + _i] = _a * _s + _b * _c; } } } while (0)

namespace pg8 {
constexpr int BM = 256, BK = 64, HALF = 128, HTB = HALF * BK * 2, STAGE_BYTES = 8 * HTB, NXCD = 8, WGM = 4;
DI int lds_byte(int r, int c) { const int st = (r >> 4) * 2 + (c >> 5), rr = r & 15, cc = c & 31, ob = rr * 64 + cc * 2; return st * 1024 + (ob ^ (((ob >> 9) & 1) << 5)); }
DI void stage_rc(int b, int& R, int& C) { const int st = b / 1024, sb = b % 1024, swz = sb ^ (((sb >> 9) & 1) << 5); R = (st >> 1) * 16 + swz / 64; C = (st & 1) * 32 + (swz % 64) / 2; }
DI int perm32(int rho) { const int n = rho >> 4, i = rho & 15; return 8 * (i >> 2) + 4 * n + (i & 3); }
struct Unit { const char* a; const char* b; int pm, pn, z; };
struct Gemm { int lda, ldb, K; };
struct TileOrder {
    int nM, nN, nwg, G, c;
    DI void init(int nM_, int nN_, int G_, int c_) { nM = nM_; nN = nN_; nwg = nM * nN; G = G_; c = c_; }
    DI bool tile(int i, int& pm, int& pn) const {
        const long L = (long)i * G + c; if (L >= nwg) return false;
        int wgid = (int)L; { const int q = nwg / NXCD, r = nwg % NXCD, xcd = wgid % NXCD, off = wgid / NXCD; wgid = (xcd < r ? xcd * (q + 1) : r * (q + 1) + (xcd - r) * q) + off; }
        const int nig = WGM * nN, gid = wgid / nig, fm = gid * WGM, gsz = (nM - fm) < WGM ? (nM - fm) : WGM;
        pm = fm + ((wgid % nig) % gsz); pn = (wgid % nig) / gsz; return true;
    }
};
struct SchedPlain : TileOrder {
    const char* A; const char* B; size_t tA, tB, zB; int amask, zshift;
    DI void set(const void* A_, const void* B_, int lda, int ldb, int nM_, int nN_, int G_, int c_, int amask_ = -1, int zshift_ = 31, size_t zB_ = 0) {
        A = (const char*)A_; B = (const char*)B_; tA = (size_t)BM * lda * 2; tB = (size_t)BM * ldb * 2; amask = amask_; zshift = zshift_; zB = zB_; init(nM_, nN_, G_, c_); }
    DI bool next(int i, Unit& u) const { if (!tile(i, u.pm, u.pn)) return false; u.z = u.pm >> zshift;
        u.a = A + (size_t)(u.pm & amask) * tA; u.b = B + (size_t)u.z * zB + (size_t)u.pn * tB; return true; }
};
struct SchedGate : TileOrder {
    const char* A; const char* B;
    DI bool next(int i, Unit& u) const { if (!tile(i, u.pm, u.pn)) return false; u.z = u.pn >> 2;
        u.a = A + (size_t)u.pm * (BM * 1024 * 2) + u.z * 512; u.b = B + (size_t)u.pn * 256 * 512; return true; }
};
struct SchedProj : TileOrder {
    const char* A; const char* B;
    DI bool next(int i, Unit& u) const { if (!tile(i >> 2, u.pm, u.pn)) return false; const int n = i & 3; u.z = n;
        u.a = A + (size_t)u.pm * (BM * 1024 * 2) + n * 512; u.b = B + ((size_t)n * 1024 + u.pn * 256) * 512; return true; }
};

template <class Epi, class Sched>
DI void gemm_phase(LAS unsigned char* lds, const Gemm g, const Sched& S, const Epi& E) {
    int tid = threadIdx.x; asm volatile("" : "+v"(tid));
    const int wid = __builtin_amdgcn_readfirstlane(tid >> 6), lane = tid & 63, wr = wid >> 2, wc = wid & 3, fr = lane & 15, fq = lane >> 4;
    int K = g.K; asm volatile("" : "+s"(K)); const int nt = K / BK;
    unsigned voffA[2], voffB[2];
#pragma unroll
    for (int i = 0; i < 2; ++i) { int R, C; stage_rc(tid * 16 + i * 8192, R, C); const int Rb = Epi::PERM ? ((R & ~31) + perm32(R & 31)) : R;
        voffA[i] = (unsigned)(R * g.lda + C) * 2u; voffB[i] = (unsigned)(Rb * g.ldb + C) * 2u; }
    const size_t kstep = (size_t)(BK * 2);
    const size_t hstepA = (size_t)HALF * g.lda * 2, hstepB = (size_t)HALF * g.ldb * 2;
    const unsigned ldsw = (unsigned)wid * 1024u;
    const int aoff = lds_byte(wr * 64 + fr, fq * 8), boff = lds_byte(wc * 32 + fr, fq * 8);
#define PG8_SA(b, h) (((b) * 2 + (h)) * HTB)
#define PG8_SB(b, h) ((4 + (b) * 2 + (h)) * HTB)
#define PG8_STAGE(bufoff, gbase, voff) do { _Pragma("unroll") for (int _i = 0; _i < 2; ++_i) \
        __builtin_amdgcn_global_load_lds((const unsigned*)((const char*)(gbase) + (voff)[_i]), (LAS unsigned*)(lds + (bufoff) + ldsw + _i * 8192), 16, 0, 0); } while (0)
#define PG8_LDA(dst, b, h) do { _Pragma("unroll") for (int m = 0; m < 4; ++m) _Pragma("unroll") for (int k = 0; k < 2; ++k) dst[m][k] = *(const LAS bf16x8*)(lds + PG8_SA(b, h) + aoff + m * 2048 + k * 1024); } while (0)
#define PG8_LDB(dst, b, h) do { _Pragma("unroll") for (int n = 0; n < 2; ++n) _Pragma("unroll") for (int k = 0; k < 2; ++k) dst[n][k] = *(const LAS bf16x8*)(lds + PG8_SB(b, h) + boff + n * 2048 + k * 1024); } while (0)
#define PG8_MMA(ai, bj, At, Bt) do { __builtin_amdgcn_s_setprio(1); _Pragma("unroll") for (int m = 0; m < 4; ++m) _Pragma("unroll") for (int n = 0; n < 2; ++n) _Pragma("unroll") for (int k = 0; k < 2; ++k) \
        acc[ai][bj][m][n] = __builtin_amdgcn_mfma_f32_16x16x32_bf16(Bt[n][k], At[m][k], acc[ai][bj][m][n], 0, 0, 0); __builtin_amdgcn_s_setprio(0); } while (0)
#define PG8_WAIT_V(n) asm volatile("s_waitcnt vmcnt(" #n ")" ::: "memory")
#define PG8_WAIT_L(n) asm volatile("s_waitcnt lgkmcnt(" #n ")" ::: "memory")
#define PG8_BAR __builtin_amdgcn_s_barrier()
#define PG8_SCHED __builtin_amdgcn_sched_barrier(0)
    Unit cur, nxt; int ui = 0;
    if (!S.next(0, cur)) return;
    f32x4 acc[2][2][4][2];
#pragma unroll
    for (int a = 0; a < 2; ++a)
#pragma unroll
        for (int b = 0; b < 2; ++b)
#pragma unroll
            for (int m = 0; m < 4; ++m)
#pragma unroll
                for (int n = 0; n < 2; ++n) acc[a][b][m][n] = (f32x4){0.f, 0.f, 0.f, 0.f};
    bf16x8 At[4][2], B0[2][2], B1[2][2];
    const char* cA = cur.a; const char* cB = cur.b;
    PG8_STAGE(PG8_SB(0, 0), cB, voffB); PG8_STAGE(PG8_SA(0, 0), cA, voffA); PG8_STAGE(PG8_SB(0, 1), cB + hstepB, voffB); PG8_STAGE(PG8_SA(0, 1), cA + hstepA, voffA);
    if (wr == 1) PG8_BAR;
    PG8_WAIT_V(4); PG8_BAR;
    PG8_STAGE(PG8_SB(1, 0), cB + kstep, voffB); PG8_STAGE(PG8_SA(1, 0), cA + kstep, voffA); PG8_STAGE(PG8_SB(1, 1), cB + hstepB + kstep, voffB);
    PG8_WAIT_V(6); PG8_BAR;
    for (;;) {
        const bool has_next = S.next(ui + 1, nxt);
        const char* nA = has_next ? nxt.a : cA; const char* nB = has_next ? nxt.b : cB;
#pragma unroll 1
        for (int t = 0; t < nt; t += 2) {
            const bool last = (t == nt - 2);
            const char* a1 = cA + (size_t)(t + 1) * kstep;
            const char* a2 = last ? nA : cA + (size_t)(t + 2) * kstep; const char* b2 = last ? nB : cB + (size_t)(t + 2) * kstep;
            const char* a3 = a2 + kstep; const char* b3 = b2 + kstep;
            PG8_LDB(B0, 0, 0); PG8_SCHED; PG8_LDA(At, 0, 0); PG8_STAGE(PG8_SA(1, 1), a1 + hstepA, voffA);
            PG8_WAIT_L(8); PG8_BAR; PG8_WAIT_L(0); PG8_MMA(0, 0, At, B0); PG8_BAR; PG8_SCHED;
            PG8_LDB(B1, 0, 1); PG8_STAGE(PG8_SB(0, 0), b2, voffB);
            PG8_BAR; PG8_WAIT_L(0); PG8_MMA(0, 1, At, B1); PG8_BAR;
            PG8_LDA(At, 0, 1); PG8_STAGE(PG8_SA(0, 0), a2, voffA);
            PG8_BAR; PG8_WAIT_L(0); PG8_MMA(1, 0, At, B0); PG8_BAR; PG8_SCHED;
            PG8_STAGE(PG8_SB(0, 1), b2 + hstepB, voffB);
            PG8_WAIT_V(6); PG8_BAR; PG8_MMA(1, 1, At, B1); PG8_BAR;
            PG8_LDB(B0, 1, 0); PG8_SCHED; PG8_LDA(At, 1, 0); PG8_STAGE(PG8_SA(0, 1), a2 + hstepA, voffA);
            PG8_WAIT_L(8); PG8_BAR; PG8_WAIT_L(0); PG8_MMA(0, 0, At, B0); PG8_BAR; PG8_SCHED;
            PG8_LDB(B1, 1, 1); PG8_STAGE(PG8_SB(1, 0), b3, voffB);
            PG8_BAR; PG8_WAIT_L(0); PG8_MMA(0, 1, At, B1); PG8_BAR;
            PG8_LDA(At, 1, 1); PG8_STAGE(PG8_SA(1, 0), a3, voffA);
            PG8_BAR; PG8_WAIT_L(0); PG8_MMA(1, 0, At, B0); PG8_BAR; PG8_SCHED;
            PG8_STAGE(PG8_SB(1, 1), b3 + hstepB, voffB);
            PG8_WAIT_V(6); PG8_BAR; PG8_MMA(1, 1, At, B1); PG8_BAR;
        }
        { int fr_ = fr, fq_ = fq; asm volatile("" : "+v"(fr_), "+v"(fq_)); E(acc, cur, wr, wc, fr_, fq_); }
        if (!has_next) break;
#pragma unroll
        for (int a = 0; a < 2; ++a)
#pragma unroll
            for (int b = 0; b < 2; ++b)
#pragma unroll
                for (int m = 0; m < 4; ++m)
#pragma unroll
                    for (int n = 0; n < 2; ++n) acc[a][b][m][n] = (f32x4){0.f, 0.f, 0.f, 0.f};
        cur = nxt; cA = nA; cB = nB; ++ui;
    }
    PG8_WAIT_V(0);
    if (wr == 0) PG8_BAR;
    PG8_BAR;
#undef PG8_SA
#undef PG8_SB
#undef PG8_STAGE
#undef PG8_LDA
#undef PG8_LDB
#undef PG8_MMA
#undef PG8_WAIT_V
#undef PG8_WAIT_L
#undef PG8_BAR
#undef PG8_SCHED
}

typedef const f32x4 (&AccRef)[2][2][4][2];
#define EPI_PERM_LOOP(...) _Pragma("unroll") for (int ai = 0; ai < 2; ++ai) _Pragma("unroll") for (int m = 0; m < 4; ++m) { const int lr = ai * 128 + wr * 64 + m * 16 + fr; \
    _Pragma("unroll") for (int bj = 0; bj < 2; ++bj) { const int lc = bj * 128 + wc * 32 + 8 * fq; f32x4 v0 = acc[ai][bj][m][0], v1 = acc[ai][bj][m][1]; __VA_ARGS__ } }
#define EPI_PACK(w, v0, v1) u32x4 w; w.x = cvt_pk_bf16(v0[0], v0[1]); w.y = cvt_pk_bf16(v0[2], v0[3]); w.z = cvt_pk_bf16(v1[0], v1[1]); w.w = cvt_pk_bf16(v1[2], v1[3]);

struct EpiIn {
    static constexpr bool PERM = true;
    bf16_t* sg; bf16_t* us;
    DI void operator()(AccRef acc, const Unit& u, int wr, int wc, int fr, int fq) const {
        const int row0 = u.pm * BM;
        if (u.pn < 16) { bf16_t* base = sg + (size_t)row0 * 4096 + u.pn * BM;
            EPI_PERM_LOOP({ _Pragma("unroll") for (int j = 0; j < 4; ++j) { v0[j] = sigmoidf_(v0[j]); v1[j] = sigmoidf_(v1[j]); } u32x4 w; w.x = pk2(v0[0], v0[1]); w.y = pk2(v0[2], v0[3]); w.z = pk2(v1[0], v1[1]); w.w = pk2(v1[2], v1[3]); __builtin_nontemporal_store(w, (u32x4*)(base + (size_t)lr * 4096 + lc)); }) }
        else { bf16_t* base = us + (size_t)row0 * USW + (u.pn - 16) * BM;
            EPI_PERM_LOOP({ EPI_PACK(w, v0, v1); *(u32x4*)(base + (size_t)lr * USW + lc) = w; }) }
    }
};
struct EpiStore {
    static constexpr bool PERM = true;
    bf16_t* O; int ldc; const float* cscale; int mode;
    DI void operator()(AccRef acc, const Unit& u, int wr, int wc, int fr, int fq) const {
        size_t rb, cb;
        if (mode == 0) { rb = (size_t)u.pm * BM; cb = (size_t)u.pn * BM; }
        else if (mode == 1) { rb = (size_t)MC + u.pn * 1024 + u.pm * BM; cb = 512; }
        else { rb = (size_t)u.pm * BM; cb = 512; }
        bf16_t* base = O + rb * ldc + cb;
        if (cscale) { const float* cs = cscale + u.pn * BM;
            EPI_PERM_LOOP({ const f32x4 s0 = *(const f32x4*)(cs + lc), s1 = *(const f32x4*)(cs + lc + 4); v0 = v0 * s0; v1 = v1 * s1; EPI_PACK(w, v0, v1); *(u32x4*)(base + (size_t)lr * ldc + lc) = w; }) }
        else { EPI_PERM_LOOP({ EPI_PACK(w, v0, v1); *(u32x4*)(base + (size_t)lr * ldc + lc) = w; }) }
    }
};
struct EpiZt {
    static constexpr bool PERM = false;
    bf16_t* ztl; bf16_t* ztc;
    DI void operator()(AccRef acc, const Unit& u, int wr, int wc, int fr, int fq) const {
        const int row0 = u.pm * BM; bf16_t* base; int T, t0;
        if (row0 < MC) { T = 256; t0 = 0; base = ztc + (size_t)(row0 >> 8) * 256 * 512; } else { const int rr = row0 - MC; T = 1024; t0 = rr & 1023; base = ztl + (size_t)(rr >> 10) * 256 * 2048; }
        const int ldz = 2 * T;
#pragma unroll
        for (int ai = 0; ai < 2; ++ai)
#pragma unroll
            for (int m = 0; m < 4; ++m) { const int t = t0 + ai * 128 + wr * 64 + m * 16 + fr;
#pragma unroll
                for (int bj = 0; bj < 2; ++bj)
#pragma unroll
                    for (int n = 0; n < 2; ++n) { const int j = u.pn * BM + bj * 128 + wc * 32 + n * 16 + 4 * fq; const int g = j >> 7, hf = (j >> 6) & 1, cp = j & 63;
                        bf16_t* d = base + (size_t)(g * 64 + cp) * ldz + hf * T + t; const f32x4 v = acc[ai][bj][m][n];
                        d[0] = f2bf(v[0]); d[ldz] = f2bf(v[1]); d[2 * ldz] = f2bf(v[2]); d[3 * ldz] = f2bf(v[3]); } }
    }
};
struct EpiProj {
    static constexpr bool PERM = true;
    const bf16_t* sg; float* mp; bf16_t* mg;
    DI void operator()(AccRef acc, const Unit& u, int wr, int wc, int fr, int fq) const {
        const int n = u.z; const size_t row0 = (size_t)u.pm * BM; const int col0 = u.pn * BM;
        const bf16_t* sgb = sg + row0 * 4096 + n * 1024 + col0; float* mpb = mp + row0 * DM + col0; bf16_t* mgb = mg + row0 * DM + col0;
        EPI_PERM_LOOP({ const u32x4 gw = *(const u32x4*)(sgb + (size_t)lr * 4096 + lc);
            v0[0] *= bflo(gw.x); v0[1] *= bfhi(gw.x); v0[2] *= bflo(gw.y); v0[3] *= bfhi(gw.y); v1[0] *= bflo(gw.z); v1[1] *= bfhi(gw.z); v1[2] *= bflo(gw.w); v1[3] *= bfhi(gw.w);
            float* p = mpb + (size_t)lr * DM + lc;
            if (n > 0) { v0 = v0 + *(const f32x4*)p; v1 = v1 + *(const f32x4*)(p + 4); }
            if (n < 3) { *(f32x4*)p = v0; *(f32x4*)(p + 4) = v1; }
            else { EPI_PACK(w, v0, v1); *(u32x4*)(mgb + (size_t)lr * DM + lc) = w; } })
    }
};
struct EpiGate {
    static constexpr bool PERM = true;
    bf16_t* sg;
    DI void operator()(AccRef acc, const Unit& u, int wr, int wc, int fr, int fq) const {
        bf16_t* base = sg + (size_t)u.pm * BM * 4096 + u.pn * BM;
        EPI_PERM_LOOP({ bf16_t* p = base + (size_t)lr * 4096 + lc; const u32x4 gw = *(const u32x4*)p;
            v0[0] *= bflo(gw.x); v0[1] *= bfhi(gw.x); v0[2] *= bflo(gw.y); v0[3] *= bfhi(gw.y); v1[0] *= bflo(gw.z); v1[1] *= bfhi(gw.z); v1[2] *= bflo(gw.w); v1[3] *= bfhi(gw.w);
            EPI_PACK(w, v0, v1); *(u32x4*)p = w; })
    }
};
struct EpiResid {
    static constexpr bool PERM = false;
    const float* xp; const float* xs; float* out; const float* gate;
    DI void operator()(AccRef acc, const Unit& u, int wr, int wc, int fr, int fq) const {
        const int row0 = u.pm * BM; const float* bs = xp ? (row0 < MC ? xp + (size_t)row0 * DM : xs + (size_t)(row0 - MC) * DM) : out + (size_t)row0 * DM;
        float* ob = out + (size_t)row0 * DM; const float* gp = gate + (size_t)cond_row(row0) * 6144;
#pragma unroll
        for (int bj = 0; bj < 2; ++bj)
#pragma unroll
            for (int n = 0; n < 2; ++n) { const int col = u.pn * BM + bj * 128 + wc * 32 + n * 16 + 4 * fq; const f32x4 gv = *(const f32x4*)(gp + col);
#pragma unroll
                for (int ai = 0; ai < 2; ++ai)
#pragma unroll
                    for (int m = 0; m < 4; ++m) { const size_t off = (size_t)(ai * 128 + wr * 64 + m * 16 + fr) * DM + col;
                        const f32x4 b = *(const f32x4*)(bs + off); *(f32x4*)(ob + off) = b + gv * acc[ai][bj][m][n]; } }
    }
};
}

struct Params {
    const float* in[31];
    float* out; unsigned char* ws;
    int lo, hi;
};
enum { I_XP = 0, I_XS, I_C, I_CCTX, I_CDK, I_CDV, I_CCKV, I_CKR, I_WADA, I_BADA, I_GN1, I_GN2, I_WIN, I_POOLW, I_POOLS, I_DQN, I_DKN, I_DLAM, I_DSUB,
       I_QAN, I_WUQ, I_KVN, I_WUKV, I_MQN, I_MKN, I_WBR, I_WOUT, I_WUP, I_CONVW, I_CONVB, I_WDOWN };

DI void tr_load(const float* src, int R, int C, int tile, int tid, f32x4 (&v)[8]) {
    const int ntk = R / 64, tk = tile % ntk, tn = tile / ntk, k0 = tk * 64, n0 = tn * 256;
#pragma unroll
    for (int i = 0; i < 8; ++i) { const int k = (tid >> 6) + 8 * i, n = n0 + (tid & 63) * 4; v[i] = (f32x4){0.f, 0.f, 0.f, 0.f};
        if (n < C) v[i] = *(const f32x4*)(src + (size_t)(k0 + k) * C + n); }
}
DI void tr_store(LAS unsigned char* lds, bf16_t* dst, int R, int tile, int tid, const f32x4 (&v)[8]) {
    LAS float* T = (LAS float*)lds;
    const int ntk = R / 64, tk = tile % ntk, tn = tile / ntk, k0 = tk * 64, n0 = tn * 256;
    __syncthreads();
#pragma unroll
    for (int i = 0; i < 8; ++i) { const int k = (tid >> 6) + 8 * i; LAS float* t = T + k * 257 + (tid & 63) * 4; t[0] = v[i][0]; t[1] = v[i][1]; t[2] = v[i][2]; t[3] = v[i][3]; }
    __syncthreads();
#pragma unroll
    for (int j = 0; j < 4; ++j) { const int n = (tid >> 3) + 64 * j, kc = (tid & 7) * 8; u32x4 w;
        w.x = pk2(T[(kc + 0) * 257 + n], T[(kc + 1) * 257 + n]); w.y = pk2(T[(kc + 2) * 257 + n], T[(kc + 3) * 257 + n]);
        w.z = pk2(T[(kc + 4) * 257 + n], T[(kc + 5) * 257 + n]); w.w = pk2(T[(kc + 6) * 257 + n], T[(kc + 7) * 257 + n]);
        *(u32x4*)(dst + (size_t)(n0 + n) * R + k0 + kc) = w; }
}
DI void tr_job(LAS unsigned char* lds, const float* src, bf16_t* dst, int R, int C, int Cpad, int& base, int G, int c) {
    const int nt = (R / 64) * (Cpad / 256); int tid = threadIdx.x; asm volatile("" : "+v"(tid));
    int t = (c + G - (base % G)) % G; base += nt;
    if (t >= nt) return;
    f32x4 nx[8]; tr_load(src, R, C, t, tid, nx);
    for (; t < nt; t += G) {
        f32x4 cur[8];
#pragma unroll
        for (int i = 0; i < 8; ++i) cur[i] = nx[i];
        if (t + G < nt) tr_load(src, R, C, t + G, tid, nx);
        tr_store(lds, dst, R, t, tid, cur);
    }
}

DI void convert_layer_weights(const Params& p, LAS unsigned char* lds, int l, int G, int c) {
    unsigned char* ws = p.ws; int base = 0;
    tr_job(lds, p.in[I_WIN] + (size_t)l * DM * INC, (bf16_t*)(ws + WS_WIN + l * SZ_WIN), DM, INC, INP, base, G, c);
    tr_job(lds, p.in[I_WUP] + (size_t)l * DM * F2, (bf16_t*)(ws + WS_WUP + l * SZ_WUP), DM, F2, F2, base, G, c);
    tr_job(lds, p.in[I_WDOWN] + (size_t)l * FH * DM, (bf16_t*)(ws + WS_WD + l * SZ_WD), FH, DM, DM, base, G, c);
    tr_job(lds, p.in[I_WOUT] + (size_t)l * DM * DM, (bf16_t*)(ws + WS_WO + l * SZ_WO), DM, DM, DM, base, G, c);
    for (int n = 0; n < 4; ++n)
        tr_job(lds, p.in[I_WBR] + ((size_t)l * 4 + n) * 256 * DM, (bf16_t*)(ws + WS_WB + l * SZ_WB) + (size_t)n * 1024 * 256, 256, DM, DM, base, G, c);
    __syncthreads();
}

DI void phase_prepass(const Params& p, LAS unsigned char* lds, int G, int c) {
    unsigned char* ws = p.ws; int tid = threadIdx.x; asm volatile("" : "+v"(tid));
    convert_layer_weights(p, lds, 0, G, c);
    {
        LAS float* sc = (LAS float*)lds;
        for (int i = tid; i < 9 * 1024; i += NTHR) { const int r = i >> 10, k = i & 1023; const float v = r == 0 ? p.in[I_CCTX][k] : p.in[I_C][(r - 1) * 1024 + k]; sc[i] = v * sigmoidf_(v); }
        __syncthreads();
        LAS float* red = (LAS float*)(lds + 9 * 1024 * 4);
        float* mod = (float*)(ws + WS_MOD);
        for (int it = c; it < 192; it += G) {
            const int l = it / 48, col = (it % 48) * 128 + (tid & 127), kq = tid >> 7;
            const float* w = p.in[I_WADA] + (size_t)l * DM * 6144 + col;
            float a[9];
#pragma unroll
            for (int r = 0; r < 9; ++r) a[r] = 0.f;
#pragma unroll 8
            for (int k = kq * 256; k < kq * 256 + 256; ++k) { const float wv = w[(size_t)k * 6144];
#pragma unroll
                for (int r = 0; r < 9; ++r) a[r] += sc[r * 1024 + k] * wv; }
            __syncthreads();
#pragma unroll
            for (int r = 0; r < 9; ++r) red[(kq * 9 + r) * 128 + (tid & 127)] = a[r];
            __syncthreads();
            for (int i = tid; i < 9 * 128; i += NTHR) { const int r = i >> 7, cc = i & 127, colo = (it % 48) * 128 + cc;
                mod[((size_t)l * 9 + r) * 6144 + colo] = red[(0 * 9 + r) * 128 + cc] + red[(1 * 9 + r) * 128 + cc] + red[(2 * 9 + r) * 128 + cc] + red[(3 * 9 + r) * 128 + cc] + p.in[I_BADA][l * 6144 + colo]; }
        }
        __syncthreads();
    }
    const size_t gt = (size_t)c * NTHR + tid, gs = (size_t)G * NTHR;
    for (size_t i = gt; i < (size_t)NLAY * 512 * 256; i += gs) {
        const int l = (int)(i >> 17), n = (int)(i >> 8) & 511, k = (int)i & 255;
        { const int h = n >> 7, d = n & 127; float v = 0.f; if (d < 96 && k < 192) v = p.in[I_WUQ][((size_t)l * 192 + k) * 384 + h * 96 + d] * p.in[I_QAN][l * 192 + k];
          ((bf16_t*)(ws + WS_WUQ))[i] = f2bf(v); }
        { float v = 0.f, vp = 0.f; if (k < 128) { vp = p.in[I_WUKV][((size_t)l * 128 + k) * 512 + n]; v = vp * p.in[I_KVN][l * 128 + k]; }
          ((bf16_t*)(ws + WS_WUKV))[i] = f2bf(v); ((bf16_t*)(ws + WS_WUKVP))[i] = f2bf(vp); }
    }
    for (size_t i = gt; i < (size_t)512 * 256; i += gs) {
        const int j = (int)(i >> 8), k = (int)i & 255, g = j >> 7, hf = (j >> 6) & 1, cp = j & 63, g2 = k >> 6, cc = k & 63; float v = 0.f;
        if (g == g2) { const int m = (cp * cc) & 63; const float a = (float)m * (1.0f / 32.0f); v = (hf ? -sinpif(a) : cospif(a)) * 0.125f; }
        ((bf16_t*)(ws + WS_BDFT))[i] = f2bf(v);
    }
    for (size_t i = gt; i < (size_t)NLAY * 256 * 256; i += gs) {
        const int l = (int)(i >> 16), e = (int)(i >> 8) & 255, k = (int)i & 255; float v = 0.f;
        if ((e >> 6) == (k >> 6)) v = p.in[I_POOLW][(((size_t)l * 4 + (e >> 6)) * 64 + (k & 63)) * 64 + (e & 63)];
        ((bf16_t*)(ws + WS_BDPOOL))[i] = f2bf(v);
    }
    for (size_t i = gt; i < (size_t)1024 * 2048; i += gs) {
        const int kt = (int)(i >> 11), t = (int)i & 2047, tt = t & 1023; const int m = (kt * tt) & 1023; const float a = (float)m * (1.0f / 512.0f);
        ((bf16_t*)(ws + WS_D1024))[i] = f2bf((t < 1024 ? cospif(a) : sinpif(a)) * (1.0f / 32.0f));
    }
    for (size_t i = gt; i < (size_t)256 * 512; i += gs) {
        const int kt = (int)(i >> 9), t = (int)i & 511, tt = t & 255; const int m = (kt * tt) & 255; const float a = (float)m * (1.0f / 128.0f);
        ((bf16_t*)(ws + WS_D256))[i] = f2bf((t < 256 ? cospif(a) : sinpif(a)) * (1.0f / 16.0f));
    }
    for (size_t i = gt; i < (size_t)NLAY * 8 * 4 * 512 * 64; i += gs) {
        const int d = (int)i & 63, key = (int)(i >> 6) & 511, h = (int)(i >> 15) & 3, b = (int)(i >> 17) & 7, l = (int)(i >> 20);
        ((bf16_t*)(ws + WS_KDC))[i] = f2bf(p.in[I_CDK][((((size_t)b * 4 + l) * 512 + key) * 4 + h) * 64 + d]);
    }
    for (size_t i = gt; i < (size_t)NLAY * 8 * 4 * 64 * 512; i += gs) {
        const int key = (int)i & 511, dv = (int)(i >> 9) & 63, h = (int)(i >> 15) & 3, b = (int)(i >> 17) & 7, l = (int)(i >> 20);
        ((bf16_t*)(ws + WS_VDTC))[i] = f2bf(p.in[I_CDV][((((size_t)b * 4 + l) * 512 + key) * 4 + h) * 64 + dv]);
    }
    for (size_t i = gt; i < (size_t)NLAY * 4096 * 256; i += gs) {
        const int k = (int)i & 255, key = (int)(i >> 8) & 511, b = (int)(i >> 17) & 7, l = (int)(i >> 20);
        ((bf16_t*)(ws + WS_R1 + R1_AC))[i] = k < 128 ? f2bf(p.in[I_CCKV][(((size_t)b * 4 + l) * 512 + key) * 128 + k]) : (bf16_t)0;
    }
}

DI void phase_norm(const Params& p, int l, int which, bool from_input, int G, int c) {
    int tid_ = threadIdx.x; asm volatile("" : "+v"(tid_)); const int lane = tid_ & 63, wid = tid_ >> 6;
    const float* gn = p.in[which ? I_GN2 : I_GN1] + l * DM; const float* mod = (const float*)(p.ws + WS_MOD) + (size_t)l * 9 * 6144 + which * 3072;
    bf16_t* h = (bf16_t*)(p.ws + WS_HM);
    for (int rowa = c * 8 + wid; rowa < MT; rowa += 2 * G * 8) {
        const int rowb = rowa + G * 8; const bool hb = rowb < MT;
        const float* xa = from_input ? (rowa < MC ? p.in[I_XP] + (size_t)rowa * DM : p.in[I_XS] + (size_t)(rowa - MC) * DM) : p.out + (size_t)rowa * DM;
        const int rb = hb ? rowb : rowa;
        const float* xb = from_input ? (rb < MC ? p.in[I_XP] + (size_t)rb * DM : p.in[I_XS] + (size_t)(rb - MC) * DM) : p.out + (size_t)rb * DM;
        f32x4 va[4], vb[4]; float sa = 0.f, sb2 = 0.f;
#pragma unroll
        for (int i = 0; i < 4; ++i) { va[i] = *(const f32x4*)(xa + i * 256 + lane * 4); vb[i] = *(const f32x4*)(xb + i * 256 + lane * 4); }
#pragma unroll
        for (int i = 0; i < 4; ++i) { sa += va[i][0] * va[i][0] + va[i][1] * va[i][1] + va[i][2] * va[i][2] + va[i][3] * va[i][3]; sb2 += vb[i][0] * vb[i][0] + vb[i][1] * vb[i][1] + vb[i][2] * vb[i][2] + vb[i][3] * vb[i][3]; }
        for (int o = 32; o >= 1; o >>= 1) { sa += __shfl_xor(sa, o); sb2 += __shfl_xor(sb2, o); }
        const float rsa = rsqrtf(sa * (1.0f / DM) + EPSV), rsb = rsqrtf(sb2 * (1.0f / DM) + EPSV);
        const float* mra = mod + (size_t)cond_row(rowa) * 6144; const float* mrb = mod + (size_t)cond_row(rb) * 6144;
#pragma unroll
        for (int i = 0; i < 4; ++i) { const int col = i * 256 + lane * 4; const f32x4 g = *(const f32x4*)(gn + col);
            { const f32x4 sh = *(const f32x4*)(mra + col), sc = *(const f32x4*)(mra + 1024 + col); const f32x4 o = va[i] * rsa * g * (sc + 1.0f) + sh; u32x2 w; w.x = pk2(o[0], o[1]); w.y = pk2(o[2], o[3]); *(u32x2*)(h + (size_t)rowa * DM + col) = w; }
            if (hb) { const f32x4 sh = *(const f32x4*)(mrb + col), sc = *(const f32x4*)(mrb + 1024 + col); const f32x4 o = vb[i] * rsb * g * (sc + 1.0f) + sh; u32x2 w; w.x = pk2(o[0], o[1]); w.y = pk2(o[2], o[3]); *(u32x2*)(h + (size_t)rowb * DM + col) = w; } }
    }
}

DI void phase_c1_rows(const Params& p, LAS unsigned char* lds, int l, int G, int c) {
    int tid = threadIdx.x; asm volatile("" : "+v"(tid)); unsigned char* ws = p.ws;
    const bf16_t* us = (const bf16_t*)(ws + WS_R1 + R1_US);
    bf16_t* Qd = (bf16_t*)(ws + WS_HM + HM_QD); bf16_t* Kds = (bf16_t*)(ws + WS_KDS); bf16_t* VdTs = (bf16_t*)(ws + WS_VDTS); bf16_t* pooled = (bf16_t*)(ws + WS_R2 + R2_POOLED);
    const float* qn = p.in[I_DQN] + l * 32; const float* kn = p.in[I_DKN] + l * 32;
    LAS bf16_t* VT = (LAS bf16_t*)lds;
    LAS bf16_t* PT = (LAS bf16_t*)(lds + 64 * 264 * 2);
    for (int it = G - 1 - c; it < MT / 64; it += G) {
        const int r0 = it * 64; const bool lat = r0 >= MC; const int T = lat ? 1024 : 256, t0 = lat ? ((r0 - MC) & 1023) : (r0 & 255), sb = r0 - t0;
        __syncthreads();
        for (int q = tid; q < 64 * 32; q += NTHR) { const int t = q >> 5, ch = q & 31; *(LAS u32x4*)(VT + t * 264 + ch * 8) = *(const u32x4*)(us + (size_t)(r0 + t) * USW + US_V + ch * 8); }
        for (int q = tid; q < 80 * 32; q += NTHR) { const int tr = q >> 5, ch = q & 31, t = t0 - 8 + tr; u32x4 v = (u32x4){0u, 0u, 0u, 0u};
            if (t >= 0 && t < T) v = *(const u32x4*)(us + (size_t)(sb + t) * USW + US_POOL + ch * 8); *(LAS u32x4*)(PT + tr * 264 + ch * 8) = v; }
#pragma unroll
        for (int j = 0; j < 2; ++j) {
            const int vid = tid + NTHR * j, tl = vid >> 4, w = vid & 15, row = r0 + tl, t = t0 + tl; const bool isk = w >= 8; const int h = (w & 7) >> 1, hf = w & 1;
            const bf16_t* src = us + (size_t)row * USW + US_Q + w * 32;
            float y[32]; float ss = 0.f;
#pragma unroll
            for (int q = 0; q < 4; ++q) { const u32x4 v = *(const u32x4*)(src + q * 8);
                y[q * 8 + 0] = bflo(v.x); y[q * 8 + 1] = bfhi(v.x); y[q * 8 + 2] = bflo(v.y); y[q * 8 + 3] = bfhi(v.y); y[q * 8 + 4] = bflo(v.z); y[q * 8 + 5] = bfhi(v.z); y[q * 8 + 6] = bflo(v.w); y[q * 8 + 7] = bfhi(v.w); }
#pragma unroll
            for (int d = 0; d < 32; ++d) ss += y[d] * y[d];
            const float rs = rsqrtf(ss * (1.0f / 32.0f) + EPSV); const float* gnp = isk ? kn : qn;
#pragma unroll
            for (int d = 0; d < 32; ++d) y[d] = y[d] * rs * gnp[d];
            if (isk && !lat) { float* o = p.out + O_DK + ((size_t)((r0 >> 8) * 4 + l) * 256 + t) * 256 + h * 64 + hf * 32;
#pragma unroll
                for (int q = 0; q < 8; ++q) *(f32x4*)(o + q * 4) = (f32x4){y[q * 4], y[q * 4 + 1], y[q * 4 + 2], y[q * 4 + 3]}; }
            if (lat) { const float prow = (float)(t >> 6), pcol = (float)(t & 63); ROPE32(y, 0, prow, pcol); }
            bf16_t* dst = isk ? Kds + (size_t)sb * 256 + ((size_t)h * T + t) * 64 + hf * 32 : Qd + (size_t)row * 256 + h * 64 + hf * 32;
#pragma unroll
            for (int q = 0; q < 4; ++q) { u32x4 wv; wv.x = pk2(y[q * 8], y[q * 8 + 1]); wv.y = pk2(y[q * 8 + 2], y[q * 8 + 3]); wv.z = pk2(y[q * 8 + 4], y[q * 8 + 5]); wv.w = pk2(y[q * 8 + 6], y[q * 8 + 7]); *(u32x4*)(dst + q * 8) = wv; }
        }
        __syncthreads();
        if (!lat) { float* o = p.out + O_DV + ((size_t)((r0 >> 8) * 4 + l) * 256 + t0) * 256;
            for (int q = tid; q < 64 * 256; q += NTHR) o[q] = bf2f(VT[(q >> 8) * 264 + (q & 255)]); }
        { const int cidx = tid & 255, th = tid >> 8; bf16_t* dst = VdTs + (size_t)sb * 256 + ((size_t)(cidx >> 6) * 64 + (cidx & 63)) * T + t0 + th * 32;
#pragma unroll
          for (int q = 0; q < 4; ++q) { u32x4 wv; const LAS bf16_t* s = VT + (th * 32 + q * 8) * 264 + cidx;
              wv.x = (unsigned)s[0] | ((unsigned)s[264] << 16); wv.y = (unsigned)s[2 * 264] | ((unsigned)s[3 * 264] << 16); wv.z = (unsigned)s[4 * 264] | ((unsigned)s[5 * 264] << 16); wv.w = (unsigned)s[6 * 264] | ((unsigned)s[7 * 264] << 16);
              *(u32x4*)(dst + q * 8) = wv; } }
        { const int cidx = tid & 255, th = tid >> 8, hw = 1 << (cidx >> 6);
          const int tf = t0 + th * 32; float s = 0.f;
          { const int lo = max(tf - hw, 0), hi = min(tf + hw, T); for (int tt = lo; tt < hi; ++tt) s += bf2f(PT[(tt - t0 + 8) * 264 + cidx]); }
          for (int q = 0; q < 32; ++q) { const int tl = th * 32 + q, t = t0 + tl; const int lo = max(t - hw, 0), hi = min(t + hw, T);
              const float v = s * __builtin_amdgcn_rcpf((float)(hi - lo)) - bf2f(PT[(tl + 8) * 264 + cidx]); pooled[(size_t)(r0 + tl) * 256 + cidx] = f2bf(v);
              if (t + hw < T) s += bf2f(PT[(t + hw - t0 + 8) * 264 + cidx]);
              if (t - hw >= 0) s -= bf2f(PT[(t - hw - t0 + 8) * 264 + cidx]); } }
    }
    __syncthreads();
}

DI float sumsq8(const u32x4 v) { const float a0 = bflo(v.x), a1 = bfhi(v.x), a2 = bflo(v.y), a3 = bfhi(v.y), a4 = bflo(v.z), a5 = bfhi(v.z), a6 = bflo(v.w), a7 = bfhi(v.w);
    return a0 * a0 + a1 * a1 + a2 * a2 + a3 * a3 + a4 * a4 + a5 * a5 + a6 * a6 + a7 * a7; }
DI u32x4 scale8(const u32x4 v, float sc, const float* g) { const f32x4 g0 = *(const f32x4*)g, g1 = *(const f32x4*)(g + 4); u32x4 w;
    w.x = pk2(bflo(v.x) * sc * g0[0], bfhi(v.x) * sc * g0[1]); w.y = pk2(bflo(v.y) * sc * g0[2], bfhi(v.y) * sc * g0[3]);
    w.z = pk2(bflo(v.z) * sc * g1[0], bfhi(v.z) * sc * g1[1]); w.w = pk2(bflo(v.w) * sc * g1[2], bfhi(v.w) * sc * g1[3]); return w; }
DI u32x4 scale8n(const u32x4 v, float sc) { u32x4 w; w.x = pk2(bflo(v.x) * sc, bfhi(v.x) * sc); w.y = pk2(bflo(v.y) * sc, bfhi(v.y) * sc); w.z = pk2(bflo(v.z) * sc, bfhi(v.z) * sc); w.w = pk2(bflo(v.w) * sc, bfhi(v.w) * sc); return w; }
#define UNPK8(y, o, v) do { y[(o) + 0] = bflo(v.x); y[(o) + 1] = bfhi(v.x); y[(o) + 2] = bflo(v.y); y[(o) + 3] = bfhi(v.y); y[(o) + 4] = bflo(v.z); y[(o) + 5] = bfhi(v.z); y[(o) + 6] = bflo(v.w); y[(o) + 7] = bfhi(v.w); } while (0)
template <bool CACHE>
DI void phase_mla_finish(const Params& p, LAS unsigned char* lds, int l, int G, int c) {
    int tid = threadIdx.x; asm volatile("" : "+v"(tid)); unsigned char* ws = p.ws;
    const bf16_t* us = (const bf16_t*)(ws + WS_R1 + R1_US);
    LAS bf16_t* VT = (LAS bf16_t*)lds;
    const int nitems = CACHE ? NLAY * 4096 / 64 : MT / 64;
    const int it_first = CACHE ? c : (G == 256 ? (c >= 96 ? c - 96 : (c < 32 ? 160 + c : nitems)) : G - 1 - c);
    for (int it = it_first; it < nitems; it += G) {
        int r0, T, t0, sb, lay; bool lat;
        if (CACHE) { lay = it >> 6; r0 = (it & 63) * 64; lat = false; T = 512; t0 = r0 & 511; sb = r0 - t0; }
        else { lay = l; r0 = it * 64; lat = r0 >= MC; T = lat ? 1024 : 256; t0 = lat ? ((r0 - MC) & 1023) : (r0 & 255); sb = r0 - t0; }
        const int role = tid >> 8, tl = (tid & 255) >> 2, h = tid & 3, row = r0 + tl, t = t0 + tl;
        const float prow = (float)(t >> 6), pcol = (float)(t & 63);
        __syncthreads();
        if (role == 0 && !CACHE) {
            const bf16_t* cq = us + (size_t)row * USW + US_CQ + h * 48; float ss = 0.f;
#pragma unroll
            for (int q = 0; q < 6; ++q) ss += sumsq8(*(const u32x4*)(cq + q * 8));
            ss += __shfl_xor(ss, 1); ss += __shfl_xor(ss, 2);
            const float rq = rsqrtf(ss * (1.0f / 192.0f) + EPSV);
            const bf16_t* src = (const bf16_t*)(ws + WS_R2 + R2_QRAW) + (size_t)row * 512 + h * 128;
            float s2 = 0.f;
#pragma unroll
            for (int q = 0; q < 12; ++q) s2 += sumsq8(*(const u32x4*)(src + q * 8));
            s2 *= rq * rq;
            const float r2 = rsqrtf(s2 * (1.0f / 96.0f) + EPSV) * rq; const float* gq = p.in[I_MQN] + lay * 96;
            bf16_t* dst = (bf16_t*)(ws + WS_HM + HM_QM) + (size_t)row * 384 + h * 96;
#pragma unroll
            for (int q = 0; q < 8; ++q) *(u32x4*)(dst + q * 8) = scale8(*(const u32x4*)(src + q * 8), r2, gq + q * 8);
            float y[32];
#pragma unroll
            for (int q = 0; q < 4; ++q) { const u32x4 v = *(const u32x4*)(src + 64 + q * 8); UNPK8(y, q * 8, v); }
#pragma unroll
            for (int d = 0; d < 32; ++d) y[d] = y[d] * r2 * gq[64 + d];
            if (lat) ROPE32(y, 0, prow, pcol);
#pragma unroll
            for (int q = 0; q < 4; ++q) { u32x4 wv; wv.x = pk2(y[q * 8], y[q * 8 + 1]); wv.y = pk2(y[q * 8 + 2], y[q * 8 + 3]); wv.z = pk2(y[q * 8 + 4], y[q * 8 + 5]); wv.w = pk2(y[q * 8 + 6], y[q * 8 + 7]); *(u32x4*)(dst + 64 + q * 8) = wv; }
        }
        if (role == 1) {
            float rkv = 1.0f;
            const int b = r0 >> (CACHE ? 9 : 8);
            if (!CACHE) {
                const bf16_t* ck = us + (size_t)row * USW + US_CKV + h * 32; float ss = 0.f;
#pragma unroll
                for (int q = 0; q < 4; ++q) ss += sumsq8(*(const u32x4*)(ck + q * 8));
                ss += __shfl_xor(ss, 1); ss += __shfl_xor(ss, 2);
                rkv = rsqrtf(ss * (1.0f / 128.0f) + EPSV);
                if (!lat) { const float* gk = p.in[I_KVN] + lay * 128 + h * 32; float* o = p.out + O_CKV + ((size_t)(b * 4 + lay) * 256 + t) * 128 + h * 32;
#pragma unroll
                    for (int q = 0; q < 4; ++q) { const u32x4 v = *(const u32x4*)(ck + q * 8); const f32x4 g0 = *(const f32x4*)(gk + q * 8), g1 = *(const f32x4*)(gk + q * 8 + 4);
                        *(f32x4*)(o + q * 8) = (f32x4){bflo(v.x) * rkv * g0[0], bfhi(v.x) * rkv * g0[1], bflo(v.y) * rkv * g0[2], bfhi(v.y) * rkv * g0[3]};
                        *(f32x4*)(o + q * 8 + 4) = (f32x4){bflo(v.z) * rkv * g1[0], bfhi(v.z) * rkv * g1[1], bflo(v.w) * rkv * g1[2], bfhi(v.w) * rkv * g1[3]}; } }
            }
            float y[32];
            if (CACHE) { const float* krp = p.in[I_CKR] + ((size_t)(b * 4 + lay) * 512 + t) * 32;
#pragma unroll
                for (int q = 0; q < 8; ++q) { const f32x4 v = *(const f32x4*)(krp + q * 4); y[q * 4] = v[0]; y[q * 4 + 1] = v[1]; y[q * 4 + 2] = v[2]; y[q * 4 + 3] = v[3]; } }
            else { const bf16_t* krp = us + (size_t)row * USW + US_KR;
#pragma unroll
                for (int q = 0; q < 4; ++q) { const u32x4 v = *(const u32x4*)(krp + q * 8); UNPK8(y, q * 8, v); }
                if (!lat) { float* o = p.out + O_KR + ((size_t)(b * 4 + lay) * 256 + t) * 32 + h * 8; const u32x4 v = *(const u32x4*)(krp + h * 8);
                    *(f32x4*)o = (f32x4){bflo(v.x), bfhi(v.x), bflo(v.y), bfhi(v.y)}; *(f32x4*)(o + 4) = (f32x4){bflo(v.z), bfhi(v.z), bflo(v.w), bfhi(v.w)}; } }
            const bf16_t* src = CACHE ? (const bf16_t*)(ws + WS_R1 + R1_KVRC) + ((size_t)lay * 4096 + row) * 512 + h * 128 : (const bf16_t*)(ws + WS_R2 + R2_KVRAW) + (size_t)row * 512 + h * 128;
            float s2 = 0.f, s3 = 0.f;
#pragma unroll
            for (int q = 0; q < 8; ++q) s2 += sumsq8(*(const u32x4*)(src + q * 8));
#pragma unroll
            for (int d = 0; d < 32; ++d) s3 += y[d] * y[d];
            s2 = s2 * rkv * rkv + s3;
            const float r2 = rsqrtf(s2 * (1.0f / 96.0f) + EPSV); const float* gk2 = p.in[I_MKN] + lay * 96;
            bf16_t* dst = CACHE ? (bf16_t*)(ws + WS_KMC) + ((((size_t)lay * 8 + b) * 4 + h) * 512 + t) * 96 : (bf16_t*)(ws + WS_HM + HM_KMS) + (size_t)sb * 384 + ((size_t)h * T + t) * 96;
#pragma unroll
            for (int q = 0; q < 8; ++q) *(u32x4*)(dst + q * 8) = scale8(*(const u32x4*)(src + q * 8), r2 * rkv, gk2 + q * 8);
#pragma unroll
            for (int q = 0; q < 8; ++q) *(LAS u32x4*)(VT + tl * 264 + h * 64 + q * 8) = scale8n(*(const u32x4*)(src + 64 + q * 8), rkv);
#pragma unroll
            for (int d = 0; d < 32; ++d) y[d] = y[d] * r2 * gk2[64 + d];
            if (lat) ROPE32(y, 0, prow, pcol);
#pragma unroll
            for (int q = 0; q < 4; ++q) { u32x4 wv; wv.x = pk2(y[q * 8], y[q * 8 + 1]); wv.y = pk2(y[q * 8 + 2], y[q * 8 + 3]); wv.z = pk2(y[q * 8 + 4], y[q * 8 + 5]); wv.w = pk2(y[q * 8 + 6], y[q * 8 + 7]); *(u32x4*)(dst + 64 + q * 8) = wv; }
        }
        __syncthreads();
        { const int cidx = tid & 255, th = tid >> 8; const int b = r0 >> 9;
          bf16_t* dst = CACHE ? (bf16_t*)(ws + WS_VMTC) + ((((size_t)lay * 8 + b) * 4 + (cidx >> 6)) * 64 + (cidx & 63)) * 512 + t0 + th * 32
                              : (bf16_t*)(ws + WS_VMTS) + (size_t)sb * 256 + ((size_t)(cidx >> 6) * 64 + (cidx & 63)) * T + t0 + th * 32;
#pragma unroll
          for (int q = 0; q < 4; ++q) { u32x4 wv; const LAS bf16_t* s = VT + (th * 32 + q * 8) * 264 + cidx;
              wv.x = (unsigned)s[0] | ((unsigned)s[264] << 16); wv.y = (unsigned)s[2 * 264] | ((unsigned)s[3 * 264] << 16); wv.z = (unsigned)s[4 * 264] | ((unsigned)s[5 * 264] << 16); wv.w = (unsigned)s[6 * 264] | ((unsigned)s[7 * 264] << 16);
              *(u32x4*)(dst + q * 8) = wv; } }
    }
    __syncthreads();
}

template <bool DIFF>
DI void attn_item(LAS unsigned char* lds, const bf16_t* Qp, int qstride, const bf16_t* K0, const bf16_t* VT0, int n0, int vts0, const bf16_t* K1, const bf16_t* VT1, int n1, int vts1,
                  bf16_t* outp, float cscale, float lam, const float* subln, float oscale) {
    constexpr int KD = DIFF ? 64 : 96, KP = KD + 8, NP = KD / 32, CPK = KD / 8;
    int tid = threadIdx.x; asm volatile("" : "+v"(tid)); const int lane = tid & 63, wid = tid >> 6, fr = lane & 15, g = lane >> 4;
    bf16x8 qf[NP];
#pragma unroll
    for (int pi = 0; pi < NP; ++pi) { u32x4 w = *(const u32x4*)(Qp + (size_t)(wid * 16 + fr) * qstride + pi * 32 + g * 8);
        w.x = pk2(bflo(w.x) * cscale, bfhi(w.x) * cscale); w.y = pk2(bflo(w.y) * cscale, bfhi(w.y) * cscale); w.z = pk2(bflo(w.z) * cscale, bfhi(w.z) * cscale); w.w = pk2(bflo(w.w) * cscale, bfhi(w.w) * cscale);
        qf[pi] = __builtin_bit_cast(bf16x8, w); }
    f32x4 O1[4], O2[4];
#pragma unroll
    for (int i = 0; i < 4; ++i) { O1[i] = (f32x4){0.f, 0.f, 0.f, 0.f}; O2[i] = (f32x4){0.f, 0.f, 0.f, 0.f}; }
    float l1 = 0.f, l2 = 0.f;
    const int nt0 = n0 >> 6, ntt = nt0 + (n1 >> 6);
    u32x4 pk0, pk1 = (u32x4){0u, 0u, 0u, 0u}, pv;
#define ATT_PREFETCH(ti) do { const bool s_ = (ti) >= nt0; const bf16_t* Kb = s_ ? K1 + (size_t)((ti) - nt0) * 64 * KD : K0 + (size_t)(ti) * 64 * KD; \
        const bf16_t* Vb = s_ ? VT1 + ((ti) - nt0) * 64 : VT0 + (ti) * 64; const int vs = s_ ? vts1 : vts0; \
        pk0 = *(const u32x4*)(Kb + tid * 8); if (!DIFF && tid < 256) pk1 = *(const u32x4*)(Kb + (512 + tid) * 8); pv = *(const u32x4*)(Vb + (size_t)(tid >> 3) * vs + (tid & 7) * 8); } while (0)
    constexpr int TILE_B = 64 * KP * 2 + 64 * 72 * 2;
#define ATT_STORE(buf) do { LAS bf16_t* Kt_ = (LAS bf16_t*)(lds + (buf) * TILE_B); LAS bf16_t* Vt_ = (LAS bf16_t*)(lds + (buf) * TILE_B + 64 * KP * 2); \
        *(LAS u32x4*)(Kt_ + (tid / CPK) * KP + (tid % CPK) * 8) = pk0; \
        if (!DIFF && tid < 256) { const int q_ = 512 + tid; *(LAS u32x4*)(Kt_ + (q_ / CPK) * KP + (q_ % CPK) * 8) = pk1; } \
        *(LAS u32x4*)(Vt_ + (tid >> 3) * 72 + (tid & 7) * 8) = pv; } while (0)
    ATT_PREFETCH(0);
    __syncthreads();
    ATT_STORE(0);
    if (ntt > 1) ATT_PREFETCH(1);
    __syncthreads();
    for (int ti = 0; ti < ntt; ++ti) {
        const LAS bf16_t* Kt = (const LAS bf16_t*)(lds + (ti & 1) * TILE_B); const LAS bf16_t* Vt = (const LAS bf16_t*)(lds + (ti & 1) * TILE_B + 64 * KP * 2);
        if (ti + 1 < ntt) { ATT_STORE((ti + 1) & 1); if (ti + 2 < ntt) ATT_PREFETCH(ti + 2); }
        f32x4 s1[4], s2[4];
#pragma unroll
        for (int kb = 0; kb < 4; ++kb) {
            const LAS bf16_t* kr = Kt + (kb * 16 + fr) * KP + g * 8; const f32x4 z = (f32x4){0.f, 0.f, 0.f, 0.f};
            if (DIFF) { s1[kb] = __builtin_amdgcn_mfma_f32_16x16x32_bf16(*(const LAS bf16x8*)kr, qf[0], z, 0, 0, 0); s2[kb] = __builtin_amdgcn_mfma_f32_16x16x32_bf16(*(const LAS bf16x8*)(kr + 32), qf[NP > 1 ? 1 : 0], z, 0, 0, 0); }
            else { f32x4 a = __builtin_amdgcn_mfma_f32_16x16x32_bf16(*(const LAS bf16x8*)kr, qf[0], z, 0, 0, 0); a = __builtin_amdgcn_mfma_f32_16x16x32_bf16(*(const LAS bf16x8*)(kr + 32), qf[NP > 1 ? 1 : 0], a, 0, 0, 0);
                   s1[kb] = __builtin_amdgcn_mfma_f32_16x16x32_bf16(*(const LAS bf16x8*)(kr + 64), qf[NP > 2 ? 2 : 0], a, 0, 0, 0); s2[kb] = z; }
        }
#pragma unroll
        for (int kb = 0; kb < 4; ++kb)
#pragma unroll
            for (int r = 0; r < 4; ++r) { const float e1 = __builtin_amdgcn_exp2f(s1[kb][r]); s1[kb][r] = e1; l1 += e1;
                if (DIFF) { const float e2 = __builtin_amdgcn_exp2f(s2[kb][r]); s2[kb][r] = e2; l2 += e2; } }
        bf16x8 pb1[2], pb2[2];
#pragma unroll
        for (int pp = 0; pp < 2; ++pp) { u32x4 w; w.x = pk2(s1[2 * pp][0], s1[2 * pp][1]); w.y = pk2(s1[2 * pp][2], s1[2 * pp][3]); w.z = pk2(s1[2 * pp + 1][0], s1[2 * pp + 1][1]); w.w = pk2(s1[2 * pp + 1][2], s1[2 * pp + 1][3]);
            pb1[pp] = __builtin_bit_cast(bf16x8, w);
            if (DIFF) { u32x4 w2; w2.x = pk2(s2[2 * pp][0], s2[2 * pp][1]); w2.y = pk2(s2[2 * pp][2], s2[2 * pp][3]); w2.z = pk2(s2[2 * pp + 1][0], s2[2 * pp + 1][1]); w2.w = pk2(s2[2 * pp + 1][2], s2[2 * pp + 1][3]); pb2[pp] = __builtin_bit_cast(bf16x8, w2); } }
#pragma unroll
        for (int dvb = 0; dvb < 4; ++dvb)
#pragma unroll
            for (int pp = 0; pp < 2; ++pp) { const LAS bf16_t* vr = Vt + (dvb * 16 + fr) * 72 + pp * 32 + g * 4;
                const u32x2 lo = *(const LAS u32x2*)vr, hi = *(const LAS u32x2*)(vr + 16); const u32x4 vv = (u32x4){lo.x, lo.y, hi.x, hi.y}; const bf16x8 vf = __builtin_bit_cast(bf16x8, vv);
                O1[dvb] = __builtin_amdgcn_mfma_f32_16x16x32_bf16(vf, pb1[pp], O1[dvb], 0, 0, 0);
                if (DIFF) O2[dvb] = __builtin_amdgcn_mfma_f32_16x16x32_bf16(vf, pb2[pp], O2[dvb], 0, 0, 0); }
        __syncthreads();
    }
#undef ATT_PREFETCH
#undef ATT_STORE
    l1 += __shfl_xor(l1, 16); l1 += __shfl_xor(l1, 32);
    const float i1 = 1.0f / l1; float o[4][4];
    if (DIFF) { l2 += __shfl_xor(l2, 16); l2 += __shfl_xor(l2, 32); const float i2 = lam / l2; float ss = 0.f;
#pragma unroll
        for (int dvb = 0; dvb < 4; ++dvb)
#pragma unroll
            for (int r = 0; r < 4; ++r) { o[dvb][r] = O1[dvb][r] * i1 - O2[dvb][r] * i2; ss += o[dvb][r] * o[dvb][r]; }
        ss += __shfl_xor(ss, 16); ss += __shfl_xor(ss, 32);
        const float rn = rsqrtf(ss * (1.0f / 64.0f) + EPSV) * oscale;
#pragma unroll
        for (int dvb = 0; dvb < 4; ++dvb)
#pragma unroll
            for (int r = 0; r < 4; ++r) o[dvb][r] = o[dvb][r] * rn * subln[dvb * 16 + g * 4 + r];
    } else {
#pragma unroll
        for (int dvb = 0; dvb < 4; ++dvb)
#pragma unroll
            for (int r = 0; r < 4; ++r) o[dvb][r] = O1[dvb][r] * i1;
    }
    bf16_t* orow = outp + (size_t)(wid * 16 + fr) * DM + g * 4;
#pragma unroll
    for (int dvb = 0; dvb < 4; ++dvb) { u32x2 w; w.x = pk2(o[dvb][0], o[dvb][1]); w.y = pk2(o[dvb][2], o[dvb][3]); *(u32x2*)(orow + dvb * 16) = w; }
}

DI void phase_attn(const Params& p, LAS unsigned char* lds, int l, int G, int c) {
    unsigned char* ws = p.ws;
    const float* lq = p.in[I_DLAM] + l * 128; float d01 = 0.f, d23 = 0.f;
    for (int i = 0; i < 32; ++i) { d01 += lq[i] * lq[32 + i]; d23 += lq[64 + i] * lq[96 + i]; }
    const float lam_init = 0.8f - 0.6f * expf(-0.3f * (float)l), lam = expf(d01) - expf(d23) + lam_init;
    const bf16_t* Qd = (const bf16_t*)(ws + WS_HM + HM_QD); const bf16_t* Qm = (const bf16_t*)(ws + WS_HM + HM_QM);
    const bf16_t* Kds = (const bf16_t*)(ws + WS_KDS); const bf16_t* VdTs = (const bf16_t*)(ws + WS_VDTS); const bf16_t* Kms = (const bf16_t*)(ws + WS_HM + HM_KMS); const bf16_t* VmTs = (const bf16_t*)(ws + WS_VMTS);
    const bf16_t* Kdc = (const bf16_t*)(ws + WS_KDC); const bf16_t* VdTc = (const bf16_t*)(ws + WS_VDTC); const bf16_t* Kmc = (const bf16_t*)(ws + WS_KMC); const bf16_t* VmTc = (const bf16_t*)(ws + WS_VMTC);
    bf16_t* br = (bf16_t*)(ws + WS_R2 + R2_BR);
    const float cs_da = 0.17677669529663687f * 1.4426950408889634f, cs_ml = 0.10206207261596577f * 1.4426950408889634f;
    for (int L = c; L < 768; L += G) {
        bool mla, lat; int b, h, qb;
        if (L < 512) { lat = true; mla = L >= 256; const int i = L & 255; b = i >> 5; h = (i >> 3) & 3; qb = i & 7; }
        else { lat = false; const int i = L - 512; mla = i >= 128; const int j = i & 127; b = j >> 3; h = (j >> 1) & 3; qb = j & 1; }
        const int T = lat ? 1024 : 256, sb = lat ? MC + b * 1024 : b * 256, row0 = sb + qb * 128, n0 = lat ? 512 : 0;
        const size_t cidx = ((size_t)(l * 8 + b) * 4 + h);
        if (!mla) attn_item<true>(lds, Qd + (size_t)row0 * 256 + h * 64, 256, Kdc + cidx * 512 * 64, VdTc + cidx * 64 * 512, n0, 512, Kds + (size_t)sb * 256 + (size_t)h * T * 64, VdTs + (size_t)sb * 256 + (size_t)h * 64 * T, T, T,
                                  br + (size_t)row0 * DM + 256 + h * 64, cs_da, lam, p.in[I_DSUB] + l * 64, 1.0f - lam_init);
        else attn_item<false>(lds, Qm + (size_t)row0 * 384 + h * 96, 384, Kmc + cidx * 512 * 96, VmTc + cidx * 64 * 512, n0, 512, Kms + (size_t)sb * 384 + (size_t)h * T * 96, VmTs + (size_t)sb * 256 + (size_t)h * 64 * T, T, T,
                              br + (size_t)row0 * DM + 768 + h * 64, cs_ml, 0.f, nullptr, 1.0f);
    }
    __syncthreads();
}

DI void phase_convact(const Params& p, int l, int G, int c) {
    const bf16_t* u2 = (const bf16_t*)(p.ws + WS_R1); bf16_t* act = (bf16_t*)(p.ws + WS_R2);
    const float* cw = p.in[I_CONVW] + (size_t)l * 3 * F2; const float* cbp = p.in[I_CONVB] + (size_t)l * F2;
    int tidc = threadIdx.x; asm volatile("" : "+v"(tidc));
    for (size_t idx = (size_t)c * NTHR + tidc; idx < (size_t)(MT / 8) * 352; idx += (size_t)G * NTHR) {
        const int ch = (int)(idx % 352), seg = (int)(idx / 352), f = ch * 8, r0 = seg * 8;
        const bool lat = r0 >= MC; const int T = lat ? 1024 : 256, t0 = lat ? ((r0 - MC) & 1023) : (r0 & 255);
        float wg[3][8], wv[3][8], bg[8], bv[8];
#pragma unroll
        for (int j = 0; j < 3; ++j)
#pragma unroll
            for (int q = 0; q < 2; ++q) { const f32x4 a = *(const f32x4*)(cw + j * F2 + f + q * 4), b = *(const f32x4*)(cw + j * F2 + FH + f + q * 4);
#pragma unroll
                for (int e = 0; e < 4; ++e) { wg[j][q * 4 + e] = a[e]; wv[j][q * 4 + e] = b[e]; } }
#pragma unroll
        for (int q = 0; q < 2; ++q) { const f32x4 a = *(const f32x4*)(cbp + f + q * 4), b = *(const f32x4*)(cbp + FH + f + q * 4);
#pragma unroll
            for (int e = 0; e < 4; ++e) { bg[q * 4 + e] = a[e]; bv[q * 4 + e] = b[e]; } }
        const u32x4 zz = (u32x4){0u, 0u, 0u, 0u};
        u32x4 pg = t0 > 0 ? *(const u32x4*)(u2 + (size_t)(r0 - 1) * F2 + f) : zz, pvv = t0 > 0 ? *(const u32x4*)(u2 + (size_t)(r0 - 1) * F2 + FH + f) : zz;
        u32x4 cg_ = *(const u32x4*)(u2 + (size_t)r0 * F2 + f), cv_ = *(const u32x4*)(u2 + (size_t)r0 * F2 + FH + f);
#pragma unroll 2
        for (int i = 0; i < 8; ++i) {
            const bool hn = (t0 + i + 1) < T;
            const u32x4 ng = hn ? *(const u32x4*)(u2 + (size_t)(r0 + i + 1) * F2 + f) : zz, nv = hn ? *(const u32x4*)(u2 + (size_t)(r0 + i + 1) * F2 + FH + f) : zz;
            float o[8];
#define CA_ONE(e, PW, CW, NW, PV, CV, NV, HI) { const float gp = HI ? bfhi(PW) : bflo(PW), gc = HI ? bfhi(CW) : bflo(CW), gn = HI ? bfhi(NW) : bflo(NW); \
                const float vp = HI ? bfhi(PV) : bflo(PV), vc = HI ? bfhi(CV) : bflo(CV), vn = HI ? bfhi(NV) : bflo(NV); \
                const float Gv = wg[0][e] * gp + wg[1][e] * gc + wg[2][e] * gn + bg[e], Vv = wv[0][e] * vp + wv[1][e] * vc + wv[2][e] * vn + bv[e]; o[e] = Gv * sigmoidf_(Gv) * Vv; }
            CA_ONE(0, pg.x, cg_.x, ng.x, pvv.x, cv_.x, nv.x, 0) CA_ONE(1, pg.x, cg_.x, ng.x, pvv.x, cv_.x, nv.x, 1)
            CA_ONE(2, pg.y, cg_.y, ng.y, pvv.y, cv_.y, nv.y, 0) CA_ONE(3, pg.y, cg_.y, ng.y, pvv.y, cv_.y, nv.y, 1)
            CA_ONE(4, pg.z, cg_.z, ng.z, pvv.z, cv_.z, nv.z, 0) CA_ONE(5, pg.z, cg_.z, ng.z, pvv.z, cv_.z, nv.z, 1)
            CA_ONE(6, pg.w, cg_.w, ng.w, pvv.w, cv_.w, nv.w, 0) CA_ONE(7, pg.w, cg_.w, ng.w, pvv.w, cv_.w, nv.w, 1)
#undef CA_ONE
            u32x4 w; w.x = pk2(o[0], o[1]); w.y = pk2(o[2], o[3]); w.z = pk2(o[4], o[5]); w.w = pk2(o[6], o[7]);
            *(u32x4*)(act + (size_t)(r0 + i) * FH + f) = w;
            pg = cg_; pvv = cv_; cg_ = ng; cv_ = nv;
        }
    }
}


DI void gbar(unsigned* ctr, unsigned G) {
    asm volatile("s_waitcnt vmcnt(0) lgkmcnt(0)" ::: "memory");
    __syncthreads();
    if (threadIdx.x < 64) {
        if (threadIdx.x == 0) {
            __builtin_amdgcn_fence(__ATOMIC_RELEASE, "agent");
            asm volatile("s_waitcnt vmcnt(0)" ::: "memory");
            __hip_atomic_fetch_add(ctr, 1u, __ATOMIC_RELAXED, __HIP_MEMORY_SCOPE_AGENT);
            const unsigned long long t0 = __builtin_amdgcn_s_memrealtime();
            while (__hip_atomic_load(ctr, __ATOMIC_RELAXED, __HIP_MEMORY_SCOPE_AGENT) < G) {
                __builtin_amdgcn_s_sleep(2);
                if (__builtin_amdgcn_s_memrealtime() - t0 > 20000000ull) break;
            }
        }
        __builtin_amdgcn_fence(__ATOMIC_ACQUIRE, "agent");
        asm volatile("s_waitcnt vmcnt(0)" ::: "memory");
    }
    __syncthreads();
}

#define XB_TMO      128
#define XB_XCNT(j)  (256  + 64 * (j))
#define XB_XSUB(j)  (1280 + 64 * (j))
#define XB_XGEN(j)  (2304 + 64 * (j))
#define XB_TOP      3328
#define XB_TOPGEN   3392
#define XCD_BAR_WORDS 3456
#define XB_SPIN_CAP (1u << 18)
DI unsigned xb_ld(unsigned* p)              { return __hip_atomic_load(p, __ATOMIC_RELAXED, __HIP_MEMORY_SCOPE_AGENT); }
DI unsigned xb_add(unsigned* p, unsigned v) { return __hip_atomic_fetch_add(p, v, __ATOMIC_RELAXED, __HIP_MEMORY_SCOPE_AGENT); }
DI unsigned xb_xcc_id() { return (unsigned)__builtin_amdgcn_s_getreg((3 << 11) | 20) & 0xFu; }
#define XB_SPIN(cond, bar) do { unsigned _sp = 0; while (cond) { __builtin_amdgcn_s_sleep(1); \
    if ((++_sp & 255u) == 0u) { if (xb_ld(&(bar)[XB_TMO])) break; if (_sp > XB_SPIN_CAP) { atomicAdd(&(bar)[XB_TMO], 1u); break; } } } } while (0)
struct XcdBarrier { unsigned* bar; unsigned x; volatile LAS unsigned* st; };
DI XcdBarrier xcd_barrier_post(unsigned* bar, volatile LAS unsigned* st) {
    XcdBarrier b; b.bar = bar; b.x = xb_xcc_id(); b.st = st;
    if (threadIdx.x == 0) (void)xb_add(&bar[XB_XCNT(b.x)], 1u);
    return b;
}
DI void xcd_barrier_complete(unsigned* bar, unsigned x, unsigned& nloc, unsigned& nx) {
    const unsigned G = gridDim.x * gridDim.y * gridDim.z;
    unsigned sum, cnt, mine, sp = 0u;
    for (;;) {
        sum = 0u; cnt = 0u; mine = 0u;
#pragma unroll
        for (unsigned j = 0; j < 16; ++j) { const unsigned c = xb_ld(&bar[XB_XCNT(j)]); sum += c; cnt += (c > 0u) ? 1u : 0u; mine = (j == x) ? c : mine; }
        if (sum == G) break;
        __builtin_amdgcn_s_sleep(1);
        if ((++sp & 255u) == 0u) { if (xb_ld(&bar[XB_TMO])) break; if (sp > XB_SPIN_CAP) { atomicAdd(&bar[XB_TMO], 1u); break; } }
    }
    nloc = mine > 0u ? mine : 1u; nx = cnt > 0u ? cnt : 1u;
}
DI void xcd_barrier(const XcdBarrier& b) {
    asm volatile("s_waitcnt vmcnt(0) lgkmcnt(0)" ::: "memory");
    __syncthreads();
    if (threadIdx.x == 0) {
        unsigned* bar = b.bar;
        __builtin_amdgcn_s_waitcnt(0);
        unsigned nloc = b.st[0], nx = b.st[1];
        if (nloc == 0u) { xcd_barrier_complete(bar, b.x, nloc, nx); b.st[0] = nloc; b.st[1] = nx; }
        const unsigned old = xb_add(&bar[XB_XSUB(b.x)], 1u);
        const unsigned gen = old / nloc;
        if (old + 1u == (gen + 1u) * nloc) {
            __builtin_amdgcn_fence(__ATOMIC_RELEASE, "agent");
            asm volatile("s_waitcnt vmcnt(0)" ::: "memory");
            const unsigned og = xb_add(&bar[XB_TOP], 1u);
            const unsigned tg = og / nx;
            if (og + 1u == (tg + 1u) * nx) xb_add(&bar[XB_TOPGEN], 1u);
            else XB_SPIN(xb_ld(&bar[XB_TOPGEN]) == tg, bar);
            __builtin_amdgcn_fence(__ATOMIC_ACQUIRE, "agent");
            xb_add(&bar[XB_XGEN(b.x)], 1u);
            asm volatile("s_waitcnt vmcnt(0)" ::: "memory");
        } else {
            XB_SPIN(xb_ld(&bar[XB_XGEN(b.x)]) == gen, bar);
            __builtin_amdgcn_fence(__ATOMIC_ACQUIRE, "agent");
            asm volatile("s_waitcnt vmcnt(0)" ::: "memory");
        }
    }
    __syncthreads();
}
#ifndef PHMASK
#define PHMASK 0xFFFF
#endif
#define PHM(k) ((PHMASK >> (k)) & 1)
__global__ void __launch_bounds__(NTHR) mega(Params p) {
    extern __shared__ __attribute__((aligned(16))) unsigned char lds_raw[];
    LAS unsigned char* lds = (LAS unsigned char*)lds_raw;
    cg::grid_group grid = cg::this_grid();
    const int G = gridDim.x, c = blockIdx.x;
    unsigned char* ws = p.ws;
    bf16_t* hm = (bf16_t*)(ws + WS_HM); bf16_t* sg = (bf16_t*)(ws + WS_R1 + R1_SG); bf16_t* us = (bf16_t*)(ws + WS_R1 + R1_US);
    bf16_t* br = (bf16_t*)(ws + WS_R2 + R2_BR); float* mod = (float*)(ws + WS_MOD);
    volatile LAS unsigned* xst = (volatile LAS unsigned*)(lds + 131072);
    if (threadIdx.x < 4) xst[threadIdx.x] = 0u;
    __syncthreads();
    const XcdBarrier xbar = xcd_barrier_post((unsigned*)ws, xst);
    for (int ph = p.lo; ph < p.hi; ++ph) {
        if (ph == 0) { if (PHM(12)) phase_prepass(p, lds, G, c); }
        else if (ph == 1 && PHM(11)) {
            pg8::Gemm g{256, 256, 256}; pg8::SchedPlain S; S.set(ws + WS_R1 + R1_AC, ws + WS_WUKVP, 256, 256, 64, 2, G, c, -1, 4, SZ_SM);
            pg8::EpiStore E{(bf16_t*)(ws + WS_R1 + R1_KVRC), 512, nullptr, 0}; pg8::gemm_phase(lds, g, S, E);
        } else {
            const int l = (ph - 2) / 11, s = (ph - 2) % 11;
            if (s == 0 && PHM(0)) { if (l == 0) phase_mla_finish<true>(p, lds, 0, G, c); phase_norm(p, l, 0, l == 0, G, c); }
            else if (s == 1 && PHM(1)) { pg8::Gemm g{DM, DM, DM}; pg8::SchedPlain S; S.set(hm, ws + WS_WIN + l * SZ_WIN, DM, DM, MT / 256, INP / 256, G, c); pg8::EpiIn E{sg, us}; pg8::gemm_phase(lds, g, S, E); }
            else if (s == 2 && PHM(2)) {
                { pg8::Gemm g{USW, 256, 256}; pg8::SchedPlain S; S.set(us + US_FT, ws + WS_BDFT, USW, 256, MT / 256, 2, G, c); pg8::EpiZt E{(bf16_t*)(ws + WS_R2 + R2_ZTL), (bf16_t*)(ws + WS_R2 + R2_ZTC)}; pg8::gemm_phase(lds, g, S, E); }
                __syncthreads();
                { pg8::Gemm g{USW, 256, 256}; pg8::SchedPlain S; S.set(us + US_CQ, ws + WS_WUQ + l * SZ_SM, USW, 256, MT / 256, 2, G, (c + G - 96 % G) % G); pg8::EpiStore E{(bf16_t*)(ws + WS_R2 + R2_QRAW), 512, nullptr, 0}; pg8::gemm_phase(lds, g, S, E); }
                __syncthreads();
                { pg8::Gemm g{USW, 256, 256}; pg8::SchedPlain S; S.set(us + US_CKV, ws + WS_WUKV + l * SZ_SM, USW, 256, MT / 256, 2, G, (c + G - 192 % G) % G); pg8::EpiStore E{(bf16_t*)(ws + WS_R2 + R2_KVRAW), 512, nullptr, 0}; pg8::gemm_phase(lds, g, S, E); }
                __syncthreads();
                phase_c1_rows(p, lds, l, G, c);
            } else if (s == 3 && PHM(3)) {
                { pg8::Gemm g{256, 256, 256}; pg8::SchedPlain S; S.set(ws + WS_R2 + R2_POOLED, ws + WS_BDPOOL + l * SZ_BDPOOL, 256, 256, MT / 256, 1, G, c); pg8::EpiStore E{br, DM, p.in[I_POOLS] + l * 256, 0}; pg8::gemm_phase(lds, g, S, E); }
                __syncthreads();
                { pg8::Gemm g{2048, 2048, 2048}; pg8::SchedPlain S; S.set(ws + WS_D1024, ws + WS_R2 + R2_ZTL, 2048, 2048, 4, 8, G, (c + G - 48 % G) % G); pg8::EpiStore E{br, DM, nullptr, 1}; pg8::gemm_phase(lds, g, S, E); }
                __syncthreads();
                { pg8::Gemm g{512, 512, 512}; pg8::SchedPlain S; S.set(ws + WS_D256, ws + WS_R2 + R2_ZTC, 512, 512, 16, 1, G, (c + G - 80 % G) % G, 0, 0, (size_t)256 * 512 * 2); pg8::EpiStore E{br, DM, nullptr, 2}; pg8::gemm_phase(lds, g, S, E); }
                __syncthreads();
                phase_mla_finish<false>(p, lds, l, G, c);
            } else if (s == 4 && PHM(4)) phase_attn(p, lds, l, G, c);
            else if (s == 5 && PHM(5)) { pg8::Gemm g{DM, 256, 256}; pg8::SchedGate S; S.init(MT / 256, 16, G, c); S.A = (const char*)br; S.B = (const char*)(ws + WS_WB + l * SZ_WB);
                pg8::EpiGate E{sg}; pg8::gemm_phase(lds, g, S, E);
                xcd_barrier(xbar);
                int tidm = threadIdx.x; asm volatile("" : "+v"(tidm));
#pragma unroll 3
                for (size_t i = (size_t)c * NTHR + tidm; i < (size_t)MT * 128; i += (size_t)G * NTHR) { const size_t row = i >> 7; const int d = (int)(i & 127) * 8; const bf16_t* gp = sg + row * 4096 + d;
                    float a[8];
#pragma unroll
                    for (int j = 0; j < 8; ++j) a[j] = 0.f;
#pragma unroll
                    for (int n = 0; n < 4; ++n) { const u32x4 v = *(const u32x4*)(gp + n * 1024); a[0] += bflo(v.x); a[1] += bfhi(v.x); a[2] += bflo(v.y); a[3] += bfhi(v.y); a[4] += bflo(v.z); a[5] += bfhi(v.z); a[6] += bflo(v.w); a[7] += bfhi(v.w); }
                    u32x4 w; w.x = pk2(a[0], a[1]); w.y = pk2(a[2], a[3]); w.z = pk2(a[4], a[5]); w.w = pk2(a[6], a[7]); *(u32x4*)(hm + row * DM + d) = w; } }
            else if (s == 6 && PHM(6)) { pg8::Gemm g{DM, DM, DM}; pg8::SchedPlain S; S.set(hm, ws + WS_WO + l * SZ_WO, DM, DM, MT / 256, 4, G, c);
                pg8::EpiResid E{l == 0 ? p.in[I_XP] : nullptr, p.in[I_XS], p.out, mod + (size_t)l * 9 * 6144 + 2 * 1024}; pg8::gemm_phase(lds, g, S, E); }
            else if (s == 7 && PHM(7)) phase_norm(p, l, 1, false, G, c);
            else if (s == 8 && PHM(8)) { pg8::Gemm g{DM, DM, DM}; pg8::SchedPlain S; S.set(hm, ws + WS_WUP + l * SZ_WUP, DM, DM, MT / 256, F2 / 256, G, c); pg8::EpiStore E{(bf16_t*)(ws + WS_R1), F2, nullptr, 0}; pg8::gemm_phase(lds, g, S, E); }
            else if (s == 9 && PHM(9)) phase_convact(p, l, G, c);
            else if (PHM(10)) { pg8::Gemm g{FH, FH, FH}; pg8::SchedPlain S; S.set(ws + WS_R2, ws + WS_WD + l * SZ_WD, FH, FH, MT / 256, 4, G, c);
                pg8::EpiResid E{nullptr, nullptr, p.out, mod + (size_t)l * 9 * 6144 + 5 * 1024}; pg8::gemm_phase(lds, g, S, E);
                if (l + 1 < NLAY && G == 256 && c >= 192) { __syncthreads(); convert_layer_weights(p, lds, l + 1, 64, c - 192); }
                else if (l + 1 < NLAY && G != 256) { __syncthreads(); convert_layer_weights(p, lds, l + 1, G, c); } }
        }
        if (ph + 1 < p.hi) {
            if (ph == 0) { asm volatile("s_waitcnt vmcnt(0) lgkmcnt(0)" ::: "memory"); grid.sync();
                if (threadIdx.x < 64) { __builtin_amdgcn_fence(__ATOMIC_ACQUIRE, "agent"); asm volatile("s_waitcnt vmcnt(0)" ::: "memory"); }
                __syncthreads(); }
            else xcd_barrier(xbar); }
    }
}

constexpr int N_PHASES = 2 + NLAY * 11;

extern "C" void kernel_launch(void* const* d_in, const int* in_sizes, int n_in, void* d_out, int out_size, void* d_ws, size_t ws_size, hipStream_t stream) {
    static int grid = 0;
    if (grid == 0) {
        if (n_in != 31 || ws_size < WS_END) { fprintf(stderr, "kernel_launch: need 31 inputs and %zu bytes of workspace; got %d, %zu\n", (size_t)WS_END, n_in, ws_size); grid = -1; return; }
        int dev = 0, cus = 0, per_cu = 0;
        (void)hipGetDevice(&dev); (void)hipDeviceGetAttribute(&cus, hipDeviceAttributeMultiprocessorCount, dev);
        if (hipFuncSetAttribute((const void*)mega, hipFuncAttributeMaxDynamicSharedMemorySize, LDS_BYTES) != hipSuccess) { fprintf(stderr, "kernel_launch: hipFuncSetAttribute failed\n"); grid = -1; return; }
        if (hipOccupancyMaxActiveBlocksPerMultiprocessor(&per_cu, (const void*)mega, NTHR, LDS_BYTES) != hipSuccess || per_cu < 1) { fprintf(stderr, "kernel_launch: occupancy query failed (%d)\n", per_cu); grid = -1; return; }
        grid = cus * per_cu;
    }
    if (grid < 0) return;
    Params p{};
    for (int i = 0; i < 31; ++i) p.in[i] = (const float*)d_in[i];
    p.out = (float*)d_out; p.ws = (unsigned char*)d_ws; p.lo = 0; p.hi = N_PHASES;
    (void)hipMemsetAsync(d_ws, 0, 32768, stream);
    void* args[] = {&p};
    hipError_t e = hipLaunchCooperativeKernel((const void*)mega, dim3(grid), dim3(NTHR), args, LDS_BYTES, stream);
    if (e != hipSuccess) fprintf(stderr, "cooperative launch failed: %s (grid %d)\n", hipGetErrorString(e), grid);
}
```

```cpp
#include <hip/hip_runtime.h>
#include <hip/hip_cooperative_groups.h>
#include <cstdio>
namespace cg = cooperative_groups;

#define DI __device__ __forceinline__
#define LAS __attribute__((address_space(3)))
typedef unsigned short bf16_t;
typedef short bf16x8 __attribute__((ext_vector_type(8)));
typedef short s16x4 __attribute__((ext_vector_type(4)));
typedef float f32x4 __attribute__((ext_vector_type(4)));
typedef unsigned u32x4 __attribute__((ext_vector_type(4)));
typedef unsigned u32x2 __attribute__((ext_vector_type(2)));

constexpr int DM = 1024, MC = 4096, ML = 8192, MT = 12288, NLAY = 4;
constexpr int INC = 5728, INP = 5888, USW = 1792, F2 = 5632, FH = 2816;
constexpr float EPSV = 1e-6f;
constexpr int NTHR = 512;
constexpr int LDS_BYTES = 131072 + 256;
constexpr int US_POOL = 0, US_Q = 256, US_K = 512, US_V = 768, US_FT = 1024, US_CQ = 1280, US_CKV = 1472, US_KR = 1600;

constexpr size_t al256(size_t x) { return (x + 255) & ~(size_t)255; }
constexpr size_t WS_WIN = 32768;
constexpr size_t SZ_WIN = (size_t)INP * DM * 2;
constexpr size_t WS_WB = WS_WIN + NLAY * SZ_WIN;
constexpr size_t SZ_WB = (size_t)4096 * 256 * 2;
constexpr size_t WS_WO = WS_WB + NLAY * SZ_WB;
constexpr size_t SZ_WO = (size_t)DM * DM * 2;
constexpr size_t WS_WUP = WS_WO + NLAY * SZ_WO;
constexpr size_t SZ_WUP = (size_t)F2 * DM * 2;
constexpr size_t WS_WD = WS_WUP + NLAY * SZ_WUP;
constexpr size_t SZ_WD = (size_t)DM * FH * 2;
constexpr size_t WS_WUQ = WS_WD + NLAY * SZ_WD;
constexpr size_t SZ_SM = (size_t)512 * 256 * 2;
constexpr size_t WS_WUKV = WS_WUQ + NLAY * SZ_SM;
constexpr size_t WS_WUKVP = WS_WUKV + NLAY * SZ_SM;
constexpr size_t WS_BDFT = WS_WUKVP + NLAY * SZ_SM;
constexpr size_t WS_BDPOOL = WS_BDFT + SZ_SM;
constexpr size_t SZ_BDPOOL = (size_t)256 * 256 * 2;
constexpr size_t WS_D1024 = WS_BDPOOL + NLAY * SZ_BDPOOL;
constexpr size_t WS_D256 = WS_D1024 + (size_t)1024 * 2048 * 2;
constexpr size_t WS_MOD = WS_D256 + (size_t)256 * 512 * 2;
constexpr size_t WS_HM = al256(WS_MOD + (size_t)NLAY * 9 * 6144 * 4);
constexpr size_t SZ_HM = (size_t)MT * DM * 2;
constexpr size_t HM_QM = 0, HM_KMS = (size_t)MT * 384 * 2, HM_QD = 2 * (size_t)MT * 384 * 2;
constexpr size_t WS_R1 = WS_HM + SZ_HM;
constexpr size_t R1_SG = 0, R1_US = (size_t)MT * 4096 * 2;
constexpr size_t SZ_R1 = R1_US + (size_t)MT * USW * 2;
constexpr size_t R1_AC = 0, R1_KVRC = (size_t)NLAY * 4096 * 256 * 2;
constexpr size_t WS_R2 = WS_R1 + SZ_R1;
constexpr size_t R2_BR = 0, R2_MP = (size_t)MT * DM * 2;
constexpr size_t R2_QRAW = R2_MP, R2_KVRAW = R2_QRAW + (size_t)MT * 512 * 2, R2_ZTL = R2_KVRAW + (size_t)MT * 512 * 2,
                 R2_ZTC = R2_ZTL + (size_t)2048 * 2048 * 2, R2_POOLED = R2_ZTC + (size_t)16 * 256 * 512 * 2;
constexpr size_t SZ_R2 = R2_MP + (size_t)MT * DM * 4;
constexpr size_t WS_KDS = WS_R2 + SZ_R2;
constexpr size_t SZ_S64 = (size_t)MT * 256 * 2;
constexpr size_t WS_VDTS = WS_KDS + SZ_S64;
constexpr size_t WS_VMTS = WS_VDTS + SZ_S64;
constexpr size_t WS_KDC = WS_VMTS + SZ_S64;
constexpr size_t SZ_C64 = (size_t)NLAY * 8 * 4 * 512 * 64 * 2;
constexpr size_t WS_VDTC = WS_KDC + SZ_C64;
constexpr size_t WS_KMC = WS_VDTC + SZ_C64;
constexpr size_t WS_VMTC = WS_KMC + (size_t)NLAY * 8 * 4 * 512 * 96 * 2;
constexpr size_t WS_END = WS_VMTC + SZ_C64;
static_assert(R2_POOLED + (size_t)MT * 256 * 2 <= SZ_R2, "r2 overlay");
static_assert((size_t)MT * F2 * 2 <= SZ_R1, "u2 fits r1");
static_assert((size_t)MT * FH * 2 <= SZ_R2, "act fits r2");
static_assert(HM_QD + (size_t)MT * 256 * 2 <= SZ_HM, "hm overlay");

constexpr size_t O_X = 0, O_DK = 12582912, O_DV = 16777216, O_CKV = 20971520, O_KR = 23068672;

DI bf16_t f2bf(float f) { const __bf16 r = (__bf16)f; return __builtin_bit_cast(bf16_t, r); }
DI float bf2f(bf16_t b) { return __uint_as_float(((unsigned)b) << 16); }
DI float bflo(unsigned w) { return __uint_as_float(w << 16); }
DI float bfhi(unsigned w) { return __uint_as_float(w & 0xffff0000u); }
typedef float f32x2_ __attribute__((ext_vector_type(2)));
typedef __bf16 bf16x2_ __attribute__((ext_vector_type(2)));
DI unsigned pk2(float lo, float hi) { const f32x2_ v = {lo, hi}; const bf16x2_ r = __builtin_convertvector(v, bf16x2_); return __builtin_bit_cast(unsigned, r); }
DI unsigned cvt_pk_bf16(float lo, float hi) { return pk2(lo, hi); }
DI float wave_sum(float v) { for (int o = 32; o >= 1; o >>= 1) v += __shfl_xor(v, o); return v; }
DI int cond_row(int row) { return row < MC ? 0 : 1 + ((row - MC) >> 10); }
DI float sigmoidf_(float x) { return __builtin_amdgcn_rcpf(1.0f + __expf(-x)); }
DI void sincos_rev(float ang, float& s, float& c) { float f = ang * 0.15915494309189535f; f -= rintf(f); s = __builtin_amdgcn_sinf(f); c = __builtin_amdgcn_cosf(f); }
__device__ const float ROPE_INV[8] = {1.0f, 0.31622776601683794f, 0.1f, 0.031622776601683794f, 0.01f, 0.0031622776601683794f, 0.001f, 0.00031622776601683794f};
#define ROPE32(y, base, prow, pcol) do { _Pragma("unroll") for (int _i = 0; _i < 8; ++_i) { float _s, _c; \
    sincos_rev((prow) * ROPE_INV[_i], _s, _c); { const float _a = y[(base) + _i], _b = y[(base) + 8 + _i]; y[(base) + _i] = _a * _c - _b * _s; y[(base) + 8 + _i] = _a * _s + _b * _c; } \
    sincos_rev((pcol) * ROPE_INV[_i], _s, _c); { const float _a = y[(base) + 16 + _i], _b = y[(base) + 24 + _i]; y[(base) + 16 + _i] = _a * _c - _b * _s; y[(base) + 24 + _i] = _a * _s + _b * _c; } } } while (0)

namespace pg8 {
constexpr int BM = 256, BK = 64, HALF = 128, HTB = HALF * BK * 2, STAGE_BYTES = 8 * HTB, NXCD = 8, WGM = 4;
DI int lds_byte(int r, int c) { const int st = (r >> 4) * 2 + (c >> 5), rr = r & 15, cc = c & 31, ob = rr * 64 + cc * 2; return st * 1024 + (ob ^ (((ob >> 9) & 1) << 5)); }
DI void stage_rc(int b, int& R, int& C) { const int st = b / 1024, sb = b % 1024, swz = sb ^ (((sb >> 9) & 1) << 5); R = (st >> 1) * 16 + swz / 64; C = (st & 1) * 32 + (swz % 64) / 2; }
DI int perm32(int rho) { const int n = rho >> 4, i = rho & 15; return 8 * (i >> 2) + 4 * n + (i & 3); }
struct Unit { const char* a; const char* b; int pm, pn, z; };
struct Gemm { int lda, ldb, K; };
struct TileOrder {
    int nM, nN, nwg, G, c;
    DI void init(int nM_, int nN_, int G_, int c_) { nM = nM_; nN = nN_; nwg = nM * nN; G = G_; c = c_; }
    DI bool tile(int i, int& pm, int& pn) const {
        const long L = (long)i * G + c; if (L >= nwg) return false;
        int wgid = (int)L; { const int q = nwg / NXCD, r = nwg % NXCD, xcd = wgid % NXCD, off = wgid / NXCD; wgid = (xcd < r ? xcd * (q + 1) : r * (q + 1) + (xcd - r) * q) + off; }
        const int nig = WGM * nN, gid = wgid / nig, fm = gid * WGM, gsz = (nM - fm) < WGM ? (nM - fm) : WGM;
        pm = fm + ((wgid % nig) % gsz); pn = (wgid % nig) / gsz; return true;
    }
};
struct SchedPlain : TileOrder {
    const char* A; const char* B; size_t tA, tB, zB; int amask, zshift;
    DI void set(const void* A_, const void* B_, int lda, int ldb, int nM_, int nN_, int G_, int c_, int amask_ = -1, int zshift_ = 31, size_t zB_ = 0) {
        A = (const char*)A_; B = (const char*)B_; tA = (size_t)BM * lda * 2; tB = (size_t)BM * ldb * 2; amask = amask_; zshift = zshift_; zB = zB_; init(nM_, nN_, G_, c_); }
    DI bool next(int i, Unit& u) const { if (!tile(i, u.pm, u.pn)) return false; u.z = u.pm >> zshift;
        u.a = A + (size_t)(u.pm & amask) * tA; u.b = B + (size_t)u.z * zB + (size_t)u.pn * tB; return true; }
};
struct SchedGate : TileOrder {
    const char* A; const char* B;
    DI bool next(int i, Unit& u) const { if (!tile(i, u.pm, u.pn)) return false; u.z = u.pn >> 2;
        u.a = A + (size_t)u.pm * (BM * 1024 * 2) + u.z * 512; u.b = B + (size_t)u.pn * 256 * 512; return true; }
};
struct SchedProj : TileOrder {
    const char* A; const char* B;
    DI bool next(int i, Unit& u) const { if (!tile(i >> 2, u.pm, u.pn)) return false; const int n = i & 3; u.z = n;
        u.a = A + (size_t)u.pm * (BM * 1024 * 2) + n * 512; u.b = B + ((size_t)n * 1024 + u.pn * 256) * 512; return true; }
};

template <class Epi, class Sched>
DI void gemm_phase(LAS unsigned char* lds, const Gemm g, const Sched& S, const Epi& E) {
    int tid = threadIdx.x; asm volatile("" : "+v"(tid));
    const int wid = __builtin_amdgcn_readfirstlane(tid >> 6), lane = tid & 63, wr = wid >> 2, wc = wid & 3, fr = lane & 15, fq = lane >> 4;
    int K = g.K; asm volatile("" : "+s"(K)); const int nt = K / BK;
    unsigned voffA[2], voffB[2];
#pragma unroll
    for (int i = 0; i < 2; ++i) { int R, C; stage_rc(tid * 16 + i * 8192, R, C); const int Rb = Epi::PERM ? ((R & ~31) + perm32(R & 31)) : R;
        voffA[i] = (unsigned)(R * g.lda + C) * 2u; voffB[i] = (unsigned)(Rb * g.ldb + C) * 2u; }
    const size_t kstep = (size_t)(BK * 2);
    const size_t hstepA = (size_t)HALF * g.lda * 2, hstepB = (size_t)HALF * g.ldb * 2;
    const unsigned ldsw = (unsigned)wid * 1024u;
    const int aoff = lds_byte(wr * 64 + fr, fq * 8), boff = lds_byte(wc * 32 + fr, fq * 8);
#define PG8_SA(b, h) (((b) * 2 + (h)) * HTB)
#define PG8_SB(b, h) ((4 + (b) * 2 + (h)) * HTB)
#define PG8_STAGE(bufoff, gbase, voff) do { _Pragma("unroll") for (int _i = 0; _i < 2; ++_i) \
        __builtin_amdgcn_global_load_lds((const unsigned*)((const char*)(gbase) + (voff)[_i]), (LAS unsigned*)(lds + (bufoff) + ldsw + _i * 8192), 16, 0, 0); } while (0)
#define PG8_LDA(dst, b, h) do { _Pragma("unroll") for (int m = 0; m < 4; ++m) _Pragma("unroll") for (int k = 0; k < 2; ++k) dst[m][k] = *(const LAS bf16x8*)(lds + PG8_SA(b, h) + aoff + m * 2048 + k * 1024); } while (0)
#define PG8_LDB(dst, b, h) do { _Pragma("unroll") for (int n = 0; n < 2; ++n) _Pragma("unroll") for (int k = 0; k < 2; ++k) dst[n][k] = *(const LAS bf16x8*)(lds + PG8_SB(b, h) + boff + n * 2048 + k * 1024); } while (0)
#define PG8_MMA(ai, bj, At, Bt) do { __builtin_amdgcn_s_setprio(1); _Pragma("unroll") for (int m = 0; m < 4; ++m) _Pragma("unroll") for (int n = 0; n < 2; ++n) _Pragma("unroll") for (int k = 0; k < 2; ++k) \
        acc[ai][bj][m][n] = __builtin_amdgcn_mfma_f32_16x16x32_bf16(Bt[n][k], At[m][k], acc[ai][bj][m][n], 0, 0, 0); __builtin_amdgcn_s_setprio(0); } while (0)
#define PG8_WAIT_V(n) asm volatile("s_waitcnt vmcnt(" #n ")" ::: "memory")
#define PG8_WAIT_L(n) asm volatile("s_waitcnt lgkmcnt(" #n ")" ::: "memory")
#define PG8_BAR __builtin_amdgcn_s_barrier()
#define PG8_SCHED __builtin_amdgcn_sched_barrier(0)
    Unit cur, nxt; int ui = 0;
    if (!S.next(0, cur)) return;
    f32x4 acc[2][2][4][2];
#pragma unroll
    for (int a = 0; a < 2; ++a)
#pragma unroll
        for (int b = 0; b < 2; ++b)
#pragma unroll
            for (int m = 0; m < 4; ++m)
#pragma unroll
                for (int n = 0; n < 2; ++n) acc[a][b][m][n] = (f32x4){0.f, 0.f, 0.f, 0.f};
    bf16x8 At[4][2], B0[2][2], B1[2][2];
    const char* cA = cur.a; const char* cB = cur.b;
    PG8_STAGE(PG8_SB(0, 0), cB, voffB); PG8_STAGE(PG8_SA(0, 0), cA, voffA); PG8_STAGE(PG8_SB(0, 1), cB + hstepB, voffB); PG8_STAGE(PG8_SA(0, 1), cA + hstepA, voffA);
    if (wr == 1) PG8_BAR;
    PG8_WAIT_V(4); PG8_BAR;
    PG8_STAGE(PG8_SB(1, 0), cB + kstep, voffB); PG8_STAGE(PG8_SA(1, 0), cA + kstep, voffA); PG8_STAGE(PG8_SB(1, 1), cB + hstepB + kstep, voffB);
    PG8_WAIT_V(6); PG8_BAR;
    for (;;) {
        const bool has_next = S.next(ui + 1, nxt);
        const char* nA = has_next ? nxt.a : cA; const char* nB = has_next ? nxt.b : cB;
#pragma unroll 1
        for (int t = 0; t < nt; t += 2) {
            const bool last = (t == nt - 2);
            const char* a1 = cA + (size_t)(t + 1) * kstep;
            const char* a2 = last ? nA : cA + (size_t)(t + 2) * kstep; const char* b2 = last ? nB : cB + (size_t)(t + 2) * kstep;
            const char* a3 = a2 + kstep; const char* b3 = b2 + kstep;
            PG8_LDB(B0, 0, 0); PG8_SCHED; PG8_LDA(At, 0, 0); PG8_STAGE(PG8_SA(1, 1), a1 + hstepA, voffA);
            PG8_WAIT_L(8); PG8_BAR; PG8_WAIT_L(0); PG8_MMA(0, 0, At, B0); PG8_BAR; PG8_SCHED;
            PG8_LDB(B1, 0, 1); PG8_STAGE(PG8_SB(0, 0), b2, voffB);
            PG8_BAR; PG8_WAIT_L(0); PG8_MMA(0, 1, At, B1); PG8_BAR;
            PG8_LDA(At, 0, 1); PG8_STAGE(PG8_SA(0, 0), a2, voffA);
            PG8_BAR; PG8_WAIT_L(0); PG8_MMA(1, 0, At, B0); PG8_BAR; PG8_SCHED;
            PG8_STAGE(PG8_SB(0, 1), b2 + hstepB, voffB);
            PG8_WAIT_V(6); PG8_BAR; PG8_MMA(1, 1, At, B1); PG8_BAR;
            PG8_LDB(B0, 1, 0); PG8_SCHED; PG8_LDA(At, 1, 0); PG8_STAGE(PG8_SA(0, 1), a2 + hstepA, voffA);
            PG8_WAIT_L(8); PG8_BAR; PG8_WAIT_L(0); PG8_MMA(0, 0, At, B0); PG8_BAR; PG8_SCHED;
            PG8_LDB(B1, 1, 1); PG8_STAGE(PG8_SB(1, 0), b3, voffB);
            PG8_BAR; PG8_WAIT_L(0); PG8_MMA(0, 1, At, B1); PG8_BAR;
            PG8_LDA(At, 1, 1); PG8_STAGE(PG8_SA(1, 0), a3, voffA);
            PG8_BAR; PG8_WAIT_L(0); PG8_MMA(1, 0, At, B0); PG8_BAR; PG8_SCHED;
            PG8_STAGE(PG8_SB(1, 1), b3 + hstepB, voffB);
            PG8_WAIT_V(6); PG8_BAR; PG8_MMA(1, 1, At, B1); PG8_BAR;
        }
        { int fr_ = fr, fq_ = fq; asm volatile("" : "+v"(fr_), "+v"(fq_)); E(acc, cur, wr, wc, fr_, fq_); }
        if (!has_next) break;
#pragma unroll
        for (int a = 0; a < 2; ++a)
#pragma unroll
            for (int b = 0; b < 2; ++b)
#pragma unroll
                for (int m = 0; m < 4; ++m)
#pragma unroll
                    for (int n = 0; n < 2; ++n) acc[a][b][m][n] = (f32x4){0.f, 0.f, 0.f, 0.f};
        cur = nxt; cA = nA; cB = nB; ++ui;
    }
    PG8_WAIT_V(0);
    if (wr == 0) PG8_BAR;
    PG8_BAR;
#undef PG8_SA
#undef PG8_SB
#undef PG8_STAGE
#undef PG8_LDA
#undef PG8_LDB
#undef PG8_MMA
#undef PG8_WAIT_V
#undef PG8_WAIT_L
#undef PG8_BAR
#undef PG8_SCHED
}

typedef const f32x4 (&AccRef)[2][2][4][2];
#define EPI_PERM_LOOP(...) _Pragma("unroll") for (int ai = 0; ai < 2; ++ai) _Pragma("unroll") for (int m = 0; m < 4; ++m) { const int lr = ai * 128 + wr * 64 + m * 16 + fr; \
    _Pragma("unroll") for (int bj = 0; bj < 2; ++bj) { const int lc = bj * 128 + wc * 32 + 8 * fq; f32x4 v0 = acc[ai][bj][m][0], v1 = acc[ai][bj][m][1]; __VA_ARGS__ } }
#define EPI_PACK(w, v0, v1) u32x4 w; w.x = cvt_pk_bf16(v0[0], v0[1]); w.y = cvt_pk_bf16(v0[2], v0[3]); w.z = cvt_pk_bf16(v1[0], v1[1]); w.w = cvt_pk_bf16(v1[2], v1[3]);

struct EpiIn {
    static constexpr bool PERM = true;
    bf16_t* sg; bf16_t* us;
    DI void operator()(AccRef acc, const Unit& u, int wr, int wc, int fr, int fq) const {
        const int row0 = u.pm * BM;
        if (u.pn < 16) { bf16_t* base = sg + (size_t)row0 * 4096 + u.pn * BM;
            EPI_PERM_LOOP({ _Pragma("unroll") for (int j = 0; j < 4; ++j) { v0[j] = sigmoidf_(v0[j]); v1[j] = sigmoidf_(v1[j]); } u32x4 w; w.x = pk2(v0[0], v0[1]); w.y = pk2(v0[2], v0[3]); w.z = pk2(v1[0], v1[1]); w.w = pk2(v1[2], v1[3]); __builtin_nontemporal_store(w, (u32x4*)(base + (size_t)lr * 4096 + lc)); }) }
        else { bf16_t* base = us + (size_t)row0 * USW + (u.pn - 16) * BM;
            EPI_PERM_LOOP({ EPI_PACK(w, v0, v1); *(u32x4*)(base + (size_t)lr * USW + lc) = w; }) }
    }
};
struct EpiStore {
    static constexpr bool PERM = true;
    bf16_t* O; int ldc; const float* cscale; int mode;
    DI void operator()(AccRef acc, const Unit& u, int wr, int wc, int fr, int fq) const {
        size_t rb, cb;
        if (mode == 0) { rb = (size_t)u.pm * BM; cb = (size_t)u.pn * BM; }
        else if (mode == 1) { rb = (size_t)MC + u.pn * 1024 + u.pm * BM; cb = 512; }
        else { rb = (size_t)u.pm * BM; cb = 512; }
        bf16_t* base = O + rb * ldc + cb;
        if (cscale) { const float* cs = cscale + u.pn * BM;
            EPI_PERM_LOOP({ const f32x4 s0 = *(const f32x4*)(cs + lc), s1 = *(const f32x4*)(cs + lc + 4); v0 = v0 * s0; v1 = v1 * s1; EPI_PACK(w, v0, v1); *(u32x4*)(base + (size_t)lr * ldc + lc) = w; }) }
        else { EPI_PERM_LOOP({ EPI_PACK(w, v0, v1); *(u32x4*)(base + (size_t)lr * ldc + lc) = w; }) }
    }
};
struct EpiZt {
    static constexpr bool PERM = false;
    bf16_t* ztl; bf16_t* ztc;
    DI void operator()(AccRef acc, const Unit& u, int wr, int wc, int fr, int fq) const {
        const int row0 = u.pm * BM; bf16_t* base; int T, t0;
        if (row0 < MC) { T = 256; t0 = 0; base = ztc + (size_t)(row0 >> 8) * 256 * 512; } else { const int rr = row0 - MC; T = 1024; t0 = rr & 1023; base = ztl + (size_t)(rr >> 10) * 256 * 2048; }
        const int ldz = 2 * T;
#pragma unroll
        for (int ai = 0; ai < 2; ++ai)
#pragma unroll
            for (int m = 0; m < 4; ++m) { const int t = t0 + ai * 128 + wr * 64 + m * 16 + fr;
#pragma unroll
                for (int bj = 0; bj < 2; ++bj)
#pragma unroll
                    for (int n = 0; n < 2; ++n) { const int j = u.pn * BM + bj * 128 + wc * 32 + n * 16 + 4 * fq; const int g = j >> 7, hf = (j >> 6) & 1, cp = j & 63;
                        bf16_t* d = base + (size_t)(g * 64 + cp) * ldz + hf * T + t; const f32x4 v = acc[ai][bj][m][n];
                        d[0] = f2bf(v[0]); d[ldz] = f2bf(v[1]); d[2 * ldz] = f2bf(v[2]); d[3 * ldz] = f2bf(v[3]); } }
    }
};
struct EpiProj {
    static constexpr bool PERM = true;
    const bf16_t* sg; float* mp; bf16_t* mg;
    DI void operator()(AccRef acc, const Unit& u, int wr, int wc, int fr, int fq) const {
        const int n = u.z; const size_t row0 = (size_t)u.pm * BM; const int col0 = u.pn * BM;
        const bf16_t* sgb = sg + row0 * 4096 + n * 1024 + col0; float* mpb = mp + row0 * DM + col0; bf16_t* mgb = mg + row0 * DM + col0;
        EPI_PERM_LOOP({ const u32x4 gw = *(const u32x4*)(sgb + (size_t)lr * 4096 + lc);
            v0[0] *= bflo(gw.x); v0[1] *= bfhi(gw.x); v0[2] *= bflo(gw.y); v0[3] *= bfhi(gw.y); v1[0] *= bflo(gw.z); v1[1] *= bfhi(gw.z); v1[2] *= bflo(gw.w); v1[3] *= bfhi(gw.w);
            float* p = mpb + (size_t)lr * DM + lc;
            if (n > 0) { v0 = v0 + *(const f32x4*)p; v1 = v1 + *(const f32x4*)(p + 4); }
            if (n < 3) { *(f32x4*)p = v0; *(f32x4*)(p + 4) = v1; }
            else { EPI_PACK(w, v0, v1); *(u32x4*)(mgb + (size_t)lr * DM + lc) = w; } })
    }
};
struct EpiGate {
    static constexpr bool PERM = true;
    bf16_t* sg;
    DI void operator()(AccRef acc, const Unit& u, int wr, int wc, int fr, int fq) const {
        bf16_t* base = sg + (size_t)u.pm * BM * 4096 + u.pn * BM;
        EPI_PERM_LOOP({ bf16_t* p = base + (size_t)lr * 4096 + lc; const u32x4 gw = *(const u32x4*)p;
            v0[0] *= bflo(gw.x); v0[1] *= bfhi(gw.x); v0[2] *= bflo(gw.y); v0[3] *= bfhi(gw.y); v1[0] *= bflo(gw.z); v1[1] *= bfhi(gw.z); v1[2] *= bflo(gw.w); v1[3] *= bfhi(gw.w);
            EPI_PACK(w, v0, v1); *(u32x4*)p = w; })
    }
};
struct EpiResid {
    static constexpr bool PERM = false;
    const float* xp; const float* xs; float* out; const float* gate;
    DI void operator()(AccRef acc, const Unit& u, int wr, int wc, int fr, int fq) const {
        const int row0 = u.pm * BM; const float* bs = xp ? (row0 < MC ? xp + (size_t)row0 * DM : xs + (size_t)(row0 - MC) * DM) : out + (size_t)row0 * DM;
        float* ob = out + (size_t)row0 * DM; const float* gp = gate + (size_t)cond_row(row0) * 6144;
#pragma unroll
        for (int bj = 0; bj < 2; ++bj)
#pragma unroll
            for (int n = 0; n < 2; ++n) { const int col = u.pn * BM + bj * 128 + wc * 32 + n * 16 + 4 * fq; const f32x4 gv = *(const f32x4*)(gp + col);
#pragma unroll
                for (int ai = 0; ai < 2; ++ai)
#pragma unroll
                    for (int m = 0; m < 4; ++m) { const size_t off = (size_t)(ai * 128 + wr * 64 + m * 16 + fr) * DM + col;
                        const f32x4 b = *(const f32x4*)(bs + off); *(f32x4*)(ob + off) = b + gv * acc[ai][bj][m][n]; } }
    }
};
}

struct Params {
    const float* in[31];
    float* out; unsigned char* ws;
    int lo, hi;
};
enum { I_XP = 0, I_XS, I_C, I_CCTX, I_CDK, I_CDV, I_CCKV, I_CKR, I_WADA, I_BADA, I_GN1, I_GN2, I_WIN, I_POOLW, I_POOLS, I_DQN, I_DKN, I_DLAM, I_DSUB,
       I_QAN, I_WUQ, I_KVN, I_WUKV, I_MQN, I_MKN, I_WBR, I_WOUT, I_WUP, I_CONVW, I_CONVB, I_WDOWN };

DI void tr_load(const float* src, int R, int C, int tile, int tid, f32x4 (&v)[8]) {
    const int ntk = R / 64, tk = tile % ntk, tn = tile / ntk, k0 = tk * 64, n0 = tn * 256;
#pragma unroll
    for (int i = 0; i < 8; ++i) { const int k = (tid >> 6) + 8 * i, n = n0 + (tid & 63) * 4; v[i] = (f32x4){0.f, 0.f, 0.f, 0.f};
        if (n < C) v[i] = *(const f32x4*)(src + (size_t)(k0 + k) * C + n); }
}
DI void tr_store(LAS unsigned char* lds, bf16_t* dst, int R, int tile, int tid, const f32x4 (&v)[8]) {
    LAS float* T = (LAS float*)lds;
    const int ntk = R / 64, tk = tile % ntk, tn = tile / ntk, k0 = tk * 64, n0 = tn * 256;
    __syncthreads();
#pragma unroll
    for (int i = 0; i < 8; ++i) { const int k = (tid >> 6) + 8 * i; LAS float* t = T + k * 257 + (tid & 63) * 4; t[0] = v[i][0]; t[1] = v[i][1]; t[2] = v[i][2]; t[3] = v[i][3]; }
    __syncthreads();
#pragma unroll
    for (int j = 0; j < 4; ++j) { const int n = (tid >> 3) + 64 * j, kc = (tid & 7) * 8; u32x4 w;
        w.x = pk2(T[(kc + 0) * 257 + n], T[(kc + 1) * 257 + n]); w.y = pk2(T[(kc + 2) * 257 + n], T[(kc + 3) * 257 + n]);
        w.z = pk2(T[(kc + 4) * 257 + n], T[(kc + 5) * 257 + n]); w.w = pk2(T[(kc + 6) * 257 + n], T[(kc + 7) * 257 + n]);
        *(u32x4*)(dst + (size_t)(n0 + n) * R + k0 + kc) = w; }
}
DI void tr_job(LAS unsigned char* lds, const float* src, bf16_t* dst, int R, int C, int Cpad, int& base, int G, int c) {
    const int nt = (R / 64) * (Cpad / 256); int tid = threadIdx.x; asm volatile("" : "+v"(tid));
    int t = (c + G - (base % G)) % G; base += nt;
    if (t >= nt) return;
    f32x4 nx[8]; tr_load(src, R, C, t, tid, nx);
    for (; t < nt; t += G) {
        f32x4 cur[8];
#pragma unroll
        for (int i = 0; i < 8; ++i) cur[i] = nx[i];
        if (t + G < nt) tr_load(src, R, C, t + G, tid, nx);
        tr_store(lds, dst, R, t, tid, cur);
    }
}

DI void convert_layer_weights(const Params& p, LAS unsigned char* lds, int l, int G, int c) {
    unsigned char* ws = p.ws; int base = 0;
    tr_job(lds, p.in[I_WIN] + (size_t)l * DM * INC, (bf16_t*)(ws + WS_WIN + l * SZ_WIN), DM, INC, INP, base, G, c);
    tr_job(lds, p.in[I_WUP] + (size_t)l * DM * F2, (bf16_t*)(ws + WS_WUP + l * SZ_WUP), DM, F2, F2, base, G, c);
    tr_job(lds, p.in[I_WDOWN] + (size_t)l * FH * DM, (bf16_t*)(ws + WS_WD + l * SZ_WD), FH, DM, DM, base, G, c);
    tr_job(lds, p.in[I_WOUT] + (size_t)l * DM * DM, (bf16_t*)(ws + WS_WO + l * SZ_WO), DM, DM, DM, base, G, c);
    for (int n = 0; n < 4; ++n)
        tr_job(lds, p.in[I_WBR] + ((size_t)l * 4 + n) * 256 * DM, (bf16_t*)(ws + WS_WB + l * SZ_WB) + (size_t)n * 1024 * 256, 256, DM, DM, base, G, c);
    __syncthreads();
}

DI void phase_prepass(const Params& p, LAS unsigned char* lds, int G, int c) {
    unsigned char* ws = p.ws; int tid = threadIdx.x; asm volatile("" : "+v"(tid));
    convert_layer_weights(p, lds, 0, G, c);
    {
        LAS float* sc = (LAS float*)lds;
        for (int i = tid; i < 9 * 1024; i += NTHR) { const int r = i >> 10, k = i & 1023; const float v = r == 0 ? p.in[I_CCTX][k] : p.in[I_C][(r - 1) * 1024 + k]; sc[i] = v * sigmoidf_(v); }
        __syncthreads();
        LAS float* red = (LAS float*)(lds + 9 * 1024 * 4);
        float* mod = (float*)(ws + WS_MOD);
        for (int it = c; it < 192; it += G) {
            const int l = it / 48, col = (it % 48) * 128 + (tid & 127), kq = tid >> 7;
            const float* w = p.in[I_WADA] + (size_t)l * DM * 6144 + col;
            float a[9];
#pragma unroll
            for (int r = 0; r < 9; ++r) a[r] = 0.f;
#pragma unroll 8
            for (int k = kq * 256; k < kq * 256 + 256; ++k) { const float wv = w[(size_t)k * 6144];
#pragma unroll
                for (int r = 0; r < 9; ++r) a[r] += sc[r * 1024 + k] * wv; }
            __syncthreads();
#pragma unroll
            for (int r = 0; r < 9; ++r) red[(kq * 9 + r) * 128 + (tid & 127)] = a[r];
            __syncthreads();
            for (int i = tid; i < 9 * 128; i += NTHR) { const int r = i >> 7, cc = i & 127, colo = (it % 48) * 128 + cc;
                mod[((size_t)l * 9 + r) * 6144 + colo] = red[(0 * 9 + r) * 128 + cc] + red[(1 * 9 + r) * 128 + cc] + red[(2 * 9 + r) * 128 + cc] + red[(3 * 9 + r) * 128 + cc] + p.in[I_BADA][l * 6144 + colo]; }
        }
        __syncthreads();
    }
    const size_t gt = (size_t)c * NTHR + tid, gs = (size_t)G * NTHR;
    for (size_t i = gt; i < (size_t)NLAY * 512 * 256; i += gs) {
        const int l = (int)(i >> 17), n = (int)(i >> 8) & 511, k = (int)i & 255;
        { const int h = n >> 7, d = n & 127; float v = 0.f; if (d < 96 && k < 192) v = p.in[I_WUQ][((size_t)l * 192 + k) * 384 + h * 96 + d] * p.in[I_QAN][l * 192 + k];
          ((bf16_t*)(ws + WS_WUQ))[i] = f2bf(v); }
        { float v = 0.f, vp = 0.f; if (k < 128) { vp = p.in[I_WUKV][((size_t)l * 128 + k) * 512 + n]; v = vp * p.in[I_KVN][l * 128 + k]; }
          ((bf16_t*)(ws + WS_WUKV))[i] = f2bf(v); ((bf16_t*)(ws + WS_WUKVP))[i] = f2bf(vp); }
    }
    for (size_t i = gt; i < (size_t)512 * 256; i += gs) {
        const int j = (int)(i >> 8), k = (int)i & 255, g = j >> 7, hf = (j >> 6) & 1, cp = j & 63, g2 = k >> 6, cc = k & 63; float v = 0.f;
        if (g == g2) { const int m = (cp * cc) & 63; const float a = (float)m * (1.0f / 32.0f); v = (hf ? -sinpif(a) : cospif(a)) * 0.125f; }
        ((bf16_t*)(ws + WS_BDFT))[i] = f2bf(v);
    }
    for (size_t i = gt; i < (size_t)NLAY * 256 * 256; i += gs) {
        const int l = (int)(i >> 16), e = (int)(i >> 8) & 255, k = (int)i & 255; float v = 0.f;
        if ((e >> 6) == (k >> 6)) v = p.in[I_POOLW][(((size_t)l * 4 + (e >> 6)) * 64 + (k & 63)) * 64 + (e & 63)];
        ((bf16_t*)(ws + WS_BDPOOL))[i] = f2bf(v);
    }
    for (size_t i = gt; i < (size_t)1024 * 2048; i += gs) {
        const int kt = (int)(i >> 11), t = (int)i & 2047, tt = t & 1023; const int m = (kt * tt) & 1023; const float a = (float)m * (1.0f / 512.0f);
        ((bf16_t*)(ws + WS_D1024))[i] = f2bf((t < 1024 ? cospif(a) : sinpif(a)) * (1.0f / 32.0f));
    }
    for (size_t i = gt; i < (size_t)256 * 512; i += gs) {
        const int kt = (int)(i >> 9), t = (int)i & 511, tt = t & 255; const int m = (kt * tt) & 255; const float a = (float)m * (1.0f / 128.0f);
        ((bf16_t*)(ws + WS_D256))[i] = f2bf((t < 256 ? cospif(a) : sinpif(a)) * (1.0f / 16.0f));
    }
    for (size_t i = gt; i < (size_t)NLAY * 8 * 4 * 512 * 64; i += gs) {
        const int d = (int)i & 63, key = (int)(i >> 6) & 511, h = (int)(i >> 15) & 3, b = (int)(i >> 17) & 7, l = (int)(i >> 20);
        ((bf16_t*)(ws + WS_KDC))[i] = f2bf(p.in[I_CDK][((((size_t)b * 4 + l) * 512 + key) * 4 + h) * 64 + d]);
    }
    for (size_t i = gt; i < (size_t)NLAY * 8 * 4 * 64 * 512; i += gs) {
        const int key = (int)i & 511, dv = (int)(i >> 9) & 63, h = (int)(i >> 15) & 3, b = (int)(i >> 17) & 7, l = (int)(i >> 20);
        ((bf16_t*)(ws + WS_VDTC))[i] = f2bf(p.in[I_CDV][((((size_t)b * 4 + l) * 512 + key) * 4 + h) * 64 + dv]);
    }
    for (size_t i = gt; i < (size_t)NLAY * 4096 * 256; i += gs) {
        const int k = (int)i & 255, key = (int)(i >> 8) & 511, b = (int)(i >> 17) & 7, l = (int)(i >> 20);
        ((bf16_t*)(ws + WS_R1 + R1_AC))[i] = k < 128 ? f2bf(p.in[I_CCKV][(((size_t)b * 4 + l) * 512 + key) * 128 + k]) : (bf16_t)0;
    }
}

DI void phase_norm(const Params& p, int l, int which, bool from_input, int G, int c) {
    int tid_ = threadIdx.x; asm volatile("" : "+v"(tid_)); const int lane = tid_ & 63, wid = tid_ >> 6;
    const float* gn = p.in[which ? I_GN2 : I_GN1] + l * DM; const float* mod = (const float*)(p.ws + WS_MOD) + (size_t)l * 9 * 6144 + which * 3072;
    bf16_t* h = (bf16_t*)(p.ws + WS_HM);
    for (int rowa = c * 8 + wid; rowa < MT; rowa += 2 * G * 8) {
        const int rowb = rowa + G * 8; const bool hb = rowb < MT;
        const float* xa = from_input ? (rowa < MC ? p.in[I_XP] + (size_t)rowa * DM : p.in[I_XS] + (size_t)(rowa - MC) * DM) : p.out + (size_t)rowa * DM;
        const int rb = hb ? rowb : rowa;
        const float* xb = from_input ? (rb < MC ? p.in[I_XP] + (size_t)rb * DM : p.in[I_XS] + (size_t)(rb - MC) * DM) : p.out + (size_t)rb * DM;
        f32x4 va[4], vb[4]; float sa = 0.f, sb2 = 0.f;
#pragma unroll
        for (int i = 0; i < 4; ++i) { va[i] = *(const f32x4*)(xa + i * 256 + lane * 4); vb[i] = *(const f32x4*)(xb + i * 256 + lane * 4); }
#pragma unroll
        for (int i = 0; i < 4; ++i) { sa += va[i][0] * va[i][0] + va[i][1] * va[i][1] + va[i][2] * va[i][2] + va[i][3] * va[i][3]; sb2 += vb[i][0] * vb[i][0] + vb[i][1] * vb[i][1] + vb[i][2] * vb[i][2] + vb[i][3] * vb[i][3]; }
        for (int o = 32; o >= 1; o >>= 1) { sa += __shfl_xor(sa, o); sb2 += __shfl_xor(sb2, o); }
        const float rsa = rsqrtf(sa * (1.0f / DM) + EPSV), rsb = rsqrtf(sb2 * (1.0f / DM) + EPSV);
        const float* mra = mod + (size_t)cond_row(rowa) * 6144; const float* mrb = mod + (size_t)cond_row(rb) * 6144;
#pragma unroll
        for (int i = 0; i < 4; ++i) { const int col = i * 256 + lane * 4; const f32x4 g = *(const f32x4*)(gn + col);
            { const f32x4 sh = *(const f32x4*)(mra + col), sc = *(const f32x4*)(mra + 1024 + col); const f32x4 o = va[i] * rsa * g * (sc + 1.0f) + sh; u32x2 w; w.x = pk2(o[0], o[1]); w.y = pk2(o[2], o[3]); *(u32x2*)(h + (size_t)rowa * DM + col) = w; }
            if (hb) { const f32x4 sh = *(const f32x4*)(mrb + col), sc = *(const f32x4*)(mrb + 1024 + col); const f32x4 o = vb[i] * rsb * g * (sc + 1.0f) + sh; u32x2 w; w.x = pk2(o[0], o[1]); w.y = pk2(o[2], o[3]); *(u32x2*)(h + (size_t)rowb * DM + col) = w; } }
    }
}

DI void phase_c1_rows(const Params& p, LAS unsigned char* lds, int l, int G, int c) {
    int tid = threadIdx.x; asm volatile("" : "+v"(tid)); unsigned char* ws = p.ws;
    const bf16_t* us = (const bf16_t*)(ws + WS_R1 + R1_US);
    bf16_t* Qd = (bf16_t*)(ws + WS_HM + HM_QD); bf16_t* Kds = (bf16_t*)(ws + WS_KDS); bf16_t* VdTs = (bf16_t*)(ws + WS_VDTS); bf16_t* pooled = (bf16_t*)(ws + WS_R2 + R2_POOLED);
    const float* qn = p.in[I_DQN] + l * 32; const float* kn = p.in[I_DKN] + l * 32;
    LAS bf16_t* VT = (LAS bf16_t*)lds;
    LAS bf16_t* PT = (LAS bf16_t*)(lds + 64 * 264 * 2);
    for (int it = G - 1 - c; it < MT / 64; it += G) {
        const int r0 = it * 64; const bool lat = r0 >= MC; const int T = lat ? 1024 : 256, t0 = lat ? ((r0 - MC) & 1023) : (r0 & 255), sb = r0 - t0;
        __syncthreads();
        for (int q = tid; q < 64 * 32; q += NTHR) { const int t = q >> 5, ch = q & 31; *(LAS u32x4*)(VT + t * 264 + ch * 8) = *(const u32x4*)(us + (size_t)(r0 + t) * USW + US_V + ch * 8); }
        for (int q = tid; q < 80 * 32; q += NTHR) { const int tr = q >> 5, ch = q & 31, t = t0 - 8 + tr; u32x4 v = (u32x4){0u, 0u, 0u, 0u};
            if (t >= 0 && t < T) v = *(const u32x4*)(us + (size_t)(sb + t) * USW + US_POOL + ch * 8); *(LAS u32x4*)(PT + tr * 264 + ch * 8) = v; }
#pragma unroll
        for (int j = 0; j < 2; ++j) {
            const int vid = tid + NTHR * j, tl = vid >> 4, w = vid & 15, row = r0 + tl, t = t0 + tl; const bool isk = w >= 8; const int h = (w & 7) >> 1, hf = w & 1;
            const bf16_t* src = us + (size_t)row * USW + US_Q + w * 32;
            float y[32]; float ss = 0.f;
#pragma unroll
            for (int q = 0; q < 4; ++q) { const u32x4 v = *(const u32x4*)(src + q * 8);
                y[q * 8 + 0] = bflo(v.x); y[q * 8 + 1] = bfhi(v.x); y[q * 8 + 2] = bflo(v.y); y[q * 8 + 3] = bfhi(v.y); y[q * 8 + 4] = bflo(v.z); y[q * 8 + 5] = bfhi(v.z); y[q * 8 + 6] = bflo(v.w); y[q * 8 + 7] = bfhi(v.w); }
#pragma unroll
            for (int d = 0; d < 32; ++d) ss += y[d] * y[d];
            const float rs = rsqrtf(ss * (1.0f / 32.0f) + EPSV); const float* gnp = isk ? kn : qn;
#pragma unroll
            for (int d = 0; d < 32; ++d) y[d] = y[d] * rs * gnp[d];
            if (isk && !lat) { float* o = p.out + O_DK + ((size_t)((r0 >> 8) * 4 + l) * 256 + t) * 256 + h * 64 + hf * 32;
#pragma unroll
                for (int q = 0; q < 8; ++q) *(f32x4*)(o + q * 4) = (f32x4){y[q * 4], y[q * 4 + 1], y[q * 4 + 2], y[q * 4 + 3]}; }
            if (lat) { const float prow = (float)(t >> 6), pcol = (float)(t & 63); ROPE32(y, 0, prow, pcol); }
            bf16_t* dst = isk ? Kds + (size_t)sb * 256 + ((size_t)h * T + t) * 64 + hf * 32 : Qd + (size_t)row * 256 + h * 64 + hf * 32;
#pragma unroll
            for (int q = 0; q < 4; ++q) { u32x4 wv; wv.x = pk2(y[q * 8], y[q * 8 + 1]); wv.y = pk2(y[q * 8 + 2], y[q * 8 + 3]); wv.z = pk2(y[q * 8 + 4], y[q * 8 + 5]); wv.w = pk2(y[q * 8 + 6], y[q * 8 + 7]); *(u32x4*)(dst + q * 8) = wv; }
        }
        __syncthreads();
        if (!lat) { float* o = p.out + O_DV + ((size_t)((r0 >> 8) * 4 + l) * 256 + t0) * 256;
            for (int q = tid; q < 64 * 256; q += NTHR) o[q] = bf2f(VT[(q >> 8) * 264 + (q & 255)]); }
        { const int cidx = tid & 255, th = tid >> 8; bf16_t* dst = VdTs + (size_t)sb * 256 + ((size_t)(cidx >> 6) * 64 + (cidx & 63)) * T + t0 + th * 32;
#pragma unroll
          for (int q = 0; q < 4; ++q) { u32x4 wv; const LAS bf16_t* s = VT + (th * 32 + q * 8) * 264 + cidx;
              wv.x = (unsigned)s[0] | ((unsigned)s[264] << 16); wv.y = (unsigned)s[2 * 264] | ((unsigned)s[3 * 264] << 16); wv.z = (unsigned)s[4 * 264] | ((unsigned)s[5 * 264] << 16); wv.w = (unsigned)s[6 * 264] | ((unsigned)s[7 * 264] << 16);
              *(u32x4*)(dst + q * 8) = wv; } }
        { const int cidx = tid & 255, th = tid >> 8, hw = 1 << (cidx >> 6);
          const int tf = t0 + th * 32; float s = 0.f;
          { const int lo = max(tf - hw, 0), hi = min(tf + hw, T); for (int tt = lo; tt < hi; ++tt) s += bf2f(PT[(tt - t0 + 8) * 264 + cidx]); }
          for (int q = 0; q < 32; ++q) { const int tl = th * 32 + q, t = t0 + tl; const int lo = max(t - hw, 0), hi = min(t + hw, T);
              const float v = s * __builtin_amdgcn_rcpf((float)(hi - lo)) - bf2f(PT[(tl + 8) * 264 + cidx]); pooled[(size_t)(r0 + tl) * 256 + cidx] = f2bf(v);
              if (t + hw < T) s += bf2f(PT[(t + hw - t0 + 8) * 264 + cidx]);
              if (t - hw >= 0) s -= bf2f(PT[(t - hw - t0 + 8) * 264 + cidx]); } }
    }
    __syncthreads();
}

DI float sumsq8(const u32x4 v) { const float a0 = bflo(v.x), a1 = bfhi(v.x), a2 = bflo(v.y), a3 = bfhi(v.y), a4 = bflo(v.z), a5 = bfhi(v.z), a6 = bflo(v.w), a7 = bfhi(v.w);
    return a0 * a0 + a1 * a1 + a2 * a2 + a3 * a3 + a4 * a4 + a5 * a5 + a6 * a6 + a7 * a7; }
DI u32x4 scale8(const u32x4 v, float sc, const float* g) { const f32x4 g0 = *(const f32x4*)g, g1 = *(const f32x4*)(g + 4); u32x4 w;
    w.x = pk2(bflo(v.x) * sc * g0[0], bfhi(v.x) * sc * g0[1]); w.y = pk2(bflo(v.y) * sc * g0[2], bfhi(v.y) * sc * g0[3]);
    w.z = pk2(bflo(v.z) * sc * g1[0], bfhi(v.z) * sc * g1[1]); w.w = pk2(bflo(v.w) * sc * g1[2], bfhi(v.w) * sc * g1[3]); return w; }
DI u32x4 scale8n(const u32x4 v, float sc) { u32x4 w; w.x = pk2(bflo(v.x) * sc, bfhi(v.x) * sc); w.y = pk2(bflo(v.y) * sc, bfhi(v.y) * sc); w.z = pk2(bflo(v.z) * sc, bfhi(v.z) * sc); w.w = pk2(bflo(v.w) * sc, bfhi(v.w) * sc); return w; }
#define UNPK8(y, o, v) do { y[(o) + 0] = bflo(v.x); y[(o) + 1] = bfhi(v.x); y[(o) + 2] = bflo(v.y); y[(o) + 3] = bfhi(v.y); y[(o) + 4] = bflo(v.z); y[(o) + 5] = bfhi(v.z); y[(o) + 6] = bflo(v.w); y[(o) + 7] = bfhi(v.w); } while (0)
template <bool CACHE>
DI void phase_mla_finish(const Params& p, LAS unsigned char* lds, int l, int G, int c) {
    int tid = threadIdx.x; asm volatile("" : "+v"(tid)); unsigned char* ws = p.ws;
    const bf16_t* us = (const bf16_t*)(ws + WS_R1 + R1_US);
    LAS bf16_t* VT = (LAS bf16_t*)lds;
    const int nitems = CACHE ? NLAY * 4096 / 64 : MT / 64;
    const int it_first = CACHE ? c : (G == 256 ? (c >= 96 ? c - 96 : (c < 32 ? 160 + c : nitems)) : G - 1 - c);
    for (int it = it_first; it < nitems; it += G) {
        int r0, T, t0, sb, lay; bool lat;
        if (CACHE) { lay = it >> 6; r0 = (it & 63) * 64; lat = false; T = 512; t0 = r0 & 511; sb = r0 - t0; }
        else { lay = l; r0 = it * 64; lat = r0 >= MC; T = lat ? 1024 : 256; t0 = lat ? ((r0 - MC) & 1023) : (r0 & 255); sb = r0 - t0; }
        const int role = tid >> 8, tl = (tid & 255) >> 2, h = tid & 3, row = r0 + tl, t = t0 + tl;
        const float prow = (float)(t >> 6), pcol = (float)(t & 63);
        __syncthreads();
        if (role == 0 && !CACHE) {
            const bf16_t* cq = us + (size_t)row * USW + US_CQ + h * 48; float ss = 0.f;
#pragma unroll
            for (int q = 0; q < 6; ++q) ss += sumsq8(*(const u32x4*)(cq + q * 8));
            ss += __shfl_xor(ss, 1); ss += __shfl_xor(ss, 2);
            const float rq = rsqrtf(ss * (1.0f / 192.0f) + EPSV);
            const bf16_t* src = (const bf16_t*)(ws + WS_R2 + R2_QRAW) + (size_t)row * 512 + h * 128;
            float s2 = 0.f;
#pragma unroll
            for (int q = 0; q < 12; ++q) s2 += sumsq8(*(const u32x4*)(src + q * 8));
            s2 *= rq * rq;
            const float r2 = rsqrtf(s2 * (1.0f / 96.0f) + EPSV) * rq; const float* gq = p.in[I_MQN] + lay * 96;
            bf16_t* dst = (bf16_t*)(ws + WS_HM + HM_QM) + (size_t)row * 384 + h * 96;
#pragma unroll
            for (int q = 0; q < 8; ++q) *(u32x4*)(dst + q * 8) = scale8(*(const u32x4*)(src + q * 8), r2, gq + q * 8);
            float y[32];
#pragma unroll
            for (int q = 0; q < 4; ++q) { const u32x4 v = *(const u32x4*)(src + 64 + q * 8); UNPK8(y, q * 8, v); }
#pragma unroll
            for (int d = 0; d < 32; ++d) y[d] = y[d] * r2 * gq[64 + d];
            if (lat) ROPE32(y, 0, prow, pcol);
#pragma unroll
            for (int q = 0; q < 4; ++q) { u32x4 wv; wv.x = pk2(y[q * 8], y[q * 8 + 1]); wv.y = pk2(y[q * 8 + 2], y[q * 8 + 3]); wv.z = pk2(y[q * 8 + 4], y[q * 8 + 5]); wv.w = pk2(y[q * 8 + 6], y[q * 8 + 7]); *(u32x4*)(dst + 64 + q * 8) = wv; }
        }
        if (role == 1) {
            float rkv = 1.0f;
            const int b = r0 >> (CACHE ? 9 : 8);
            if (!CACHE) {
                const bf16_t* ck = us + (size_t)row * USW + US_CKV + h * 32; float ss = 0.f;
#pragma unroll
                for (int q = 0; q < 4; ++q) ss += sumsq8(*(const u32x4*)(ck + q * 8));
                ss += __shfl_xor(ss, 1); ss += __shfl_xor(ss, 2);
                rkv = rsqrtf(ss * (1.0f / 128.0f) + EPSV);
                if (!lat) { const float* gk = p.in[I_KVN] + lay * 128 + h * 32; float* o = p.out + O_CKV + ((size_t)(b * 4 + lay) * 256 + t) * 128 + h * 32;
#pragma unroll
                    for (int q = 0; q < 4; ++q) { const u32x4 v = *(const u32x4*)(ck + q * 8); const f32x4 g0 = *(const f32x4*)(gk + q * 8), g1 = *(const f32x4*)(gk + q * 8 + 4);
                        *(f32x4*)(o + q * 8) = (f32x4){bflo(v.x) * rkv * g0[0], bfhi(v.x) * rkv * g0[1], bflo(v.y) * rkv * g0[2], bfhi(v.y) * rkv * g0[3]};
                        *(f32x4*)(o + q * 8 + 4) = (f32x4){bflo(v.z) * rkv * g1[0], bfhi(v.z) * rkv * g1[1], bflo(v.w) * rkv * g1[2], bfhi(v.w) * rkv * g1[3]}; } }
            }
            float y[32];
            if (CACHE) { const float* krp = p.in[I_CKR] + ((size_t)(b * 4 + lay) * 512 + t) * 32;
#pragma unroll
                for (int q = 0; q < 8; ++q) { const f32x4 v = *(const f32x4*)(krp + q * 4); y[q * 4] = v[0]; y[q * 4 + 1] = v[1]; y[q * 4 + 2] = v[2]; y[q * 4 + 3] = v[3]; } }
            else { const bf16_t* krp = us + (size_t)row * USW + US_KR;
#pragma unroll
                for (int q = 0; q < 4; ++q) { const u32x4 v = *(const u32x4*)(krp + q * 8); UNPK8(y, q * 8, v); }
                if (!lat) { float* o = p.out + O_KR + ((size_t)(b * 4 + lay) * 256 + t) * 32 + h * 8; const u32x4 v = *(const u32x4*)(krp + h * 8);
                    *(f32x4*)o = (f32x4){bflo(v.x), bfhi(v.x), bflo(v.y), bfhi(v.y)}; *(f32x4*)(o + 4) = (f32x4){bflo(v.z), bfhi(v.z), bflo(v.w), bfhi(v.w)}; } }
            const bf16_t* src = CACHE ? (const bf16_t*)(ws + WS_R1 + R1_KVRC) + ((size_t)lay * 4096 + row) * 512 + h * 128 : (const bf16_t*)(ws + WS_R2 + R2_KVRAW) + (size_t)row * 512 + h * 128;
            float s2 = 0.f, s3 = 0.f;
#pragma unroll
            for (int q = 0; q < 8; ++q) s2 += sumsq8(*(const u32x4*)(src + q * 8));
#pragma unroll
            for (int d = 0; d < 32; ++d) s3 += y[d] * y[d];
            s2 = s2 * rkv * rkv + s3;
            const float r2 = rsqrtf(s2 * (1.0f / 96.0f) + EPSV); const float* gk2 = p.in[I_MKN] + lay * 96;
            bf16_t* dst = CACHE ? (bf16_t*)(ws + WS_KMC) + ((((size_t)lay * 8 + b) * 4 + h) * 512 + t) * 96 : (bf16_t*)(ws + WS_HM + HM_KMS) + (size_t)sb * 384 + ((size_t)h * T + t) * 96;
#pragma unroll
            for (int q = 0; q < 8; ++q) *(u32x4*)(dst + q * 8) = scale8(*(const u32x4*)(src + q * 8), r2 * rkv, gk2 + q * 8);
#pragma unroll
            for (int q = 0; q < 8; ++q) *(LAS u32x4*)(VT + tl * 264 + h * 64 + q * 8) = scale8n(*(const u32x4*)(src + 64 + q * 8), rkv);
#pragma unroll
            for (int d = 0; d < 32; ++d) y[d] = y[d] * r2 * gk2[64 + d];
            if (lat) ROPE32(y, 0, prow, pcol);
#pragma unroll
            for (int q = 0; q < 4; ++q) { u32x4 wv; wv.x = pk2(y[q * 8], y[q * 8 + 1]); wv.y = pk2(y[q * 8 + 2], y[q * 8 + 3]); wv.z = pk2(y[q * 8 + 4], y[q * 8 + 5]); wv.w = pk2(y[q * 8 + 6], y[q * 8 + 7]); *(u32x4*)(dst + 64 + q * 8) = wv; }
        }
        __syncthreads();
        { const int cidx = tid & 255, th = tid >> 8; const int b = r0 >> 9;
          bf16_t* dst = CACHE ? (bf16_t*)(ws + WS_VMTC) + ((((size_t)lay * 8 + b) * 4 + (cidx >> 6)) * 64 + (cidx & 63)) * 512 + t0 + th * 32
                              : (bf16_t*)(ws + WS_VMTS) + (size_t)sb * 256 + ((size_t)(cidx >> 6) * 64 + (cidx & 63)) * T + t0 + th * 32;
#pragma unroll
          for (int q = 0; q < 4; ++q) { u32x4 wv; const LAS bf16_t* s = VT + (th * 32 + q * 8) * 264 + cidx;
              wv.x = (unsigned)s[0] | ((unsigned)s[264] << 16); wv.y = (unsigned)s[2 * 264] | ((unsigned)s[3 * 264] << 16); wv.z = (unsigned)s[4 * 264] | ((unsigned)s[5 * 264] << 16); wv.w = (unsigned)s[6 * 264] | ((unsigned)s[7 * 264] << 16);
              *(u32x4*)(dst + q * 8) = wv; } }
    }
    __syncthreads();
}

template <bool DIFF>
DI void attn_item(LAS unsigned char* lds, const bf16_t* Qp, int qstride, const bf16_t* K0, const bf16_t* VT0, int n0, int vts0, const bf16_t* K1, const bf16_t* VT1, int n1, int vts1,
                  bf16_t* outp, float cscale, float lam, const float* subln, float oscale) {
    constexpr int KD = DIFF ? 64 : 96, KP = KD + 8, NP = KD / 32, CPK = KD / 8;
    int tid = threadIdx.x; asm volatile("" : "+v"(tid)); const int lane = tid & 63, wid = tid >> 6, fr = lane & 15, g = lane >> 4;
    bf16x8 qf[NP];
#pragma unroll
    for (int pi = 0; pi < NP; ++pi) { u32x4 w = *(const u32x4*)(Qp + (size_t)(wid * 16 + fr) * qstride + pi * 32 + g * 8);
        w.x = pk2(bflo(w.x) * cscale, bfhi(w.x) * cscale); w.y = pk2(bflo(w.y) * cscale, bfhi(w.y) * cscale); w.z = pk2(bflo(w.z) * cscale, bfhi(w.z) * cscale); w.w = pk2(bflo(w.w) * cscale, bfhi(w.w) * cscale);
        qf[pi] = __builtin_bit_cast(bf16x8, w); }
    f32x4 O1[4], O2[4];
#pragma unroll
    for (int i = 0; i < 4; ++i) { O1[i] = (f32x4){0.f, 0.f, 0.f, 0.f}; O2[i] = (f32x4){0.f, 0.f, 0.f, 0.f}; }
    float l1 = 0.f, l2 = 0.f;
    const int nt0 = n0 >> 6, ntt = nt0 + (n1 >> 6);
    u32x4 pk0, pk1 = (u32x4){0u, 0u, 0u, 0u}, pv;
#define ATT_PREFETCH(ti) do { const bool s_ = (ti) >= nt0; const bf16_t* Kb = s_ ? K1 + (size_t)((ti) - nt0) * 64 * KD : K0 + (size_t)(ti) * 64 * KD; \
        const bf16_t* Vb = s_ ? VT1 + ((ti) - nt0) * 64 : VT0 + (ti) * 64; const int vs = s_ ? vts1 : vts0; \
        pk0 = *(const u32x4*)(Kb + tid * 8); if (!DIFF && tid < 256) pk1 = *(const u32x4*)(Kb + (512 + tid) * 8); pv = *(const u32x4*)(Vb + (size_t)(tid >> 3) * vs + (tid & 7) * 8); } while (0)
    constexpr int TILE_B = 64 * KP * 2 + 64 * 72 * 2;
#define ATT_STORE(buf) do { LAS bf16_t* Kt_ = (LAS bf16_t*)(lds + (buf) * TILE_B); LAS bf16_t* Vt_ = (LAS bf16_t*)(lds + (buf) * TILE_B + 64 * KP * 2); \
        *(LAS u32x4*)(Kt_ + (tid / CPK) * KP + (tid % CPK) * 8) = pk0; \
        if (!DIFF && tid < 256) { const int q_ = 512 + tid; *(LAS u32x4*)(Kt_ + (q_ / CPK) * KP + (q_ % CPK) * 8) = pk1; } \
        *(LAS u32x4*)(Vt_ + (tid >> 3) * 72 + (tid & 7) * 8) = pv; } while (0)
    ATT_PREFETCH(0);
    __syncthreads();
    ATT_STORE(0);
    if (ntt > 1) ATT_PREFETCH(1);
    __syncthreads();
    for (int ti = 0; ti < ntt; ++ti) {
        const LAS bf16_t* Kt = (const LAS bf16_t*)(lds + (ti & 1) * TILE_B); const LAS bf16_t* Vt = (const LAS bf16_t*)(lds + (ti & 1) * TILE_B + 64 * KP * 2);
        if (ti + 1 < ntt) { ATT_STORE((ti + 1) & 1); if (ti + 2 < ntt) ATT_PREFETCH(ti + 2); }
        f32x4 s1[4], s2[4];
#pragma unroll
        for (int kb = 0; kb < 4; ++kb) {
            const LAS bf16_t* kr = Kt + (kb * 16 + fr) * KP + g * 8; const f32x4 z = (f32x4){0.f, 0.f, 0.f, 0.f};
            if (DIFF) { s1[kb] = __builtin_amdgcn_mfma_f32_16x16x32_bf16(*(const LAS bf16x8*)kr, qf[0], z, 0, 0, 0); s2[kb] = __builtin_amdgcn_mfma_f32_16x16x32_bf16(*(const LAS bf16x8*)(kr + 32), qf[NP > 1 ? 1 : 0], z, 0, 0, 0); }
            else { f32x4 a = __builtin_amdgcn_mfma_f32_16x16x32_bf16(*(const LAS bf16x8*)kr, qf[0], z, 0, 0, 0); a = __builtin_amdgcn_mfma_f32_16x16x32_bf16(*(const LAS bf16x8*)(kr + 32), qf[NP > 1 ? 1 : 0], a, 0, 0, 0);
                   s1[kb] = __builtin_amdgcn_mfma_f32_16x16x32_bf16(*(const LAS bf16x8*)(kr + 64), qf[NP > 2 ? 2 : 0], a, 0, 0, 0); s2[kb] = z; }
        }
#pragma unroll
        for (int kb = 0; kb < 4; ++kb)
#pragma unroll
            for (int r = 0; r < 4; ++r) { const float e1 = __builtin_amdgcn_exp2f(s1[kb][r]); s1[kb][r] = e1; l1 += e1;
                if (DIFF) { const float e2 = __builtin_amdgcn_exp2f(s2[kb][r]); s2[kb][r] = e2; l2 += e2; } }
        bf16x8 pb1[2], pb2[2];
#pragma unroll
        for (int pp = 0; pp < 2; ++pp) { u32x4 w; w.x = pk2(s1[2 * pp][0], s1[2 * pp][1]); w.y = pk2(s1[2 * pp][2], s1[2 * pp][3]); w.z = pk2(s1[2 * pp + 1][0], s1[2 * pp + 1][1]); w.w = pk2(s1[2 * pp + 1][2], s1[2 * pp + 1][3]);
            pb1[pp] = __builtin_bit_cast(bf16x8, w);
            if (DIFF) { u32x4 w2; w2.x = pk2(s2[2 * pp][0], s2[2 * pp][1]); w2.y = pk2(s2[2 * pp][2], s2[2 * pp][3]); w2.z = pk2(s2[2 * pp + 1][0], s2[2 * pp + 1][1]); w2.w = pk2(s2[2 * pp + 1][2], s2[2 * pp + 1][3]); pb2[pp] = __builtin_bit_cast(bf16x8, w2); } }
#pragma unroll
        for (int dvb = 0; dvb < 4; ++dvb)
#pragma unroll
            for (int pp = 0; pp < 2; ++pp) { const LAS bf16_t* vr = Vt + (dvb * 16 + fr) * 72 + pp * 32 + g * 4;
                const u32x2 lo = *(const LAS u32x2*)vr, hi = *(const LAS u32x2*)(vr + 16); const u32x4 vv = (u32x4){lo.x, lo.y, hi.x, hi.y}; const bf16x8 vf = __builtin_bit_cast(bf16x8, vv);
                O1[dvb] = __builtin_amdgcn_mfma_f32_16x16x32_bf16(vf, pb1[pp], O1[dvb], 0, 0, 0);
                if (DIFF) O2[dvb] = __builtin_amdgcn_mfma_f32_16x16x32_bf16(vf, pb2[pp], O2[dvb], 0, 0, 0); }
        __syncthreads();
    }
#undef ATT_PREFETCH
#undef ATT_STORE
    l1 += __shfl_xor(l1, 16); l1 += __shfl_xor(l1, 32);
    const float i1 = 1.0f / l1; float o[4][4];
    if (DIFF) { l2 += __shfl_xor(l2, 16); l2 += __shfl_xor(l2, 32); const float i2 = lam / l2; float ss = 0.f;
#pragma unroll
        for (int dvb = 0; dvb < 4; ++dvb)
#pragma unroll
            for (int r = 0; r < 4; ++r) { o[dvb][r] = O1[dvb][r] * i1 - O2[dvb][r] * i2; ss += o[dvb][r] * o[dvb][r]; }
        ss += __shfl_xor(ss, 16); ss += __shfl_xor(ss, 32);
        const float rn = rsqrtf(ss * (1.0f / 64.0f) + EPSV) * oscale;
#pragma unroll
        for (int dvb = 0; dvb < 4; ++dvb)
#pragma unroll
            for (int r = 0; r < 4; ++r) o[dvb][r] = o[dvb][r] * rn * subln[dvb * 16 + g * 4 + r];
    } else {
#pragma unroll
        for (int dvb = 0; dvb < 4; ++dvb)
#pragma unroll
            for (int r = 0; r < 4; ++r) o[dvb][r] = O1[dvb][r] * i1;
    }
    bf16_t* orow = outp + (size_t)(wid * 16 + fr) * DM + g * 4;
#pragma unroll
    for (int dvb = 0; dvb < 4; ++dvb) { u32x2 w; w.x = pk2(o[dvb][0], o[dvb][1]); w.y = pk2(o[dvb][2], o[dvb][3]); *(u32x2*)(orow + dvb * 16) = w; }
}

DI void phase_attn(const Params& p, LAS unsigned char* lds, int l, int G, int c) {
    unsigned char* ws = p.ws;
    const float* lq = p.in[I_DLAM] + l * 128; float d01 = 0.f, d23 = 0.f;
    for (int i = 0; i < 32; ++i) { d01 += lq[i] * lq[32 + i]; d23 += lq[64 + i] * lq[96 + i]; }
    const float lam_init = 0.8f - 0.6f * expf(-0.3f * (float)l), lam = expf(d01) - expf(d23) + lam_init;
    const bf16_t* Qd = (const bf16_t*)(ws + WS_HM + HM_QD); const bf16_t* Qm = (const bf16_t*)(ws + WS_HM + HM_QM);
    const bf16_t* Kds = (const bf16_t*)(ws + WS_KDS); const bf16_t* VdTs = (const bf16_t*)(ws + WS_VDTS); const bf16_t* Kms = (const bf16_t*)(ws + WS_HM + HM_KMS); const bf16_t* VmTs = (const bf16_t*)(ws + WS_VMTS);
    const bf16_t* Kdc = (const bf16_t*)(ws + WS_KDC); const bf16_t* VdTc = (const bf16_t*)(ws + WS_VDTC); const bf16_t* Kmc = (const bf16_t*)(ws + WS_KMC); const bf16_t* VmTc = (const bf16_t*)(ws + WS_VMTC);
    bf16_t* br = (bf16_t*)(ws + WS_R2 + R2_BR);
    const float cs_da = 0.17677669529663687f * 1.4426950408889634f, cs_ml = 0.10206207261596577f * 1.4426950408889634f;
    for (int L = c; L < 768; L += G) {
        bool mla, lat; int b, h, qb;
        if (L < 512) { lat = true; mla = L >= 256; const int i = L & 255; b = i >> 5; h = (i >> 3) & 3; qb = i & 7; }
        else { lat = false; const int i = L - 512; mla = i >= 128; const int j = i & 127; b = j >> 3; h = (j >> 1) & 3; qb = j & 1; }
        const int T = lat ? 1024 : 256, sb = lat ? MC + b * 1024 : b * 256, row0 = sb + qb * 128, n0 = lat ? 512 : 0;
        const size_t cidx = ((size_t)(l * 8 + b) * 4 + h);
        if (!mla) attn_item<true>(lds, Qd + (size_t)row0 * 256 + h * 64, 256, Kdc + cidx * 512 * 64, VdTc + cidx * 64 * 512, n0, 512, Kds + (size_t)sb * 256 + (size_t)h * T * 64, VdTs + (size_t)sb * 256 + (size_t)h * 64 * T, T, T,
                                  br + (size_t)row0 * DM + 256 + h * 64, cs_da, lam, p.in[I_DSUB] + l * 64, 1.0f - lam_init);
        else attn_item<false>(lds, Qm + (size_t)row0 * 384 + h * 96, 384, Kmc + cidx * 512 * 96, VmTc + cidx * 64 * 512, n0, 512, Kms + (size_t)sb * 384 + (size_t)h * T * 96, VmTs + (size_t)sb * 256 + (size_t)h * 64 * T, T, T,
                              br + (size_t)row0 * DM + 768 + h * 64, cs_ml, 0.f, nullptr, 1.0f);
    }
    __syncthreads();
}

DI void phase_convact(const Params& p, int l, int G, int c) {
    const bf16_t* u2 = (const bf16_t*)(p.ws + WS_R1); bf16_t* act = (bf16_t*)(p.ws + WS_R2);
    const float* cw = p.in[I_CONVW] + (size_t)l * 3 * F2; const float* cbp = p.in[I_CONVB] + (size_t)l * F2;
    int tidc = threadIdx.x; asm volatile("" : "+v"(tidc));
    for (size_t idx = (size_t)c * NTHR + tidc; idx < (size_t)(MT / 8) * 352; idx += (size_t)G * NTHR) {
        const int ch = (int)(idx % 352), seg = (int)(idx / 352), f = ch * 8, r0 = seg * 8;
        const bool lat = r0 >= MC; const int T = lat ? 1024 : 256, t0 = lat ? ((r0 - MC) & 1023) : (r0 & 255);
        float wg[3][8], wv[3][8], bg[8], bv[8];
#pragma unroll
        for (int j = 0; j < 3; ++j)
#pragma unroll
            for (int q = 0; q < 2; ++q) { const f32x4 a = *(const f32x4*)(cw + j * F2 + f + q * 4), b = *(const f32x4*)(cw + j * F2 + FH + f + q * 4);
#pragma unroll
                for (int e = 0; e < 4; ++e) { wg[j][q * 4 + e] = a[e]; wv[j][q * 4 + e] = b[e]; } }
#pragma unroll
        for (int q = 0; q < 2; ++q) { const f32x4 a = *(const f32x4*)(cbp + f + q * 4), b = *(const f32x4*)(cbp + FH + f + q * 4);
#pragma unroll
            for (int e = 0; e < 4; ++e) { bg[q * 4 + e] = a[e]; bv[q * 4 + e] = b[e]; } }
        const u32x4 zz = (u32x4){0u, 0u, 0u, 0u};
        u32x4 pg = t0 > 0 ? *(const u32x4*)(u2 + (size_t)(r0 - 1) * F2 + f) : zz, pvv = t0 > 0 ? *(const u32x4*)(u2 + (size_t)(r0 - 1) * F2 + FH + f) : zz;
        u32x4 cg_ = *(const u32x4*)(u2 + (size_t)r0 * F2 + f), cv_ = *(const u32x4*)(u2 + (size_t)r0 * F2 + FH + f);
#pragma unroll 2
        for (int i = 0; i < 8; ++i) {
            const bool hn = (t0 + i + 1) < T;
            const u32x4 ng = hn ? *(const u32x4*)(u2 + (size_t)(r0 + i + 1) * F2 + f) : zz, nv = hn ? *(const u32x4*)(u2 + (size_t)(r0 + i + 1) * F2 + FH + f) : zz;
            float o[8];
#define CA_ONE(e, PW, CW, NW, PV, CV, NV, HI) { const float gp = HI ? bfhi(PW) : bflo(PW), gc = HI ? bfhi(CW) : bflo(CW), gn = HI ? bfhi(NW) : bflo(NW); \
                const float vp = HI ? bfhi(PV) : bflo(PV), vc = HI ? bfhi(CV) : bflo(CV), vn = HI ? bfhi(NV) : bflo(NV); \
                const float Gv = wg[0][e] * gp + wg[1][e] * gc + wg[2][e] * gn + bg[e], Vv = wv[0][e] * vp + wv[1][e] * vc + wv[2][e] * vn + bv[e]; o[e] = Gv * sigmoidf_(Gv) * Vv; }
            CA_ONE(0, pg.x, cg_.x, ng.x, pvv.x, cv_.x, nv.x, 0) CA_ONE(1, pg.x, cg_.x, ng.x, pvv.x, cv_.x, nv.x, 1)
            CA_ONE(2, pg.y, cg_.y, ng.y, pvv.y, cv_.y, nv.y, 0) CA_ONE(3, pg.y, cg_.y, ng.y, pvv.y, cv_.y, nv.y, 1)
            CA_ONE(4, pg.z, cg_.z, ng.z, pvv.z, cv_.z, nv.z, 0) CA_ONE(5, pg.z, cg_.z, ng.z, pvv.z, cv_.z, nv.z, 1)
            CA_ONE(6, pg.w, cg_.w, ng.w, pvv.w, cv_.w, nv.w, 0) CA_ONE(7, pg.w, cg_.w, ng.w, pvv.w, cv_.w, nv.w, 1)
#undef CA_ONE
            u32x4 w; w.x = pk2(o[0], o[1]); w.y = pk2(o[2], o[3]); w.z = pk2(o[4], o[5]); w.w = pk2(o[6], o[7]);
            *(u32x4*)(act + (size_t)(r0 + i) * FH + f) = w;
            pg = cg_; pvv = cv_; cg_ = ng; cv_ = nv;
        }
    }
}


DI void gbar(unsigned* ctr, unsigned G) {
    asm volatile("s_waitcnt vmcnt(0) lgkmcnt(0)" ::: "memory");
    __syncthreads();
    if (threadIdx.x < 64) {
        if (threadIdx.x == 0) {
            __builtin_amdgcn_fence(__ATOMIC_RELEASE, "agent");
            asm volatile("s_waitcnt vmcnt(0)" ::: "memory");
            __hip_atomic_fetch_add(ctr, 1u, __ATOMIC_RELAXED, __HIP_MEMORY_SCOPE_AGENT);
            const unsigned long long t0 = __builtin_amdgcn_s_memrealtime();
            while (__hip_atomic_load(ctr, __ATOMIC_RELAXED, __HIP_MEMORY_SCOPE_AGENT) < G) {
                __builtin_amdgcn_s_sleep(2);
                if (__builtin_amdgcn_s_memrealtime() - t0 > 20000000ull) break;
            }
        }
        __builtin_amdgcn_fence(__ATOMIC_ACQUIRE, "agent");
        asm volatile("s_waitcnt vmcnt(0)" ::: "memory");
    }
    __syncthreads();
}

#define XB_TMO      128
#define XB_XCNT(j)  (256  + 64 * (j))
#define XB_XSUB(j)  (1280 + 64 * (j))
#define XB_XGEN(j)  (2304 + 64 * (j))
#define XB_TOP      3328
#define XB_TOPGEN   3392
#define XCD_BAR_WORDS 3456
#define XB_SPIN_CAP (1u << 18)
DI unsigned xb_ld(unsigned* p)              { return __hip_atomic_load(p, __ATOMIC_RELAXED, __HIP_MEMORY_SCOPE_AGENT); }
DI unsigned xb_add(unsigned* p, unsigned v) { return __hip_atomic_fetch_add(p, v, __ATOMIC_RELAXED, __HIP_MEMORY_SCOPE_AGENT); }
DI unsigned xb_xcc_id() { return (unsigned)__builtin_amdgcn_s_getreg((3 << 11) | 20) & 0xFu; }
#define XB_SPIN(cond, bar) do { unsigned _sp = 0; while (cond) { __builtin_amdgcn_s_sleep(1); \
    if ((++_sp & 255u) == 0u) { if (xb_ld(&(bar)[XB_TMO])) break; if (_sp > XB_SPIN_CAP) { atomicAdd(&(bar)[XB_TMO], 1u); break; } } } } while (0)
struct XcdBarrier { unsigned* bar; unsigned x; volatile LAS unsigned* st; };
DI XcdBarrier xcd_barrier_post(unsigned* bar, volatile LAS unsigned* st) {
    XcdBarrier b; b.bar = bar; b.x = xb_xcc_id(); b.st = st;
    if (threadIdx.x == 0) (void)xb_add(&bar[XB_XCNT(b.x)], 1u);
    return b;
}
DI void xcd_barrier_complete(unsigned* bar, unsigned x, unsigned& nloc, unsigned& nx) {
    const unsigned G = gridDim.x * gridDim.y * gridDim.z;
    unsigned sum, cnt, mine, sp = 0u;
    for (;;) {
        sum = 0u; cnt = 0u; mine = 0u;
#pragma unroll
        for (unsigned j = 0; j < 16; ++j) { const unsigned c = xb_ld(&bar[XB_XCNT(j)]); sum += c; cnt += (c > 0u) ? 1u : 0u; mine = (j == x) ? c : mine; }
        if (sum == G) break;
        __builtin_amdgcn_s_sleep(1);
        if ((++sp & 255u) == 0u) { if (xb_ld(&bar[XB_TMO])) break; if (sp > XB_SPIN_CAP) { atomicAdd(&bar[XB_TMO], 1u); break; } }
    }
    nloc = mine > 0u ? mine : 1u; nx = cnt > 0u ? cnt : 1u;
}
DI void xcd_barrier(const XcdBarrier& b) {
    asm volatile("s_waitcnt vmcnt(0) lgkmcnt(0)" ::: "memory");
    __syncthreads();
    if (threadIdx.x == 0) {
        unsigned* bar = b.bar;
        __builtin_amdgcn_s_waitcnt(0);
        unsigned nloc = b.st[0], nx = b.st[1];
        if (nloc == 0u) { xcd_barrier_complete(bar, b.x, nloc, nx); b.st[0] = nloc; b.st[1] = nx; }
        const unsigned old = xb_add(&bar[XB_XSUB(b.x)], 1u);
        const unsigned gen = old / nloc;
        if (old + 1u == (gen + 1u) * nloc) {
            __builtin_amdgcn_fence(__ATOMIC_RELEASE, "agent");
            asm volatile("s_waitcnt vmcnt(0)" ::: "memory");
            const unsigned og = xb_add(&bar[XB_TOP], 1u);
            const unsigned tg = og / nx;
            if (og + 1u == (tg + 1u) * nx) xb_add(&bar[XB_TOPGEN], 1u);
            else XB_SPIN(xb_ld(&bar[XB_TOPGEN]) == tg, bar);
            __builtin_amdgcn_fence(__ATOMIC_ACQUIRE, "agent");
            xb_add(&bar[XB_XGEN(b.x)], 1u);
            asm volatile("s_waitcnt vmcnt(0)" ::: "memory");
        } else {
            XB_SPIN(xb_ld(&bar[XB_XGEN(b.x)]) == gen, bar);
            __builtin_amdgcn_fence(__ATOMIC_ACQUIRE, "agent");
            asm volatile("s_waitcnt vmcnt(0)" ::: "memory");
        }
    }
    __syncthreads();
}
#ifndef PHMASK
#define PHMASK 0xFFFF
#endif
#define PHM(k) ((PHMASK >> (k)) & 1)
__global__ void __launch_bounds__(NTHR) mega(Params p) {
    extern __shared__ __attribute__((aligned(16))) unsigned char lds_raw[];
    LAS unsigned char* lds = (LAS unsigned char*)lds_raw;
    cg::grid_group grid = cg::this_grid();
    const int G = gridDim.x, c = blockIdx.x;
    unsigned char* ws = p.ws;
    bf16_t* hm = (bf16_t*)(ws + WS_HM); bf16_t* sg = (bf16_t*)(ws + WS_R1 + R1_SG); bf16_t* us = (bf16_t*)(ws + WS_R1 + R1_US);
    bf16_t* br = (bf16_t*)(ws + WS_R2 + R2_BR); float* mod = (float*)(ws + WS_MOD);
    volatile LAS unsigned* xst = (volatile LAS unsigned*)(lds + 131072);
    if (threadIdx.x < 4) xst[threadIdx.x] = 0u;
    if (c == 0) { unsigned* bw = (unsigned*)ws; for (int i = threadIdx.x; i < XCD_BAR_WORDS; i += NTHR) bw[i] = 0u; }
    asm volatile("s_waitcnt vmcnt(0) lgkmcnt(0)" ::: "memory");
    __syncthreads();
    grid.sync();
    const XcdBarrier xbar = xcd_barrier_post((unsigned*)ws, xst);
    for (int ph = p.lo; ph < p.hi; ++ph) {
        if (ph == 0) { if (PHM(12)) phase_prepass(p, lds, G, c); }
        else if (ph == 1 && PHM(11)) {
            pg8::Gemm g{256, 256, 256}; pg8::SchedPlain S; S.set(ws + WS_R1 + R1_AC, ws + WS_WUKVP, 256, 256, 64, 2, G, c, -1, 4, SZ_SM);
            pg8::EpiStore E{(bf16_t*)(ws + WS_R1 + R1_KVRC), 512, nullptr, 0}; pg8::gemm_phase(lds, g, S, E);
        } else {
            const int l = (ph - 2) / 11, s = (ph - 2) % 11;
            if (s == 0 && PHM(0)) { if (l == 0) phase_mla_finish<true>(p, lds, 0, G, c); phase_norm(p, l, 0, l == 0, G, c); }
            else if (s == 1 && PHM(1)) { pg8::Gemm g{DM, DM, DM}; pg8::SchedPlain S; S.set(hm, ws + WS_WIN + l * SZ_WIN, DM, DM, MT / 256, INP / 256, G, c); pg8::EpiIn E{sg, us}; pg8::gemm_phase(lds, g, S, E); }
            else if (s == 2 && PHM(2)) {
                { pg8::Gemm g{USW, 256, 256}; pg8::SchedPlain S; S.set(us + US_FT, ws + WS_BDFT, USW, 256, MT / 256, 2, G, c); pg8::EpiZt E{(bf16_t*)(ws + WS_R2 + R2_ZTL), (bf16_t*)(ws + WS_R2 + R2_ZTC)}; pg8::gemm_phase(lds, g, S, E); }
                __syncthreads();
                { pg8::Gemm g{USW, 256, 256}; pg8::SchedPlain S; S.set(us + US_CQ, ws + WS_WUQ + l * SZ_SM, USW, 256, MT / 256, 2, G, (c + G - 96 % G) % G); pg8::EpiStore E{(bf16_t*)(ws + WS_R2 + R2_QRAW), 512, nullptr, 0}; pg8::gemm_phase(lds, g, S, E); }
                __syncthreads();
                { pg8::Gemm g{USW, 256, 256}; pg8::SchedPlain S; S.set(us + US_CKV, ws + WS_WUKV + l * SZ_SM, USW, 256, MT / 256, 2, G, (c + G - 192 % G) % G); pg8::EpiStore E{(bf16_t*)(ws + WS_R2 + R2_KVRAW), 512, nullptr, 0}; pg8::gemm_phase(lds, g, S, E); }
                __syncthreads();
                phase_c1_rows(p, lds, l, G, c);
            } else if (s == 3 && PHM(3)) {
                { pg8::Gemm g{256, 256, 256}; pg8::SchedPlain S; S.set(ws + WS_R2 + R2_POOLED, ws + WS_BDPOOL + l * SZ_BDPOOL, 256, 256, MT / 256, 1, G, c); pg8::EpiStore E{br, DM, p.in[I_POOLS] + l * 256, 0}; pg8::gemm_phase(lds, g, S, E); }
                __syncthreads();
                { pg8::Gemm g{2048, 2048, 2048}; pg8::SchedPlain S; S.set(ws + WS_D1024, ws + WS_R2 + R2_ZTL, 2048, 2048, 4, 8, G, (c + G - 48 % G) % G); pg8::EpiStore E{br, DM, nullptr, 1}; pg8::gemm_phase(lds, g, S, E); }
                __syncthreads();
                { pg8::Gemm g{512, 512, 512}; pg8::SchedPlain S; S.set(ws + WS_D256, ws + WS_R2 + R2_ZTC, 512, 512, 16, 1, G, (c + G - 80 % G) % G, 0, 0, (size_t)256 * 512 * 2); pg8::EpiStore E{br, DM, nullptr, 2}; pg8::gemm_phase(lds, g, S, E); }
                __syncthreads();
                phase_mla_finish<false>(p, lds, l, G, c);
            } else if (s == 4 && PHM(4)) phase_attn(p, lds, l, G, c);
            else if (s == 5 && PHM(5)) { pg8::Gemm g{DM, 256, 256}; pg8::SchedGate S; S.init(MT / 256, 16, G, c); S.A = (const char*)br; S.B = (const char*)(ws + WS_WB + l * SZ_WB);
                pg8::EpiGate E{sg}; pg8::gemm_phase(lds, g, S, E);
                xcd_barrier(xbar);
                int tidm = threadIdx.x; asm volatile("" : "+v"(tidm));
#pragma unroll 3
                for (size_t i = (size_t)c * NTHR + tidm; i < (size_t)MT * 128; i += (size_t)G * NTHR) { const size_t row = i >> 7; const int d = (int)(i & 127) * 8; const bf16_t* gp = sg + row * 4096 + d;
                    float a[8];
#pragma unroll
                    for (int j = 0; j < 8; ++j) a[j] = 0.f;
#pragma unroll
                    for (int n = 0; n < 4; ++n) { const u32x4 v = *(const u32x4*)(gp + n * 1024); a[0] += bflo(v.x); a[1] += bfhi(v.x); a[2] += bflo(v.y); a[3] += bfhi(v.y); a[4] += bflo(v.z); a[5] += bfhi(v.z); a[6] += bflo(v.w); a[7] += bfhi(v.w); }
                    u32x4 w; w.x = pk2(a[0], a[1]); w.y = pk2(a[2], a[3]); w.z = pk2(a[4], a[5]); w.w = pk2(a[6], a[7]); *(u32x4*)(hm + row * DM + d) = w; } }
            else if (s == 6 && PHM(6)) { pg8::Gemm g{DM, DM, DM}; pg8::SchedPlain S; S.set(hm, ws + WS_WO + l * SZ_WO, DM, DM, MT / 256, 4, G, c);
                pg8::EpiResid E{l == 0 ? p.in[I_XP] : nullptr, p.in[I_XS], p.out, mod + (size_t)l * 9 * 6144 + 2 * 1024}; pg8::gemm_phase(lds, g, S, E); }
            else if (s == 7 && PHM(7)) phase_norm(p, l, 1, false, G, c);
            else if (s == 8 && PHM(8)) { pg8::Gemm g{DM, DM, DM}; pg8::SchedPlain S; S.set(hm, ws + WS_WUP + l * SZ_WUP, DM, DM, MT / 256, F2 / 256, G, c); pg8::EpiStore E{(bf16_t*)(ws + WS_R1), F2, nullptr, 0}; pg8::gemm_phase(lds, g, S, E); }
            else if (s == 9 && PHM(9)) phase_convact(p, l, G, c);
            else if (PHM(10)) { pg8::Gemm g{FH, FH, FH}; pg8::SchedPlain S; S.set(ws + WS_R2, ws + WS_WD + l * SZ_WD, FH, FH, MT / 256, 4, G, c);
                pg8::EpiResid E{nullptr, nullptr, p.out, mod + (size_t)l * 9 * 6144 + 5 * 1024}; pg8::gemm_phase(lds, g, S, E);
                if (l + 1 < NLAY && G == 256 && c >= 192) { __syncthreads(); convert_layer_weights(p, lds, l + 1, 64, c - 192); }
                else if (l + 1 < NLAY && G != 256) { __syncthreads(); convert_layer_weights(p, lds, l + 1, G, c); } }
        }
        if (ph + 1 < p.hi) {
            xcd_barrier(xbar); }
    }
}

constexpr int N_PHASES = 2 + NLAY * 11;

extern "C" void kernel_launch(void* const* d_in, const int* in_sizes, int n_in, void* d_out, int out_size, void* d_ws, size_t ws_size, hipStream_t stream) {
    static int grid = 0;
    if (grid == 0) {
        if (n_in != 31 || ws_size < WS_END) { fprintf(stderr, "kernel_launch: need 31 inputs and %zu bytes of workspace; got %d, %zu\n", (size_t)WS_END, n_in, ws_size); grid = -1; return; }
        int dev = 0, cus = 0, per_cu = 0;
        (void)hipGetDevice(&dev); (void)hipDeviceGetAttribute(&cus, hipDeviceAttributeMultiprocessorCount, dev);
        if (hipFuncSetAttribute((const void*)mega, hipFuncAttributeMaxDynamicSharedMemorySize, LDS_BYTES) != hipSuccess) { fprintf(stderr, "kernel_launch: hipFuncSetAttribute failed\n"); grid = -1; return; }
        if (hipOccupancyMaxActiveBlocksPerMultiprocessor(&per_cu, (const void*)mega, NTHR, LDS_BYTES) != hipSuccess || per_cu < 1) { fprintf(stderr, "kernel_launch: occupancy query failed (%d)\n", per_cu); grid = -1; return; }
        grid = cus * per_cu;
    }
    if (grid < 0) return;
    Params p{};
    for (int i = 0; i < 31; ++i) p.in[i] = (const float*)d_in[i];
    p.out = (float*)d_out; p.ws = (unsigned char*)d_ws; p.lo = 0; p.hi = N_PHASES;
    void* args[] = {&p};
    hipError_t e = hipLaunchCooperativeKernel((const void*)mega, dim3(grid), dim3(NTHR), args, LDS_BYTES, stream);
    if (e != hipSuccess) fprintf(stderr, "cooperative launch failed: %s (grid %d)\n", hipGetErrorString(e), grid);
}
```

```cpp
#include <hip/hip_runtime.h>
#include <hip/hip_cooperative_groups.h>
#include <cstdio>
namespace cg = cooperative_groups;

#define DI __device__ __forceinline__
#define LAS __attribute__((address_space(3)))
typedef unsigned short bf16_t;
typedef short bf16x8 __attribute__((ext_vector_type(8)));
typedef short s16x4 __attribute__((ext_vector_type(4)));
typedef float f32x4 __attribute__((ext_vector_type(4)));
typedef unsigned u32x4 __attribute__((ext_vector_type(4)));
typedef unsigned u32x2 __attribute__((ext_vector_type(2)));

constexpr int DM = 1024, MC = 4096, ML = 8192, MT = 12288, NLAY = 4;
constexpr int INC = 5728, INP = 5888, USW = 1792, F2 = 5632, FH = 2816;
constexpr float EPSV = 1e-6f;
constexpr int NTHR = 512;
constexpr int LDS_BYTES = 131072 + 256;
constexpr int US_POOL = 0, US_Q = 256, US_K = 512, US_V = 768, US_FT = 1024, US_CQ = 1280, US_CKV = 1472, US_KR = 1600;

constexpr size_t al256(size_t x) { return (x + 255) & ~(size_t)255; }
constexpr size_t WS_WIN = 32768;
constexpr size_t SZ_WIN = (size_t)INP * DM * 2;
constexpr size_t WS_WB = WS_WIN + NLAY * SZ_WIN;
constexpr size_t SZ_WB = (size_t)4096 * 256 * 2;
constexpr size_t WS_WO = WS_WB + NLAY * SZ_WB;
constexpr size_t SZ_WO = (size_t)DM * DM * 2;
constexpr size_t WS_WUP = WS_WO + NLAY * SZ_WO;
constexpr size_t SZ_WUP = (size_t)F2 * DM * 2;
constexpr size_t WS_WD = WS_WUP + NLAY * SZ_WUP;
constexpr size_t SZ_WD = (size_t)DM * FH * 2;
constexpr size_t WS_WUQ = WS_WD + NLAY * SZ_WD;
constexpr size_t SZ_SM = (size_t)512 * 256 * 2;
constexpr size_t WS_WUKV = WS_WUQ + NLAY * SZ_SM;
constexpr size_t WS_WUKVP = WS_WUKV + NLAY * SZ_SM;
constexpr size_t WS_BDFT = WS_WUKVP + NLAY * SZ_SM;
constexpr size_t WS_BDPOOL = WS_BDFT + SZ_SM;
constexpr size_t SZ_BDPOOL = (size_t)256 * 256 * 2;
constexpr size_t WS_D1024 = WS_BDPOOL + NLAY * SZ_BDPOOL;
constexpr size_t WS_D256 = WS_D1024 + (size_t)1024 * 2048 * 2;
constexpr size_t WS_MOD = WS_D256 + (size_t)256 * 512 * 2;
constexpr size_t WS_HM = al256(WS_MOD + (size_t)NLAY * 9 * 6144 * 4);
constexpr size_t SZ_HM = (size_t)MT * DM * 2;
constexpr size_t HM_QM = 0, HM_KMS = (size_t)MT * 384 * 2, HM_QD = 2 * (size_t)MT * 384 * 2;
constexpr size_t WS_R1 = WS_HM + SZ_HM;
constexpr size_t R1_SG = 0, R1_US = (size_t)MT * 4096 * 2;
constexpr size_t SZ_R1 = R1_US + (size_t)MT * USW * 2;
constexpr size_t R1_AC = 0, R1_KVRC = (size_t)NLAY * 4096 * 256 * 2;
constexpr size_t WS_R2 = WS_R1 + SZ_R1;
constexpr size_t R2_BR = 0, R2_MP = (size_t)MT * DM * 2;
constexpr size_t R2_QRAW = R2_MP, R2_KVRAW = R2_QRAW + (size_t)MT * 512 * 2, R2_ZTL = R2_KVRAW + (size_t)MT * 512 * 2,
                 R2_ZTC = R2_ZTL + (size_t)2048 * 2048 * 2, R2_POOLED = R2_ZTC + (size_t)16 * 256 * 512 * 2;
constexpr size_t SZ_R2 = R2_MP + (size_t)MT * DM * 4;
constexpr size_t WS_KDS = WS_R2 + SZ_R2;
constexpr size_t SZ_S64 = (size_t)MT * 256 * 2;
constexpr size_t WS_VDTS = WS_KDS + SZ_S64;
constexpr size_t WS_VMTS = WS_VDTS + SZ_S64;
constexpr size_t WS_KDC = WS_VMTS + SZ_S64;
constexpr size_t SZ_C64 = (size_t)NLAY * 8 * 4 * 512 * 64 * 2;
constexpr size_t WS_VDTC = WS_KDC + SZ_C64;
constexpr size_t WS_KMC = WS_VDTC + SZ_C64;
constexpr size_t WS_VMTC = WS_KMC + (size_t)NLAY * 8 * 4 * 512 * 96 * 2;
constexpr size_t WS_END = WS_VMTC + SZ_C64;
static_assert(R2_POOLED + (size_t)MT * 256 * 2 <= SZ_R2, "r2 overlay");
static_assert((size_t)MT * F2 * 2 <= SZ_R1, "u2 fits r1");
static_assert((size_t)MT * FH * 2 <= SZ_R2, "act fits r2");
static_assert(HM_QD + (size_t)MT * 256 * 2 <= SZ_HM, "hm overlay");

constexpr size_t O_X = 0, O_DK = 12582912, O_DV = 16777216, O_CKV = 20971520, O_KR = 23068672;

DI bf16_t f2bf(float f) { const __bf16 r = (__bf16)f; return __builtin_bit_cast(bf16_t, r); }
DI float bf2f(bf16_t b) { return __uint_as_float(((unsigned)b) << 16); }
DI float bflo(unsigned w) { return __uint_as_float(w << 16); }
DI float bfhi(unsigned w) { return __uint_as_float(w & 0xffff0000u); }
typedef float f32x2_ __attribute__((ext_vector_type(2)));
typedef __bf16 bf16x2_ __attribute__((ext_vector_type(2)));
DI unsigned pk2(float lo, float hi) { const f32x2_ v = {lo, hi}; const bf16x2_ r = __builtin_convertvector(v, bf16x2_); return __builtin_bit_cast(unsigned, r); }
DI unsigned cvt_pk_bf16(float lo, float hi) { return pk2(lo, hi); }
DI float wave_sum(float v) { for (int o = 32; o >= 1; o >>= 1) v += __shfl_xor(v, o); return v; }
DI int cond_row(int row) { return row < MC ? 0 : 1 + ((row - MC) >> 10); }
DI float sigmoidf_(float x) { return __builtin_amdgcn_rcpf(1.0f + __expf(-x)); }
DI void sincos_rev(float ang, float& s, float& c) { float f = ang * 0.15915494309189535f; f -= rintf(f); s = __builtin_amdgcn_sinf(f); c = __builtin_amdgcn_cosf(f); }
__device__ const float ROPE_INV[8] = {1.0f, 0.31622776601683794f, 0.1f, 0.031622776601683794f, 0.01f, 0.0031622776601683794f, 0.001f, 0.00031622776601683794f};
#define ROPE32(y, base, prow, pcol) do { _Pragma("unroll") for (int _i = 0; _i < 8; ++_i) { float _s, _c; \
    sincos_rev((prow) * ROPE_INV[_i], _s, _c); { const float _a = y[(base) + _i], _b = y[(base) + 8 + _i]; y[(base) + _i] = _a * _c - _b * _s; y[(base) + 8 + _i] = _a * _s + _b * _c; } \
    sincos_rev((pcol) * ROPE_INV[_i], _s, _c); { const float _a = y[(base) + 16 + _i], _b = y[(base) + 24 + _i]; y[(base) + 16 + _i] = _a * _c - _b * _s; y[(base) + 24 + _i] = _a * _s + _b * _c; } } } while (0)

namespace pg8 {
constexpr int BM = 256, BK = 64, HALF = 128, HTB = HALF * BK * 2, STAGE_BYTES = 8 * HTB, NXCD = 8, WGM = 4;
DI int lds_byte(int r, int c) { const int st = (r >> 4) * 2 + (c >> 5), rr = r & 15, cc = c & 31, ob = rr * 64 + cc * 2; return st * 1024 + (ob ^ (((ob >> 9) & 1) << 5)); }
DI void stage_rc(int b, int& R, int& C) { const int st = b / 1024, sb = b % 1024, swz = sb ^ (((sb >> 9) & 1) << 5); R = (st >> 1) * 16 + swz / 64; C = (st & 1) * 32 + (swz % 64) / 2; }
DI int perm32(int rho) { const int n = rho >> 4, i = rho & 15; return 8 * (i >> 2) + 4 * n + (i & 3); }
struct Unit { const char* a; const char* b; int pm, pn, z; };
struct Gemm { int lda, ldb, K; };
struct TileOrder {
    int nM, nN, nwg, G, c;
    DI void init(int nM_, int nN_, int G_, int c_) { nM = nM_; nN = nN_; nwg = nM * nN; G = G_; c = c_; }
    DI bool tile(int i, int& pm, int& pn) const {
        const long L = (long)i * G + c; if (L >= nwg) return false;
        int wgid = (int)L; { const int q = nwg / NXCD, r = nwg % NXCD, xcd = wgid % NXCD, off = wgid / NXCD; wgid = (xcd < r ? xcd * (q + 1) : r * (q + 1) + (xcd - r) * q) + off; }
        const int nig = WGM * nN, gid = wgid / nig, fm = gid * WGM, gsz = (nM - fm) < WGM ? (nM - fm) : WGM;
        pm = fm + ((wgid % nig) % gsz); pn = (wgid % nig) / gsz; return true;
    }
};
struct SchedPlain : TileOrder {
    const char* A; const char* B; size_t tA, tB, zB; int amask, zshift;
    DI void set(const void* A_, const void* B_, int lda, int ldb, int nM_, int nN_, int G_, int c_, int amask_ = -1, int zshift_ = 31, size_t zB_ = 0) {
        A = (const char*)A_; B = (const char*)B_; tA = (size_t)BM * lda * 2; tB = (size_t)BM * ldb * 2; amask = amask_; zshift = zshift_; zB = zB_; init(nM_, nN_, G_, c_); }
    DI bool next(int i, Unit& u) const { if (!tile(i, u.pm, u.pn)) return false; u.z = u.pm >> zshift;
        u.a = A + (size_t)(u.pm & amask) * tA; u.b = B + (size_t)u.z * zB + (size_t)u.pn * tB; return true; }
};
struct SchedGate : TileOrder {
    const char* A; const char* B;
    DI bool next(int i, Unit& u) const { if (!tile(i, u.pm, u.pn)) return false; u.z = u.pn >> 2;
        u.a = A + (size_t)u.pm * (BM * 1024 * 2) + u.z * 512; u.b = B + (size_t)u.pn * 256 * 512; return true; }
};
struct SchedProj : TileOrder {
    const char* A; const char* B;
    DI bool next(int i, Unit& u) const { if (!tile(i >> 2, u.pm, u.pn)) return false; const int n = i & 3; u.z = n;
        u.a = A + (size_t)u.pm * (BM * 1024 * 2) + n * 512; u.b = B + ((size_t)n * 1024 + u.pn * 256) * 512; return true; }
};

template <class Epi, class Sched>
DI void gemm_phase(LAS unsigned char* lds, const Gemm g, const Sched& S, const Epi& E) {
    int tid = threadIdx.x; asm volatile("" : "+v"(tid));
    const int wid = __builtin_amdgcn_readfirstlane(tid >> 6), lane = tid & 63, wr = wid >> 2, wc = wid & 3, fr = lane & 15, fq = lane >> 4;
    int K = g.K; asm volatile("" : "+s"(K)); const int nt = K / BK;
    unsigned voffA[2], voffB[2];
#pragma unroll
    for (int i = 0; i < 2; ++i) { int R, C; stage_rc(tid * 16 + i * 8192, R, C); const int Rb = Epi::PERM ? ((R & ~31) + perm32(R & 31)) : R;
        voffA[i] = (unsigned)(R * g.lda + C) * 2u; voffB[i] = (unsigned)(Rb * g.ldb + C) * 2u; }
    const size_t kstep = (size_t)(BK * 2);
    const size_t hstepA = (size_t)HALF * g.lda * 2, hstepB = (size_t)HALF * g.ldb * 2;
    const unsigned ldsw = (unsigned)wid * 1024u;
    const int aoff = lds_byte(wr * 64 + fr, fq * 8), boff = lds_byte(wc * 32 + fr, fq * 8);
#define PG8_SA(b, h) (((b) * 2 + (h)) * HTB)
#define PG8_SB(b, h) ((4 + (b) * 2 + (h)) * HTB)
#define PG8_STAGE(bufoff, gbase, voff) do { _Pragma("unroll") for (int _i = 0; _i < 2; ++_i) \
        __builtin_amdgcn_global_load_lds((const unsigned*)((const char*)(gbase) + (voff)[_i]), (LAS unsigned*)(lds + (bufoff) + ldsw + _i * 8192), 16, 0, 0); } while (0)
#define PG8_LDA(dst, b, h) do { _Pragma("unroll") for (int m = 0; m < 4; ++m) _Pragma("unroll") for (int k = 0; k < 2; ++k) dst[m][k] = *(const LAS bf16x8*)(lds + PG8_SA(b, h) + aoff + m * 2048 + k * 1024); } while (0)
#define PG8_LDB(dst, b, h) do { _Pragma("unroll") for (int n = 0; n < 2; ++n) _Pragma("unroll") for (int k = 0; k < 2; ++k) dst[n][k] = *(const LAS bf16x8*)(lds + PG8_SB(b, h) + boff + n * 2048 + k * 1024); } while (0)
#define PG8_MMA(ai, bj, At, Bt) do { __builtin_amdgcn_s_setprio(1); _Pragma("unroll") for (int m = 0; m < 4; ++m) _Pragma("unroll") for (int n = 0; n < 2; ++n) _Pragma("unroll") for (int k = 0; k < 2; ++k) \
        acc[ai][bj][m][n] = __builtin_amdgcn_mfma_f32_16x16x32_bf16(Bt[n][k], At[m][k], acc[ai][bj][m][n], 0, 0, 0); __builtin_amdgcn_s_setprio(0); } while (0)
#define PG8_WAIT_V(n) asm volatile("s_waitcnt vmcnt(" #n ")" ::: "memory")
#define PG8_WAIT_L(n) asm volatile("s_waitcnt lgkmcnt(" #n ")" ::: "memory")
#define PG8_BAR __builtin_amdgcn_s_barrier()
#define PG8_SCHED __builtin_amdgcn_sched_barrier(0)
    Unit cur, nxt; int ui = 0;
    if (!S.next(0, cur)) return;
    f32x4 acc[2][2][4][2];
#pragma unroll
    for (int a = 0; a < 2; ++a)
#pragma unroll
        for (int b = 0; b < 2; ++b)
#pragma unroll
            for (int m = 0; m < 4; ++m)
#pragma unroll
                for (int n = 0; n < 2; ++n) acc[a][b][m][n] = (f32x4){0.f, 0.f, 0.f, 0.f};
    bf16x8 At[4][2], B0[2][2], B1[2][2];
    const char* cA = cur.a; const char* cB = cur.b;
    PG8_STAGE(PG8_SB(0, 0), cB, voffB); PG8_STAGE(PG8_SA(0, 0), cA, voffA); PG8_STAGE(PG8_SB(0, 1), cB + hstepB, voffB); PG8_STAGE(PG8_SA(0, 1), cA + hstepA, voffA);
    if (wr == 1) PG8_BAR;
    PG8_WAIT_V(4); PG8_BAR;
    PG8_STAGE(PG8_SB(1, 0), cB + kstep, voffB); PG8_STAGE(PG8_SA(1, 0), cA + kstep, voffA); PG8_STAGE(PG8_SB(1, 1), cB + hstepB + kstep, voffB);
    PG8_WAIT_V(6); PG8_BAR;
    for (;;) {
        const bool has_next = S.next(ui + 1, nxt);
        const char* nA = has_next ? nxt.a : cA; const char* nB = has_next ? nxt.b : cB;
#pragma unroll 1
        for (int t = 0; t < nt; t += 2) {
            const bool last = (t == nt - 2);
            const char* a1 = cA + (size_t)(t + 1) * kstep;
            const char* a2 = last ? nA : cA + (size_t)(t + 2) * kstep; const char* b2 = last ? nB : cB + (size_t)(t + 2) * kstep;
            const char* a3 = a2 + kstep; const char* b3 = b2 + kstep;
            PG8_LDB(B0, 0, 0); PG8_SCHED; PG8_LDA(At, 0, 0); PG8_STAGE(PG8_SA(1, 1), a1 + hstepA, voffA);
            PG8_WAIT_L(8); PG8_BAR; PG8_WAIT_L(0); PG8_MMA(0, 0, At, B0); PG8_BAR; PG8_SCHED;
            PG8_LDB(B1, 0, 1); PG8_STAGE(PG8_SB(0, 0), b2, voffB);
            PG8_BAR; PG8_WAIT_L(0); PG8_MMA(0, 1, At, B1); PG8_BAR;
            PG8_LDA(At, 0, 1); PG8_STAGE(PG8_SA(0, 0), a2, voffA);
            PG8_BAR; PG8_WAIT_L(0); PG8_MMA(1, 0, At, B0); PG8_BAR; PG8_SCHED;
            PG8_STAGE(PG8_SB(0, 1), b2 + hstepB, voffB);
            PG8_WAIT_V(6); PG8_BAR; PG8_MMA(1, 1, At, B1); PG8_BAR;
            PG8_LDB(B0, 1, 0); PG8_SCHED; PG8_LDA(At, 1, 0); PG8_STAGE(PG8_SA(0, 1), a2 + hstepA, voffA);
            PG8_WAIT_L(8); PG8_BAR; PG8_WAIT_L(0); PG8_MMA(0, 0, At, B0); PG8_BAR; PG8_SCHED;
            PG8_LDB(B1, 1, 1); PG8_STAGE(PG8_SB(1, 0), b3, voffB);
            PG8_BAR; PG8_WAIT_L(0); PG8_MMA(0, 1, At, B1); PG8_BAR;
            PG8_LDA(At, 1, 1); PG8_STAGE(PG8_SA(1, 0), a3, voffA);
            PG8_BAR; PG8_WAIT_L(0); PG8_MMA(1, 0, At, B0); PG8_BAR; PG8_SCHED;
            PG8_STAGE(PG8_SB(1, 1), b3 + hstepB, voffB);
            PG8_WAIT_V(6); PG8_BAR; PG8_MMA(1, 1, At, B1); PG8_BAR;
        }
        { int fr_ = fr, fq_ = fq; asm volatile("" : "+v"(fr_), "+v"(fq_)); E(acc, cur, wr, wc, fr_, fq_); }
        if (!has_next) break;
#pragma unroll
        for (int a = 0; a < 2; ++a)
#pragma unroll
            for (int b = 0; b < 2; ++b)
#pragma unroll
                for (int m = 0; m < 4; ++m)
#pragma unroll
                    for (int n = 0; n < 2; ++n) acc[a][b][m][n] = (f32x4){0.f, 0.f, 0.f, 0.f};
        cur = nxt; cA = nA; cB = nB; ++ui;
    }
    PG8_WAIT_V(0);
    if (wr == 0) PG8_BAR;
    PG8_BAR;
#undef PG8_SA
#undef PG8_SB
#undef PG8_STAGE
#undef PG8_LDA
#undef PG8_LDB
#undef PG8_MMA
#undef PG8_WAIT_V
#undef PG8_WAIT_L
#undef PG8_BAR
#undef PG8_SCHED
}

typedef const f32x4 (&AccRef)[2][2][4][2];
#define EPI_PERM_LOOP(...) _Pragma("unroll") for (int ai = 0; ai < 2; ++ai) _Pragma("unroll") for (int m = 0; m < 4; ++m) { const int lr = ai * 128 + wr * 64 + m * 16 + fr; \
    _Pragma("unroll") for (int bj = 0; bj < 2; ++bj) { const int lc = bj * 128 + wc * 32 + 8 * fq; f32x4 v0 = acc[ai][bj][m][0], v1 = acc[ai][bj][m][1]; __VA_ARGS__ } }
#define EPI_PACK(w, v0, v1) u32x4 w; w.x = cvt_pk_bf16(v0[0], v0[1]); w.y = cvt_pk_bf16(v0[2], v0[3]); w.z = cvt_pk_bf16(v1[0], v1[1]); w.w = cvt_pk_bf16(v1[2], v1[3]);

struct EpiIn {
    static constexpr bool PERM = true;
    bf16_t* sg; bf16_t* us;
    DI void operator()(AccRef acc, const Unit& u, int wr, int wc, int fr, int fq) const {
        const int row0 = u.pm * BM;
        if (u.pn < 16) { bf16_t* base = sg + (size_t)row0 * 4096 + u.pn * BM;
            EPI_PERM_LOOP({ _Pragma("unroll") for (int j = 0; j < 4; ++j) { v0[j] = sigmoidf_(v0[j]); v1[j] = sigmoidf_(v1[j]); } u32x4 w; w.x = pk2(v0[0], v0[1]); w.y = pk2(v0[2], v0[3]); w.z = pk2(v1[0], v1[1]); w.w = pk2(v1[2], v1[3]); __builtin_nontemporal_store(w, (u32x4*)(base + (size_t)lr * 4096 + lc)); }) }
        else { bf16_t* base = us + (size_t)row0 * USW + (u.pn - 16) * BM;
            EPI_PERM_LOOP({ EPI_PACK(w, v0, v1); *(u32x4*)(base + (size_t)lr * USW + lc) = w; }) }
    }
};
struct EpiStore {
    static constexpr bool PERM = true;
    bf16_t* O; int ldc; const float* cscale; int mode;
    DI void operator()(AccRef acc, const Unit& u, int wr, int wc, int fr, int fq) const {
        size_t rb, cb;
        if (mode == 0) { rb = (size_t)u.pm * BM; cb = (size_t)u.pn * BM; }
        else if (mode == 1) { rb = (size_t)MC + u.pn * 1024 + u.pm * BM; cb = 512; }
        else { rb = (size_t)u.pm * BM; cb = 512; }
        bf16_t* base = O + rb * ldc + cb;
        if (cscale) { const float* cs = cscale + u.pn * BM;
            EPI_PERM_LOOP({ const f32x4 s0 = *(const f32x4*)(cs + lc), s1 = *(const f32x4*)(cs + lc + 4); v0 = v0 * s0; v1 = v1 * s1; EPI_PACK(w, v0, v1); *(u32x4*)(base + (size_t)lr * ldc + lc) = w; }) }
        else { EPI_PERM_LOOP({ EPI_PACK(w, v0, v1); *(u32x4*)(base + (size_t)lr * ldc + lc) = w; }) }
    }
};
struct EpiZt {
    static constexpr bool PERM = false;
    bf16_t* ztl; bf16_t* ztc;
    DI void operator()(AccRef acc, const Unit& u, int wr, int wc, int fr, int fq) const {
        const int row0 = u.pm * BM; bf16_t* base; int T, t0;
        if (row0 < MC) { T = 256; t0 = 0; base = ztc + (size_t)(row0 >> 8) * 256 * 512; } else { const int rr = row0 - MC; T = 1024; t0 = rr & 1023; base = ztl + (size_t)(rr >> 10) * 256 * 2048; }
        const int ldz = 2 * T;
#pragma unroll
        for (int ai = 0; ai < 2; ++ai)
#pragma unroll
            for (int m = 0; m < 4; ++m) { const int t = t0 + ai * 128 + wr * 64 + m * 16 + fr;
#pragma unroll
                for (int bj = 0; bj < 2; ++bj)
#pragma unroll
                    for (int n = 0; n < 2; ++n) { const int j = u.pn * BM + bj * 128 + wc * 32 + n * 16 + 4 * fq; const int g = j >> 7, hf = (j >> 6) & 1, cp = j & 63;
                        bf16_t* d = base + (size_t)(g * 64 + cp) * ldz + hf * T + t; const f32x4 v = acc[ai][bj][m][n];
                        d[0] = f2bf(v[0]); d[ldz] = f2bf(v[1]); d[2 * ldz] = f2bf(v[2]); d[3 * ldz] = f2bf(v[3]); } }
    }
};
struct EpiProj {
    static constexpr bool PERM = true;
    const bf16_t* sg; float* mp; bf16_t* mg;
    DI void operator()(AccRef acc, const Unit& u, int wr, int wc, int fr, int fq) const {
        const int n = u.z; const size_t row0 = (size_t)u.pm * BM; const int col0 = u.pn * BM;
        const bf16_t* sgb = sg + row0 * 4096 + n * 1024 + col0; float* mpb = mp + row0 * DM + col0; bf16_t* mgb = mg + row0 * DM + col0;
        EPI_PERM_LOOP({ const u32x4 gw = *(const u32x4*)(sgb + (size_t)lr * 4096 + lc);
            v0[0] *= bflo(gw.x); v0[1] *= bfhi(gw.x); v0[2] *= bflo(gw.y); v0[3] *= bfhi(gw.y); v1[0] *= bflo(gw.z); v1[1] *= bfhi(gw.z); v1[2] *= bflo(gw.w); v1[3] *= bfhi(gw.w);
            float* p = mpb + (size_t)lr * DM + lc;
            if (n > 0) { v0 = v0 + *(const f32x4*)p; v1 = v1 + *(const f32x4*)(p + 4); }
            if (n < 3) { *(f32x4*)p = v0; *(f32x4*)(p + 4) = v1; }
            else { EPI_PACK(w, v0, v1); *(u32x4*)(mgb + (size_t)lr * DM + lc) = w; } })
    }
};
struct EpiGate {
    static constexpr bool PERM = true;
    bf16_t* sg;
    DI void operator()(AccRef acc, const Unit& u, int wr, int wc, int fr, int fq) const {
        bf16_t* base = sg + (size_t)u.pm * BM * 4096 + u.pn * BM;
        EPI_PERM_LOOP({ bf16_t* p = base + (size_t)lr * 4096 + lc; const u32x4 gw = *(const u32x4*)p;
            v0[0] *= bflo(gw.x); v0[1] *= bfhi(gw.x); v0[2] *= bflo(gw.y); v0[3] *= bfhi(gw.y); v1[0] *= bflo(gw.z); v1[1] *= bfhi(gw.z); v1[2] *= bflo(gw.w); v1[3] *= bfhi(gw.w);
            EPI_PACK(w, v0, v1); *(u32x4*)p = w; })
    }
};
struct EpiResid {
    static constexpr bool PERM = false;
    const float* xp; const float* xs; float* out; const float* gate;
    DI void operator()(AccRef acc, const Unit& u, int wr, int wc, int fr, int fq) const {
        const int row0 = u.pm * BM; const float* bs = xp ? (row0 < MC ? xp + (size_t)row0 * DM : xs + (size_t)(row0 - MC) * DM) : out + (size_t)row0 * DM;
        float* ob = out + (size_t)row0 * DM; const float* gp = gate + (size_t)cond_row(row0) * 6144;
#pragma unroll
        for (int bj = 0; bj < 2; ++bj)
#pragma unroll
            for (int n = 0; n < 2; ++n) { const int col = u.pn * BM + bj * 128 + wc * 32 + n * 16 + 4 * fq; const f32x4 gv = *(const f32x4*)(gp + col);
#pragma unroll
                for (int ai = 0; ai < 2; ++ai)
#pragma unroll
                    for (int m = 0; m < 4; ++m) { const size_t off = (size_t)(ai * 128 + wr * 64 + m * 16 + fr) * DM + col;
                        const f32x4 b = *(const f32x4*)(bs + off); *(f32x4*)(ob + off) = b + gv * acc[ai][bj][m][n]; } }
    }
};
}

struct Params {
    const float* in[31];
    float* out; unsigned char* ws;
    int lo, hi;
};
enum { I_XP = 0, I_XS, I_C, I_CCTX, I_CDK, I_CDV, I_CCKV, I_CKR, I_WADA, I_BADA, I_GN1, I_GN2, I_WIN, I_POOLW, I_POOLS, I_DQN, I_DKN, I_DLAM, I_DSUB,
       I_QAN, I_WUQ, I_KVN, I_WUKV, I_MQN, I_MKN, I_WBR, I_WOUT, I_WUP, I_CONVW, I_CONVB, I_WDOWN };

DI void tr_load(const float* src, int R, int C, int tile, int tid, f32x4 (&v)[8]) {
    const int ntk = R / 64, tk = tile % ntk, tn = tile / ntk, k0 = tk * 64, n0 = tn * 256;
#pragma unroll
    for (int i = 0; i < 8; ++i) { const int k = (tid >> 6) + 8 * i, n = n0 + (tid & 63) * 4; v[i] = (f32x4){0.f, 0.f, 0.f, 0.f};
        if (n < C) v[i] = *(const f32x4*)(src + (size_t)(k0 + k) * C + n); }
}
DI void tr_store(LAS unsigned char* lds, bf16_t* dst, int R, int tile, int tid, const f32x4 (&v)[8]) {
    LAS float* T = (LAS float*)lds;
    const int ntk = R / 64, tk = tile % ntk, tn = tile / ntk, k0 = tk * 64, n0 = tn * 256;
    __syncthreads();
#pragma unroll
    for (int i = 0; i < 8; ++i) { const int k = (tid >> 6) + 8 * i; LAS float* t = T + k * 257 + (tid & 63) * 4; t[0] = v[i][0]; t[1] = v[i][1]; t[2] = v[i][2]; t[3] = v[i][3]; }
    __syncthreads();
#pragma unroll
    for (int j = 0; j < 4; ++j) { const int n = (tid >> 3) + 64 * j, kc = (tid & 7) * 8; u32x4 w;
        w.x = pk2(T[(kc + 0) * 257 + n], T[(kc + 1) * 257 + n]); w.y = pk2(T[(kc + 2) * 257 + n], T[(kc + 3) * 257 + n]);
        w.z = pk2(T[(kc + 4) * 257 + n], T[(kc + 5) * 257 + n]); w.w = pk2(T[(kc + 6) * 257 + n], T[(kc + 7) * 257 + n]);
        *(u32x4*)(dst + (size_t)(n0 + n) * R + k0 + kc) = w; }
}
DI void tr_job(LAS unsigned char* lds, const float* src, bf16_t* dst, int R, int C, int Cpad, int& base, int G, int c) {
    const int nt = (R / 64) * (Cpad / 256); int tid = threadIdx.x; asm volatile("" : "+v"(tid));
    int t = (c + G - (base % G)) % G; base += nt;
    if (t >= nt) return;
    f32x4 nx[8]; tr_load(src, R, C, t, tid, nx);
    for (; t < nt; t += G) {
        f32x4 cur[8];
#pragma unroll
        for (int i = 0; i < 8; ++i) cur[i] = nx[i];
        if (t + G < nt) tr_load(src, R, C, t + G, tid, nx);
        tr_store(lds, dst, R, t, tid, cur);
    }
}

DI void convert_layer_weights(const Params& p, LAS unsigned char* lds, int l, int G, int c) {
    unsigned char* ws = p.ws; int base = 0;
    tr_job(lds, p.in[I_WIN] + (size_t)l * DM * INC, (bf16_t*)(ws + WS_WIN + l * SZ_WIN), DM, INC, INP, base, G, c);
    tr_job(lds, p.in[I_WUP] + (size_t)l * DM * F2, (bf16_t*)(ws + WS_WUP + l * SZ_WUP), DM, F2, F2, base, G, c);
    tr_job(lds, p.in[I_WDOWN] + (size_t)l * FH * DM, (bf16_t*)(ws + WS_WD + l * SZ_WD), FH, DM, DM, base, G, c);
    tr_job(lds, p.in[I_WOUT] + (size_t)l * DM * DM, (bf16_t*)(ws + WS_WO + l * SZ_WO), DM, DM, DM, base, G, c);
    for (int n = 0; n < 4; ++n)
        tr_job(lds, p.in[I_WBR] + ((size_t)l * 4 + n) * 256 * DM, (bf16_t*)(ws + WS_WB + l * SZ_WB) + (size_t)n * 1024 * 256, 256, DM, DM, base, G, c);
    __syncthreads();
}

DI void phase_prepass(const Params& p, LAS unsigned char* lds, int G, int c) {
    unsigned char* ws = p.ws; int tid = threadIdx.x; asm volatile("" : "+v"(tid));
    convert_layer_weights(p, lds, 0, G, c);
    {
        LAS float* sc = (LAS float*)lds;
        for (int i = tid; i < 9 * 1024; i += NTHR) { const int r = i >> 10, k = i & 1023; const float v = r == 0 ? p.in[I_CCTX][k] : p.in[I_C][(r - 1) * 1024 + k]; sc[i] = v * sigmoidf_(v); }
        __syncthreads();
        LAS float* red = (LAS float*)(lds + 9 * 1024 * 4);
        float* mod = (float*)(ws + WS_MOD);
        for (int it = c; it < 192; it += G) {
            const int l = it / 48, col = (it % 48) * 128 + (tid & 127), kq = tid >> 7;
            const float* w = p.in[I_WADA] + (size_t)l * DM * 6144 + col;
            float a[9];
#pragma unroll
            for (int r = 0; r < 9; ++r) a[r] = 0.f;
#pragma unroll 8
            for (int k = kq * 256; k < kq * 256 + 256; ++k) { const float wv = w[(size_t)k * 6144];
#pragma unroll
                for (int r = 0; r < 9; ++r) a[r] += sc[r * 1024 + k] * wv; }
            __syncthreads();
#pragma unroll
            for (int r = 0; r < 9; ++r) red[(kq * 9 + r) * 128 + (tid & 127)] = a[r];
            __syncthreads();
            for (int i = tid; i < 9 * 128; i += NTHR) { const int r = i >> 7, cc = i & 127, colo = (it % 48) * 128 + cc;
                mod[((size_t)l * 9 + r) * 6144 + colo] = red[(0 * 9 + r) * 128 + cc] + red[(1 * 9 + r) * 128 + cc] + red[(2 * 9 + r) * 128 + cc] + red[(3 * 9 + r) * 128 + cc] + p.in[I_BADA][l * 6144 + colo]; }
        }
        __syncthreads();
    }
    const size_t gt = (size_t)c * NTHR + tid, gs = (size_t)G * NTHR;
    for (size_t i = gt; i < (size_t)NLAY * 512 * 256; i += gs) {
        const int l = (int)(i >> 17), n = (int)(i >> 8) & 511, k = (int)i & 255;
        { const int h = n >> 7, d = n & 127; float v = 0.f; if (d < 96 && k < 192) v = p.in[I_WUQ][((size_t)l * 192 + k) * 384 + h * 96 + d] * p.in[I_QAN][l * 192 + k];
          ((bf16_t*)(ws + WS_WUQ))[i] = f2bf(v); }
        { float v = 0.f, vp = 0.f; if (k < 128) { vp = p.in[I_WUKV][((size_t)l * 128 + k) * 512 + n]; v = vp * p.in[I_KVN][l * 128 + k]; }
          ((bf16_t*)(ws + WS_WUKV))[i] = f2bf(v); ((bf16_t*)(ws + WS_WUKVP))[i] = f2bf(vp); }
    }
    for (size_t i = gt; i < (size_t)512 * 256; i += gs) {
        const int j = (int)(i >> 8), k = (int)i & 255, g = j >> 7, hf = (j >> 6) & 1, cp = j & 63, g2 = k >> 6, cc = k & 63; float v = 0.f;
        if (g == g2) { const int m = (cp * cc) & 63; const float a = (float)m * (1.0f / 32.0f); v = (hf ? -sinpif(a) : cospif(a)) * 0.125f; }
        ((bf16_t*)(ws + WS_BDFT))[i] = f2bf(v);
    }
    for (size_t i = gt; i < (size_t)NLAY * 256 * 256; i += gs) {
        const int l = (int)(i >> 16), e = (int)(i >> 8) & 255, k = (int)i & 255; float v = 0.f;
        if ((e >> 6) == (k >> 6)) v = p.in[I_POOLW][(((size_t)l * 4 + (e >> 6)) * 64 + (k & 63)) * 64 + (e & 63)];
        ((bf16_t*)(ws + WS_BDPOOL))[i] = f2bf(v);
    }
    for (size_t i = gt; i < (size_t)1024 * 2048; i += gs) {
        const int kt = (int)(i >> 11), t = (int)i & 2047, tt = t & 1023; const int m = (kt * tt) & 1023; const float a = (float)m * (1.0f / 512.0f);
        ((bf16_t*)(ws + WS_D1024))[i] = f2bf((t < 1024 ? cospif(a) : sinpif(a)) * (1.0f / 32.0f));
    }
    for (size_t i = gt; i < (size_t)256 * 512; i += gs) {
        const int kt = (int)(i >> 9), t = (int)i & 511, tt = t & 255; const int m = (kt * tt) & 255; const float a = (float)m * (1.0f / 128.0f);
        ((bf16_t*)(ws + WS_D256))[i] = f2bf((t < 256 ? cospif(a) : sinpif(a)) * (1.0f / 16.0f));
    }
    for (size_t i = gt; i < (size_t)NLAY * 8 * 4 * 512 * 64; i += gs) {
        const int d = (int)i & 63, key = (int)(i >> 6) & 511, h = (int)(i >> 15) & 3, b = (int)(i >> 17) & 7, l = (int)(i >> 20);
        ((bf16_t*)(ws + WS_KDC))[i] = f2bf(p.in[I_CDK][((((size_t)b * 4 + l) * 512 + key) * 4 + h) * 64 + d]);
    }
    for (size_t i = gt; i < (size_t)NLAY * 8 * 4 * 64 * 512; i += gs) {
        const int key = (int)i & 511, dv = (int)(i >> 9) & 63, h = (int)(i >> 15) & 3, b = (int)(i >> 17) & 7, l = (int)(i >> 20);
        ((bf16_t*)(ws + WS_VDTC))[i] = f2bf(p.in[I_CDV][((((size_t)b * 4 + l) * 512 + key) * 4 + h) * 64 + dv]);
    }
    for (size_t i = gt; i < (size_t)NLAY * 4096 * 256; i += gs) {
        const int k = (int)i & 255, key = (int)(i >> 8) & 511, b = (int)(i >> 17) & 7, l = (int)(i >> 20);
        ((bf16_t*)(ws + WS_R1 + R1_AC))[i] = k < 128 ? f2bf(p.in[I_CCKV][(((size_t)b * 4 + l) * 512 + key) * 128 + k]) : (bf16_t)0;
    }
}

DI void phase_norm(const Params& p, int l, int which, bool from_input, int G, int c) {
    int tid_ = threadIdx.x; asm volatile("" : "+v"(tid_)); const int lane = tid_ & 63, wid = tid_ >> 6;
    const float* gn = p.in[which ? I_GN2 : I_GN1] + l * DM; const float* mod = (const float*)(p.ws + WS_MOD) + (size_t)l * 9 * 6144 + which * 3072;
    bf16_t* h = (bf16_t*)(p.ws + WS_HM);
    for (int rowa = c * 8 + wid; rowa < MT; rowa += 2 * G * 8) {
        const int rowb = rowa + G * 8; const bool hb = rowb < MT;
        const float* xa = from_input ? (rowa < MC ? p.in[I_XP] + (size_t)rowa * DM : p.in[I_XS] + (size_t)(rowa - MC) * DM) : p.out + (size_t)rowa * DM;
        const int rb = hb ? rowb : rowa;
        const float* xb = from_input ? (rb < MC ? p.in[I_XP] + (size_t)rb * DM : p.in[I_XS] + (size_t)(rb - MC) * DM) : p.out + (size_t)rb * DM;
        f32x4 va[4], vb[4]; float sa = 0.f, sb2 = 0.f;
#pragma unroll
        for (int i = 0; i < 4; ++i) { va[i] = *(const f32x4*)(xa + i * 256 + lane * 4); vb[i] = *(const f32x4*)(xb + i * 256 + lane * 4); }
#pragma unroll
        for (int i = 0; i < 4; ++i) { sa += va[i][0] * va[i][0] + va[i][1] * va[i][1] + va[i][2] * va[i][2] + va[i][3] * va[i][3]; sb2 += vb[i][0] * vb[i][0] + vb[i][1] * vb[i][1] + vb[i][2] * vb[i][2] + vb[i][3] * vb[i][3]; }
        for (int o = 32; o >= 1; o >>= 1) { sa += __shfl_xor(sa, o); sb2 += __shfl_xor(sb2, o); }
        const float rsa = rsqrtf(sa * (1.0f / DM) + EPSV), rsb = rsqrtf(sb2 * (1.0f / DM) + EPSV);
        const float* mra = mod + (size_t)cond_row(rowa) * 6144; const float* mrb = mod + (size_t)cond_row(rb) * 6144;
#pragma unroll
        for (int i = 0; i < 4; ++i) { const int col = i * 256 + lane * 4; const f32x4 g = *(const f32x4*)(gn + col);
            { const f32x4 sh = *(const f32x4*)(mra + col), sc = *(const f32x4*)(mra + 1024 + col); const f32x4 o = va[i] * rsa * g * (sc + 1.0f) + sh; u32x2 w; w.x = pk2(o[0], o[1]); w.y = pk2(o[2], o[3]); *(u32x2*)(h + (size_t)rowa * DM + col) = w; }
            if (hb) { const f32x4 sh = *(const f32x4*)(mrb + col), sc = *(const f32x4*)(mrb + 1024 + col); const f32x4 o = vb[i] * rsb * g * (sc + 1.0f) + sh; u32x2 w; w.x = pk2(o[0], o[1]); w.y = pk2(o[2], o[3]); *(u32x2*)(h + (size_t)rowb * DM + col) = w; } }
    }
}

DI void phase_c1_rows(const Params& p, LAS unsigned char* lds, int l, int G, int c) {
    int tid = threadIdx.x; asm volatile("" : "+v"(tid)); unsigned char* ws = p.ws;
    const bf16_t* us = (const bf16_t*)(ws + WS_R1 + R1_US);
    bf16_t* Qd = (bf16_t*)(ws + WS_HM + HM_QD); bf16_t* Kds = (bf16_t*)(ws + WS_KDS); bf16_t* VdTs = (bf16_t*)(ws + WS_VDTS); bf16_t* pooled = (bf16_t*)(ws + WS_R2 + R2_POOLED);
    const float* qn = p.in[I_DQN] + l * 32; const float* kn = p.in[I_DKN] + l * 32;
    LAS bf16_t* VT = (LAS bf16_t*)lds;
    LAS bf16_t* PT = (LAS bf16_t*)(lds + 64 * 264 * 2);
    for (int it = G - 1 - c; it < MT / 64; it += G) {
        const int r0 = it * 64; const bool lat = r0 >= MC; const int T = lat ? 1024 : 256, t0 = lat ? ((r0 - MC) & 1023) : (r0 & 255), sb = r0 - t0;
        __syncthreads();
        for (int q = tid; q < 64 * 32; q += NTHR) { const int t = q >> 5, ch = q & 31; *(LAS u32x4*)(VT + t * 264 + ch * 8) = *(const u32x4*)(us + (size_t)(r0 + t) * USW + US_V + ch * 8); }
        for (int q = tid; q < 80 * 32; q += NTHR) { const int tr = q >> 5, ch = q & 31, t = t0 - 8 + tr; u32x4 v = (u32x4){0u, 0u, 0u, 0u};
            if (t >= 0 && t < T) v = *(const u32x4*)(us + (size_t)(sb + t) * USW + US_POOL + ch * 8); *(LAS u32x4*)(PT + tr * 264 + ch * 8) = v; }
#pragma unroll
        for (int j = 0; j < 2; ++j) {
            const int vid = tid + NTHR * j, tl = vid >> 4, w = vid & 15, row = r0 + tl, t = t0 + tl; const bool isk = w >= 8; const int h = (w & 7) >> 1, hf = w & 1;
            const bf16_t* src = us + (size_t)row * USW + US_Q + w * 32;
            float y[32]; float ss = 0.f;
#pragma unroll
            for (int q = 0; q < 4; ++q) { const u32x4 v = *(const u32x4*)(src + q * 8);
                y[q * 8 + 0] = bflo(v.x); y[q * 8 + 1] = bfhi(v.x); y[q * 8 + 2] = bflo(v.y); y[q * 8 + 3] = bfhi(v.y); y[q * 8 + 4] = bflo(v.z); y[q * 8 + 5] = bfhi(v.z); y[q * 8 + 6] = bflo(v.w); y[q * 8 + 7] = bfhi(v.w); }
#pragma unroll
            for (int d = 0; d < 32; ++d) ss += y[d] * y[d];
            const float rs = rsqrtf(ss * (1.0f / 32.0f) + EPSV); const float* gnp = isk ? kn : qn;
#pragma unroll
            for (int d = 0; d < 32; ++d) y[d] = y[d] * rs * gnp[d];
            if (isk && !lat) { float* o = p.out + O_DK + ((size_t)((r0 >> 8) * 4 + l) * 256 + t) * 256 + h * 64 + hf * 32;
#pragma unroll
                for (int q = 0; q < 8; ++q) __builtin_nontemporal_store((f32x4){y[q * 4], y[q * 4 + 1], y[q * 4 + 2], y[q * 4 + 3]}, (f32x4*)(o + q * 4)); }
            if (lat) { const float prow = (float)(t >> 6), pcol = (float)(t & 63); ROPE32(y, 0, prow, pcol); }
            bf16_t* dst = isk ? Kds + (size_t)sb * 256 + ((size_t)h * T + t) * 64 + hf * 32 : Qd + (size_t)row * 256 + h * 64 + hf * 32;
#pragma unroll
            for (int q = 0; q < 4; ++q) { u32x4 wv; wv.x = pk2(y[q * 8], y[q * 8 + 1]); wv.y = pk2(y[q * 8 + 2], y[q * 8 + 3]); wv.z = pk2(y[q * 8 + 4], y[q * 8 + 5]); wv.w = pk2(y[q * 8 + 6], y[q * 8 + 7]); *(u32x4*)(dst + q * 8) = wv; }
        }
        __syncthreads();
        if (!lat) { float* o = p.out + O_DV + ((size_t)((r0 >> 8) * 4 + l) * 256 + t0) * 256;
            for (int q = tid; q < 64 * 256; q += NTHR) __builtin_nontemporal_store(bf2f(VT[(q >> 8) * 264 + (q & 255)]), o + q); }
        { const int cidx = tid & 255, th = tid >> 8; bf16_t* dst = VdTs + (size_t)sb * 256 + ((size_t)(cidx >> 6) * 64 + (cidx & 63)) * T + t0 + th * 32;
#pragma unroll
          for (int q = 0; q < 4; ++q) { u32x4 wv; const LAS bf16_t* s = VT + (th * 32 + q * 8) * 264 + cidx;
              wv.x = (unsigned)s[0] | ((unsigned)s[264] << 16); wv.y = (unsigned)s[2 * 264] | ((unsigned)s[3 * 264] << 16); wv.z = (unsigned)s[4 * 264] | ((unsigned)s[5 * 264] << 16); wv.w = (unsigned)s[6 * 264] | ((unsigned)s[7 * 264] << 16);
              *(u32x4*)(dst + q * 8) = wv; } }
        { const int cidx = tid & 255, th = tid >> 8, hw = 1 << (cidx >> 6);
          const int tf = t0 + th * 32; float s = 0.f;
          { const int lo = max(tf - hw, 0), hi = min(tf + hw, T); for (int tt = lo; tt < hi; ++tt) s += bf2f(PT[(tt - t0 + 8) * 264 + cidx]); }
          for (int q = 0; q < 32; ++q) { const int tl = th * 32 + q, t = t0 + tl; const int lo = max(t - hw, 0), hi = min(t + hw, T);
              const float v = s * __builtin_amdgcn_rcpf((float)(hi - lo)) - bf2f(PT[(tl + 8) * 264 + cidx]); pooled[(size_t)(r0 + tl) * 256 + cidx] = f2bf(v);
              if (t + hw < T) s += bf2f(PT[(t + hw - t0 + 8) * 264 + cidx]);
              if (t - hw >= 0) s -= bf2f(PT[(t - hw - t0 + 8) * 264 + cidx]); } }
    }
    __syncthreads();
}

DI float sumsq8(const u32x4 v) { const float a0 = bflo(v.x), a1 = bfhi(v.x), a2 = bflo(v.y), a3 = bfhi(v.y), a4 = bflo(v.z), a5 = bfhi(v.z), a6 = bflo(v.w), a7 = bfhi(v.w);
    return a0 * a0 + a1 * a1 + a2 * a2 + a3 * a3 + a4 * a4 + a5 * a5 + a6 * a6 + a7 * a7; }
DI u32x4 scale8(const u32x4 v, float sc, const float* g) { const f32x4 g0 = *(const f32x4*)g, g1 = *(const f32x4*)(g + 4); u32x4 w;
    w.x = pk2(bflo(v.x) * sc * g0[0], bfhi(v.x) * sc * g0[1]); w.y = pk2(bflo(v.y) * sc * g0[2], bfhi(v.y) * sc * g0[3]);
    w.z = pk2(bflo(v.z) * sc * g1[0], bfhi(v.z) * sc * g1[1]); w.w = pk2(bflo(v.w) * sc * g1[2], bfhi(v.w) * sc * g1[3]); return w; }
DI u32x4 scale8n(const u32x4 v, float sc) { u32x4 w; w.x = pk2(bflo(v.x) * sc, bfhi(v.x) * sc); w.y = pk2(bflo(v.y) * sc, bfhi(v.y) * sc); w.z = pk2(bflo(v.z) * sc, bfhi(v.z) * sc); w.w = pk2(bflo(v.w) * sc, bfhi(v.w) * sc); return w; }
#define UNPK8(y, o, v) do { y[(o) + 0] = bflo(v.x); y[(o) + 1] = bfhi(v.x); y[(o) + 2] = bflo(v.y); y[(o) + 3] = bfhi(v.y); y[(o) + 4] = bflo(v.z); y[(o) + 5] = bfhi(v.z); y[(o) + 6] = bflo(v.w); y[(o) + 7] = bfhi(v.w); } while (0)
template <bool CACHE>
DI void phase_mla_finish(const Params& p, LAS unsigned char* lds, int l, int G, int c) {
    int tid = threadIdx.x; asm volatile("" : "+v"(tid)); unsigned char* ws = p.ws;
    const bf16_t* us = (const bf16_t*)(ws + WS_R1 + R1_US);
    LAS bf16_t* VT = (LAS bf16_t*)lds;
    const int nitems = CACHE ? NLAY * 4096 / 64 : MT / 64;
    const int it_first = CACHE ? c : (G == 256 ? (c >= 96 ? c - 96 : (c < 32 ? 160 + c : nitems)) : G - 1 - c);
    for (int it = it_first; it < nitems; it += G) {
        int r0, T, t0, sb, lay; bool lat;
        if (CACHE) { lay = it >> 6; r0 = (it & 63) * 64; lat = false; T = 512; t0 = r0 & 511; sb = r0 - t0; }
        else { lay = l; r0 = it * 64; lat = r0 >= MC; T = lat ? 1024 : 256; t0 = lat ? ((r0 - MC) & 1023) : (r0 & 255); sb = r0 - t0; }
        const int role = tid >> 8, tl = (tid & 255) >> 2, h = tid & 3, row = r0 + tl, t = t0 + tl;
        const float prow = (float)(t >> 6), pcol = (float)(t & 63);
        __syncthreads();
        if (role == 0 && !CACHE) {
            const bf16_t* cq = us + (size_t)row * USW + US_CQ + h * 48; float ss = 0.f;
#pragma unroll
            for (int q = 0; q < 6; ++q) ss += sumsq8(*(const u32x4*)(cq + q * 8));
            ss += __shfl_xor(ss, 1); ss += __shfl_xor(ss, 2);
            const float rq = rsqrtf(ss * (1.0f / 192.0f) + EPSV);
            const bf16_t* src = (const bf16_t*)(ws + WS_R2 + R2_QRAW) + (size_t)row * 512 + h * 128;
            float s2 = 0.f;
#pragma unroll
            for (int q = 0; q < 12; ++q) s2 += sumsq8(*(const u32x4*)(src + q * 8));
            s2 *= rq * rq;
            const float r2 = rsqrtf(s2 * (1.0f / 96.0f) + EPSV) * rq; const float* gq = p.in[I_MQN] + lay * 96;
            bf16_t* dst = (bf16_t*)(ws + WS_HM + HM_QM) + (size_t)row * 384 + h * 96;
#pragma unroll
            for (int q = 0; q < 8; ++q) *(u32x4*)(dst + q * 8) = scale8(*(const u32x4*)(src + q * 8), r2, gq + q * 8);
            float y[32];
#pragma unroll
            for (int q = 0; q < 4; ++q) { const u32x4 v = *(const u32x4*)(src + 64 + q * 8); UNPK8(y, q * 8, v); }
#pragma unroll
            for (int d = 0; d < 32; ++d) y[d] = y[d] * r2 * gq[64 + d];
            if (lat) ROPE32(y, 0, prow, pcol);
#pragma unroll
            for (int q = 0; q < 4; ++q) { u32x4 wv; wv.x = pk2(y[q * 8], y[q * 8 + 1]); wv.y = pk2(y[q * 8 + 2], y[q * 8 + 3]); wv.z = pk2(y[q * 8 + 4], y[q * 8 + 5]); wv.w = pk2(y[q * 8 + 6], y[q * 8 + 7]); *(u32x4*)(dst + 64 + q * 8) = wv; }
        }
        if (role == 1) {
            float rkv = 1.0f;
            const int b = r0 >> (CACHE ? 9 : 8);
            if (!CACHE) {
                const bf16_t* ck = us + (size_t)row * USW + US_CKV + h * 32; float ss = 0.f;
#pragma unroll
                for (int q = 0; q < 4; ++q) ss += sumsq8(*(const u32x4*)(ck + q * 8));
                ss += __shfl_xor(ss, 1); ss += __shfl_xor(ss, 2);
                rkv = rsqrtf(ss * (1.0f / 128.0f) + EPSV);
                if (!lat) { const float* gk = p.in[I_KVN] + lay * 128 + h * 32; float* o = p.out + O_CKV + ((size_t)(b * 4 + lay) * 256 + t) * 128 + h * 32;
#pragma unroll
                    for (int q = 0; q < 4; ++q) { const u32x4 v = *(const u32x4*)(ck + q * 8); const f32x4 g0 = *(const f32x4*)(gk + q * 8), g1 = *(const f32x4*)(gk + q * 8 + 4);
                        __builtin_nontemporal_store((f32x4){bflo(v.x) * rkv * g0[0], bfhi(v.x) * rkv * g0[1], bflo(v.y) * rkv * g0[2], bfhi(v.y) * rkv * g0[3]}, (f32x4*)(o + q * 8));
                        __builtin_nontemporal_store((f32x4){bflo(v.z) * rkv * g1[0], bfhi(v.z) * rkv * g1[1], bflo(v.w) * rkv * g1[2], bfhi(v.w) * rkv * g1[3]}, (f32x4*)(o + q * 8 + 4)); } }
            }
            float y[32];
            if (CACHE) { const float* krp = p.in[I_CKR] + ((size_t)(b * 4 + lay) * 512 + t) * 32;
#pragma unroll
                for (int q = 0; q < 8; ++q) { const f32x4 v = *(const f32x4*)(krp + q * 4); y[q * 4] = v[0]; y[q * 4 + 1] = v[1]; y[q * 4 + 2] = v[2]; y[q * 4 + 3] = v[3]; } }
            else { const bf16_t* krp = us + (size_t)row * USW + US_KR;
#pragma unroll
                for (int q = 0; q < 4; ++q) { const u32x4 v = *(const u32x4*)(krp + q * 8); UNPK8(y, q * 8, v); }
                if (!lat) { float* o = p.out + O_KR + ((size_t)(b * 4 + lay) * 256 + t) * 32 + h * 8; const u32x4 v = *(const u32x4*)(krp + h * 8);
                    __builtin_nontemporal_store((f32x4){bflo(v.x), bfhi(v.x), bflo(v.y), bfhi(v.y)}, (f32x4*)o); __builtin_nontemporal_store((f32x4){bflo(v.z), bfhi(v.z), bflo(v.w), bfhi(v.w)}, (f32x4*)(o + 4)); } }
            const bf16_t* src = CACHE ? (const bf16_t*)(ws + WS_R1 + R1_KVRC) + ((size_t)lay * 4096 + row) * 512 + h * 128 : (const bf16_t*)(ws + WS_R2 + R2_KVRAW) + (size_t)row * 512 + h * 128;
            float s2 = 0.f, s3 = 0.f;
#pragma unroll
            for (int q = 0; q < 8; ++q) s2 += sumsq8(*(const u32x4*)(src + q * 8));
#pragma unroll
            for (int d = 0; d < 32; ++d) s3 += y[d] * y[d];
            s2 = s2 * rkv * rkv + s3;
            const float r2 = rsqrtf(s2 * (1.0f / 96.0f) + EPSV); const float* gk2 = p.in[I_MKN] + lay * 96;
            bf16_t* dst = CACHE ? (bf16_t*)(ws + WS_KMC) + ((((size_t)lay * 8 + b) * 4 + h) * 512 + t) * 96 : (bf16_t*)(ws + WS_HM + HM_KMS) + (size_t)sb * 384 + ((size_t)h * T + t) * 96;
#pragma unroll
            for (int q = 0; q < 8; ++q) *(u32x4*)(dst + q * 8) = scale8(*(const u32x4*)(src + q * 8), r2 * rkv, gk2 + q * 8);
#pragma unroll
            for (int q = 0; q < 8; ++q) *(LAS u32x4*)(VT + tl * 264 + h * 64 + q * 8) = scale8n(*(const u32x4*)(src + 64 + q * 8), rkv);
#pragma unroll
            for (int d = 0; d < 32; ++d) y[d] = y[d] * r2 * gk2[64 + d];
            if (lat) ROPE32(y, 0, prow, pcol);
#pragma unroll
            for (int q = 0; q < 4; ++q) { u32x4 wv; wv.x = pk2(y[q * 8], y[q * 8 + 1]); wv.y = pk2(y[q * 8 + 2], y[q * 8 + 3]); wv.z = pk2(y[q * 8 + 4], y[q * 8 + 5]); wv.w = pk2(y[q * 8 + 6], y[q * 8 + 7]); *(u32x4*)(dst + 64 + q * 8) = wv; }
        }
        __syncthreads();
        { const int cidx = tid & 255, th = tid >> 8; const int b = r0 >> 9;
          bf16_t* dst = CACHE ? (bf16_t*)(ws + WS_VMTC) + ((((size_t)lay * 8 + b) * 4 + (cidx >> 6)) * 64 + (cidx & 63)) * 512 + t0 + th * 32
                              : (bf16_t*)(ws + WS_VMTS) + (size_t)sb * 256 + ((size_t)(cidx >> 6) * 64 + (cidx & 63)) * T + t0 + th * 32;
#pragma unroll
          for (int q = 0; q < 4; ++q) { u32x4 wv; const LAS bf16_t* s = VT + (th * 32 + q * 8) * 264 + cidx;
              wv.x = (unsigned)s[0] | ((unsigned)s[264] << 16); wv.y = (unsigned)s[2 * 264] | ((unsigned)s[3 * 264] << 16); wv.z = (unsigned)s[4 * 264] | ((unsigned)s[5 * 264] << 16); wv.w = (unsigned)s[6 * 264] | ((unsigned)s[7 * 264] << 16);
              *(u32x4*)(dst + q * 8) = wv; } }
    }
    __syncthreads();
}

template <bool DIFF>
DI void attn_item(LAS unsigned char* lds, const bf16_t* Qp, int qstride, const bf16_t* K0, const bf16_t* VT0, int n0, int vts0, const bf16_t* K1, const bf16_t* VT1, int n1, int vts1,
                  bf16_t* outp, float cscale, float lam, const float* subln, float oscale) {
    constexpr int KD = DIFF ? 64 : 96, KP = KD + 8, NP = KD / 32, CPK = KD / 8;
    int tid = threadIdx.x; asm volatile("" : "+v"(tid)); const int lane = tid & 63, wid = tid >> 6, fr = lane & 15, g = lane >> 4;
    bf16x8 qf[NP];
#pragma unroll
    for (int pi = 0; pi < NP; ++pi) { u32x4 w = *(const u32x4*)(Qp + (size_t)(wid * 16 + fr) * qstride + pi * 32 + g * 8);
        w.x = pk2(bflo(w.x) * cscale, bfhi(w.x) * cscale); w.y = pk2(bflo(w.y) * cscale, bfhi(w.y) * cscale); w.z = pk2(bflo(w.z) * cscale, bfhi(w.z) * cscale); w.w = pk2(bflo(w.w) * cscale, bfhi(w.w) * cscale);
        qf[pi] = __builtin_bit_cast(bf16x8, w); }
    f32x4 O1[4], O2[4];
#pragma unroll
    for (int i = 0; i < 4; ++i) { O1[i] = (f32x4){0.f, 0.f, 0.f, 0.f}; O2[i] = (f32x4){0.f, 0.f, 0.f, 0.f}; }
    float l1 = 0.f, l2 = 0.f;
    const int nt0 = n0 >> 6, ntt = nt0 + (n1 >> 6);
    u32x4 pk0, pk1 = (u32x4){0u, 0u, 0u, 0u}, pv;
#define ATT_PREFETCH(ti) do { const bool s_ = (ti) >= nt0; const bf16_t* Kb = s_ ? K1 + (size_t)((ti) - nt0) * 64 * KD : K0 + (size_t)(ti) * 64 * KD; \
        const bf16_t* Vb = s_ ? VT1 + ((ti) - nt0) * 64 : VT0 + (ti) * 64; const int vs = s_ ? vts1 : vts0; \
        pk0 = *(const u32x4*)(Kb + tid * 8); if (!DIFF && tid < 256) pk1 = *(const u32x4*)(Kb + (512 + tid) * 8); pv = *(const u32x4*)(Vb + (size_t)(tid >> 3) * vs + (tid & 7) * 8); } while (0)
    constexpr int TILE_B = 64 * KP * 2 + 64 * 72 * 2;
#define ATT_STORE(buf) do { LAS bf16_t* Kt_ = (LAS bf16_t*)(lds + (buf) * TILE_B); LAS bf16_t* Vt_ = (LAS bf16_t*)(lds + (buf) * TILE_B + 64 * KP * 2); \
        *(LAS u32x4*)(Kt_ + (tid / CPK) * KP + (tid % CPK) * 8) = pk0; \
        if (!DIFF && tid < 256) { const int q_ = 512 + tid; *(LAS u32x4*)(Kt_ + (q_ / CPK) * KP + (q_ % CPK) * 8) = pk1; } \
        *(LAS u32x4*)(Vt_ + (tid >> 3) * 72 + (tid & 7) * 8) = pv; } while (0)
    ATT_PREFETCH(0);
    __syncthreads();
    ATT_STORE(0);
    if (ntt > 1) ATT_PREFETCH(1);
    __syncthreads();
    for (int ti = 0; ti < ntt; ++ti) {
        const LAS bf16_t* Kt = (const LAS bf16_t*)(lds + (ti & 1) * TILE_B); const LAS bf16_t* Vt = (const LAS bf16_t*)(lds + (ti & 1) * TILE_B + 64 * KP * 2);
        if (ti + 1 < ntt) { ATT_STORE((ti + 1) & 1); if (ti + 2 < ntt) ATT_PREFETCH(ti + 2); }
        f32x4 s1[4], s2[4];
#pragma unroll
        for (int kb = 0; kb < 4; ++kb) {
            const LAS bf16_t* kr = Kt + (kb * 16 + fr) * KP + g * 8; const f32x4 z = (f32x4){0.f, 0.f, 0.f, 0.f};
            if (DIFF) { s1[kb] = __builtin_amdgcn_mfma_f32_16x16x32_bf16(*(const LAS bf16x8*)kr, qf[0], z, 0, 0, 0); s2[kb] = __builtin_amdgcn_mfma_f32_16x16x32_bf16(*(const LAS bf16x8*)(kr + 32), qf[NP > 1 ? 1 : 0], z, 0, 0, 0); }
            else { f32x4 a = __builtin_amdgcn_mfma_f32_16x16x32_bf16(*(const LAS bf16x8*)kr, qf[0], z, 0, 0, 0); a = __builtin_amdgcn_mfma_f32_16x16x32_bf16(*(const LAS bf16x8*)(kr + 32), qf[NP > 1 ? 1 : 0], a, 0, 0, 0);
                   s1[kb] = __builtin_amdgcn_mfma_f32_16x16x32_bf16(*(const LAS bf16x8*)(kr + 64), qf[NP > 2 ? 2 : 0], a, 0, 0, 0); s2[kb] = z; }
        }
#pragma unroll
        for (int kb = 0; kb < 4; ++kb)
#pragma unroll
            for (int r = 0; r < 4; ++r) { const float e1 = __builtin_amdgcn_exp2f(s1[kb][r]); s1[kb][r] = e1; l1 += e1;
                if (DIFF) { const float e2 = __builtin_amdgcn_exp2f(s2[kb][r]); s2[kb][r] = e2; l2 += e2; } }
        bf16x8 pb1[2], pb2[2];
#pragma unroll
        for (int pp = 0; pp < 2; ++pp) { u32x4 w; w.x = pk2(s1[2 * pp][0], s1[2 * pp][1]); w.y = pk2(s1[2 * pp][2], s1[2 * pp][3]); w.z = pk2(s1[2 * pp + 1][0], s1[2 * pp + 1][1]); w.w = pk2(s1[2 * pp + 1][2], s1[2 * pp + 1][3]);
            pb1[pp] = __builtin_bit_cast(bf16x8, w);
            if (DIFF) { u32x4 w2; w2.x = pk2(s2[2 * pp][0], s2[2 * pp][1]); w2.y = pk2(s2[2 * pp][2], s2[2 * pp][3]); w2.z = pk2(s2[2 * pp + 1][0], s2[2 * pp + 1][1]); w2.w = pk2(s2[2 * pp + 1][2], s2[2 * pp + 1][3]); pb2[pp] = __builtin_bit_cast(bf16x8, w2); } }
#pragma unroll
        for (int dvb = 0; dvb < 4; ++dvb)
#pragma unroll
            for (int pp = 0; pp < 2; ++pp) { const LAS bf16_t* vr = Vt + (dvb * 16 + fr) * 72 + pp * 32 + g * 4;
                const u32x2 lo = *(const LAS u32x2*)vr, hi = *(const LAS u32x2*)(vr + 16); const u32x4 vv = (u32x4){lo.x, lo.y, hi.x, hi.y}; const bf16x8 vf = __builtin_bit_cast(bf16x8, vv);
                O1[dvb] = __builtin_amdgcn_mfma_f32_16x16x32_bf16(vf, pb1[pp], O1[dvb], 0, 0, 0);
                if (DIFF) O2[dvb] = __builtin_amdgcn_mfma_f32_16x16x32_bf16(vf, pb2[pp], O2[dvb], 0, 0, 0); }
        __syncthreads();
    }
#undef ATT_PREFETCH
#undef ATT_STORE
    l1 += __shfl_xor(l1, 16); l1 += __shfl_xor(l1, 32);
    const float i1 = 1.0f / l1; float o[4][4];
    if (DIFF) { l2 += __shfl_xor(l2, 16); l2 += __shfl_xor(l2, 32); const float i2 = lam / l2; float ss = 0.f;
#pragma unroll
        for (int dvb = 0; dvb < 4; ++dvb)
#pragma unroll
            for (int r = 0; r < 4; ++r) { o[dvb][r] = O1[dvb][r] * i1 - O2[dvb][r] * i2; ss += o[dvb][r] * o[dvb][r]; }
        ss += __shfl_xor(ss, 16); ss += __shfl_xor(ss, 32);
        const float rn = rsqrtf(ss * (1.0f / 64.0f) + EPSV) * oscale;
#pragma unroll
        for (int dvb = 0; dvb < 4; ++dvb)
#pragma unroll
            for (int r = 0; r < 4; ++r) o[dvb][r] = o[dvb][r] * rn * subln[dvb * 16 + g * 4 + r];
    } else {
#pragma unroll
        for (int dvb = 0; dvb < 4; ++dvb)
#pragma unroll
            for (int r = 0; r < 4; ++r) o[dvb][r] = O1[dvb][r] * i1;
    }
    bf16_t* orow = outp + (size_t)(wid * 16 + fr) * DM + g * 4;
#pragma unroll
    for (int dvb = 0; dvb < 4; ++dvb) { u32x2 w; w.x = pk2(o[dvb][0], o[dvb][1]); w.y = pk2(o[dvb][2], o[dvb][3]); *(u32x2*)(orow + dvb * 16) = w; }
}

DI void phase_attn(const Params& p, LAS unsigned char* lds, int l, int G, int c) {
    unsigned char* ws = p.ws;
    const float* lq = p.in[I_DLAM] + l * 128; float d01 = 0.f, d23 = 0.f;
    for (int i = 0; i < 32; ++i) { d01 += lq[i] * lq[32 + i]; d23 += lq[64 + i] * lq[96 + i]; }
    const float lam_init = 0.8f - 0.6f * expf(-0.3f * (float)l), lam = expf(d01) - expf(d23) + lam_init;
    const bf16_t* Qd = (const bf16_t*)(ws + WS_HM + HM_QD); const bf16_t* Qm = (const bf16_t*)(ws + WS_HM + HM_QM);
    const bf16_t* Kds = (const bf16_t*)(ws + WS_KDS); const bf16_t* VdTs = (const bf16_t*)(ws + WS_VDTS); const bf16_t* Kms = (const bf16_t*)(ws + WS_HM + HM_KMS); const bf16_t* VmTs = (const bf16_t*)(ws + WS_VMTS);
    const bf16_t* Kdc = (const bf16_t*)(ws + WS_KDC); const bf16_t* VdTc = (const bf16_t*)(ws + WS_VDTC); const bf16_t* Kmc = (const bf16_t*)(ws + WS_KMC); const bf16_t* VmTc = (const bf16_t*)(ws + WS_VMTC);
    bf16_t* br = (bf16_t*)(ws + WS_R2 + R2_BR);
    const float cs_da = 0.17677669529663687f * 1.4426950408889634f, cs_ml = 0.10206207261596577f * 1.4426950408889634f;
    for (int L = c; L < 768; L += G) {
        bool mla, lat; int b, h, qb;
        if (L < 512) { lat = true; mla = L >= 256; const int i = L & 255; b = i >> 5; h = (i >> 3) & 3; qb = i & 7; }
        else { lat = false; const int i = L - 512; mla = i >= 128; const int j = i & 127; b = j >> 3; h = (j >> 1) & 3; qb = j & 1; }
        const int T = lat ? 1024 : 256, sb = lat ? MC + b * 1024 : b * 256, row0 = sb + qb * 128, n0 = lat ? 512 : 0;
        const size_t cidx = ((size_t)(l * 8 + b) * 4 + h);
        if (!mla) attn_item<true>(lds, Qd + (size_t)row0 * 256 + h * 64, 256, Kdc + cidx * 512 * 64, VdTc + cidx * 64 * 512, n0, 512, Kds + (size_t)sb * 256 + (size_t)h * T * 64, VdTs + (size_t)sb * 256 + (size_t)h * 64 * T, T, T,
                                  br + (size_t)row0 * DM + 256 + h * 64, cs_da, lam, p.in[I_DSUB] + l * 64, 1.0f - lam_init);
        else attn_item<false>(lds, Qm + (size_t)row0 * 384 + h * 96, 384, Kmc + cidx * 512 * 96, VmTc + cidx * 64 * 512, n0, 512, Kms + (size_t)sb * 384 + (size_t)h * T * 96, VmTs + (size_t)sb * 256 + (size_t)h * 64 * T, T, T,
                              br + (size_t)row0 * DM + 768 + h * 64, cs_ml, 0.f, nullptr, 1.0f);
    }
    __syncthreads();
}

DI void phase_convact(const Params& p, int l, int G, int c) {
    const bf16_t* u2 = (const bf16_t*)(p.ws + WS_R1); bf16_t* act = (bf16_t*)(p.ws + WS_R2);
    const float* cw = p.in[I_CONVW] + (size_t)l * 3 * F2; const float* cbp = p.in[I_CONVB] + (size_t)l * F2;
    int tidc = threadIdx.x; asm volatile("" : "+v"(tidc));
    for (size_t idx = (size_t)c * NTHR + tidc; idx < (size_t)(MT / 8) * 352; idx += (size_t)G * NTHR) {
        const int ch = (int)(idx % 352), seg = (int)(idx / 352), f = ch * 8, r0 = seg * 8;
        const bool lat = r0 >= MC; const int T = lat ? 1024 : 256, t0 = lat ? ((r0 - MC) & 1023) : (r0 & 255);
        float wg[3][8], wv[3][8], bg[8], bv[8];
#pragma unroll
        for (int j = 0; j < 3; ++j)
#pragma unroll
            for (int q = 0; q < 2; ++q) { const f32x4 a = *(const f32x4*)(cw + j * F2 + f + q * 4), b = *(const f32x4*)(cw + j * F2 + FH + f + q * 4);
#pragma unroll
                for (int e = 0; e < 4; ++e) { wg[j][q * 4 + e] = a[e]; wv[j][q * 4 + e] = b[e]; } }
#pragma unroll
        for (int q = 0; q < 2; ++q) { const f32x4 a = *(const f32x4*)(cbp + f + q * 4), b = *(const f32x4*)(cbp + FH + f + q * 4);
#pragma unroll
            for (int e = 0; e < 4; ++e) { bg[q * 4 + e] = a[e]; bv[q * 4 + e] = b[e]; } }
        const u32x4 zz = (u32x4){0u, 0u, 0u, 0u};
        u32x4 pg = t0 > 0 ? *(const u32x4*)(u2 + (size_t)(r0 - 1) * F2 + f) : zz, pvv = t0 > 0 ? *(const u32x4*)(u2 + (size_t)(r0 - 1) * F2 + FH + f) : zz;
        u32x4 cg_ = *(const u32x4*)(u2 + (size_t)r0 * F2 + f), cv_ = *(const u32x4*)(u2 + (size_t)r0 * F2 + FH + f);
#pragma unroll 2
        for (int i = 0; i < 8; ++i) {
            const bool hn = (t0 + i + 1) < T;
            const u32x4 ng = hn ? *(const u32x4*)(u2 + (size_t)(r0 + i + 1) * F2 + f) : zz, nv = hn ? *(const u32x4*)(u2 + (size_t)(r0 + i + 1) * F2 + FH + f) : zz;
            float o[8];
#define CA_ONE(e, PW, CW, NW, PV, CV, NV, HI) { const float gp = HI ? bfhi(PW) : bflo(PW), gc = HI ? bfhi(CW) : bflo(CW), gn = HI ? bfhi(NW) : bflo(NW); \
                const float vp = HI ? bfhi(PV) : bflo(PV), vc = HI ? bfhi(CV) : bflo(CV), vn = HI ? bfhi(NV) : bflo(NV); \
                const float Gv = wg[0][e] * gp + wg[1][e] * gc + wg[2][e] * gn + bg[e], Vv = wv[0][e] * vp + wv[1][e] * vc + wv[2][e] * vn + bv[e]; o[e] = Gv * sigmoidf_(Gv) * Vv; }
            CA_ONE(0, pg.x, cg_.x, ng.x, pvv.x, cv_.x, nv.x, 0) CA_ONE(1, pg.x, cg_.x, ng.x, pvv.x, cv_.x, nv.x, 1)
            CA_ONE(2, pg.y, cg_.y, ng.y, pvv.y, cv_.y, nv.y, 0) CA_ONE(3, pg.y, cg_.y, ng.y, pvv.y, cv_.y, nv.y, 1)
            CA_ONE(4, pg.z, cg_.z, ng.z, pvv.z, cv_.z, nv.z, 0) CA_ONE(5, pg.z, cg_.z, ng.z, pvv.z, cv_.z, nv.z, 1)
            CA_ONE(6, pg.w, cg_.w, ng.w, pvv.w, cv_.w, nv.w, 0) CA_ONE(7, pg.w, cg_.w, ng.w, pvv.w, cv_.w, nv.w, 1)
#undef CA_ONE
            u32x4 w; w.x = pk2(o[0], o[1]); w.y = pk2(o[2], o[3]); w.z = pk2(o[4], o[5]); w.w = pk2(o[6], o[7]);
            *(u32x4*)(act + (size_t)(r0 + i) * FH + f) = w;
            pg = cg_; pvv = cv_; cg_ = ng; cv_ = nv;
        }
    }
}


DI void gbar(unsigned* ctr, unsigned G) {
    asm volatile("s_waitcnt vmcnt(0) lgkmcnt(0)" ::: "memory");
    __syncthreads();
    if (threadIdx.x < 64) {
        if (threadIdx.x == 0) {
            __builtin_amdgcn_fence(__ATOMIC_RELEASE, "agent");
            asm volatile("s_waitcnt vmcnt(0)" ::: "memory");
            __hip_atomic_fetch_add(ctr, 1u, __ATOMIC_RELAXED, __HIP_MEMORY_SCOPE_AGENT);
            const unsigned long long t0 = __builtin_amdgcn_s_memrealtime();
            while (__hip_atomic_load(ctr, __ATOMIC_RELAXED, __HIP_MEMORY_SCOPE_AGENT) < G) {
                __builtin_amdgcn_s_sleep(2);
                if (__builtin_amdgcn_s_memrealtime() - t0 > 20000000ull) break;
            }
        }
        __builtin_amdgcn_fence(__ATOMIC_ACQUIRE, "agent");
        asm volatile("s_waitcnt vmcnt(0)" ::: "memory");
    }
    __syncthreads();
}

#define XB_TMO      128
#define XB_XCNT(j)  (256  + 64 * (j))
#define XB_XSUB(j)  (1280 + 64 * (j))
#define XB_XGEN(j)  (2304 + 64 * (j))
#define XB_TOP      3328
#define XB_TOPGEN   3392
#define XCD_BAR_WORDS 3456
#define XB_SPIN_CAP (1u << 18)
DI unsigned xb_ld(unsigned* p)              { return __hip_atomic_load(p, __ATOMIC_RELAXED, __HIP_MEMORY_SCOPE_AGENT); }
DI unsigned xb_add(unsigned* p, unsigned v) { return __hip_atomic_fetch_add(p, v, __ATOMIC_RELAXED, __HIP_MEMORY_SCOPE_AGENT); }
DI unsigned xb_xcc_id() { return (unsigned)__builtin_amdgcn_s_getreg((3 << 11) | 20) & 0xFu; }
#define XB_SPIN(cond, bar) do { unsigned _sp = 0; while (cond) { __builtin_amdgcn_s_sleep(1); \
    if ((++_sp & 255u) == 0u) { if (xb_ld(&(bar)[XB_TMO])) break; if (_sp > XB_SPIN_CAP) { atomicAdd(&(bar)[XB_TMO], 1u); break; } } } } while (0)
struct XcdBarrier { unsigned* bar; unsigned x; volatile LAS unsigned* st; };
DI XcdBarrier xcd_barrier_post(unsigned* bar, volatile LAS unsigned* st) {
    XcdBarrier b; b.bar = bar; b.x = xb_xcc_id(); b.st = st;
    if (threadIdx.x == 0) (void)xb_add(&bar[XB_XCNT(b.x)], 1u);
    return b;
}
DI void xcd_barrier_complete(unsigned* bar, unsigned x, unsigned& nloc, unsigned& nx) {
    const unsigned G = gridDim.x * gridDim.y * gridDim.z;
    unsigned sum, cnt, mine, sp = 0u;
    for (;;) {
        sum = 0u; cnt = 0u; mine = 0u;
#pragma unroll
        for (unsigned j = 0; j < 16; ++j) { const unsigned c = xb_ld(&bar[XB_XCNT(j)]); sum += c; cnt += (c > 0u) ? 1u : 0u; mine = (j == x) ? c : mine; }
        if (sum == G) break;
        __builtin_amdgcn_s_sleep(1);
        if ((++sp & 255u) == 0u) { if (xb_ld(&bar[XB_TMO])) break; if (sp > XB_SPIN_CAP) { atomicAdd(&bar[XB_TMO], 1u); break; } }
    }
    nloc = mine > 0u ? mine : 1u; nx = cnt > 0u ? cnt : 1u;
}
DI void xcd_barrier(const XcdBarrier& b) {
    asm volatile("s_waitcnt vmcnt(0) lgkmcnt(0)" ::: "memory");
    __syncthreads();
    if (threadIdx.x == 0) {
        unsigned* bar = b.bar;
        __builtin_amdgcn_s_waitcnt(0);
        unsigned nloc = b.st[0], nx = b.st[1];
        if (nloc == 0u) { xcd_barrier_complete(bar, b.x, nloc, nx); b.st[0] = nloc; b.st[1] = nx; }
        const unsigned old = xb_add(&bar[XB_XSUB(b.x)], 1u);
        const unsigned gen = old / nloc;
        if (old + 1u == (gen + 1u) * nloc) {
            __builtin_amdgcn_fence(__ATOMIC_RELEASE, "agent");
            asm volatile("s_waitcnt vmcnt(0)" ::: "memory");
            const unsigned og = xb_add(&bar[XB_TOP], 1u);
            const unsigned tg = og / nx;
            if (og + 1u == (tg + 1u) * nx) xb_add(&bar[XB_TOPGEN], 1u);
            else XB_SPIN(xb_ld(&bar[XB_TOPGEN]) == tg, bar);
            __builtin_amdgcn_fence(__ATOMIC_ACQUIRE, "agent");
            xb_add(&bar[XB_XGEN(b.x)], 1u);
            asm volatile("s_waitcnt vmcnt(0)" ::: "memory");
        } else {
            XB_SPIN(xb_ld(&bar[XB_XGEN(b.x)]) == gen, bar);
            __builtin_amdgcn_fence(__ATOMIC_ACQUIRE, "agent");
            asm volatile("s_waitcnt vmcnt(0)" ::: "memory");
        }
    }
    __syncthreads();
}
#ifndef PHMASK
#define PHMASK 0xFFFF
#endif
#define PHM(k) ((PHMASK >> (k)) & 1)
__global__ void __launch_bounds__(NTHR) mega(Params p) {
    extern __shared__ __attribute__((aligned(16))) unsigned char lds_raw[];
    LAS unsigned char* lds = (LAS unsigned char*)lds_raw;
    cg::grid_group grid = cg::this_grid();
    const int G = gridDim.x, c = blockIdx.x;
    unsigned char* ws = p.ws;
    bf16_t* hm = (bf16_t*)(ws + WS_HM); bf16_t* sg = (bf16_t*)(ws + WS_R1 + R1_SG); bf16_t* us = (bf16_t*)(ws + WS_R1 + R1_US);
    bf16_t* br = (bf16_t*)(ws + WS_R2 + R2_BR); float* mod = (float*)(ws + WS_MOD);
    volatile LAS unsigned* xst = (volatile LAS unsigned*)(lds + 131072);
    if (threadIdx.x < 4) xst[threadIdx.x] = 0u;
    if (c == 0) { unsigned* bw = (unsigned*)ws; for (int i = threadIdx.x; i < XCD_BAR_WORDS; i += NTHR) bw[i] = 0u; }
    asm volatile("s_waitcnt vmcnt(0) lgkmcnt(0)" ::: "memory");
    __syncthreads();
    grid.sync();
    const XcdBarrier xbar = xcd_barrier_post((unsigned*)ws, xst);
    for (int ph = p.lo; ph < p.hi; ++ph) {
        if (ph == 0) { if (PHM(12)) phase_prepass(p, lds, G, c); }
        else if (ph == 1 && PHM(11)) {
            pg8::Gemm g{256, 256, 256}; pg8::SchedPlain S; S.set(ws + WS_R1 + R1_AC, ws + WS_WUKVP, 256, 256, 64, 2, G, c, -1, 4, SZ_SM);
            pg8::EpiStore E{(bf16_t*)(ws + WS_R1 + R1_KVRC), 512, nullptr, 0}; pg8::gemm_phase(lds, g, S, E);
        } else {
            const int l = (ph - 2) / 11, s = (ph - 2) % 11;
            if (s == 0 && PHM(0)) { if (l == 0) phase_mla_finish<true>(p, lds, 0, G, c); phase_norm(p, l, 0, l == 0, G, c); }
            else if (s == 1 && PHM(1)) { pg8::Gemm g{DM, DM, DM}; pg8::SchedPlain S; S.set(hm, ws + WS_WIN + l * SZ_WIN, DM, DM, MT / 256, INP / 256, G, c); pg8::EpiIn E{sg, us}; pg8::gemm_phase(lds, g, S, E); }
            else if (s == 2 && PHM(2)) {
                { pg8::Gemm g{USW, 256, 256}; pg8::SchedPlain S; S.set(us + US_FT, ws + WS_BDFT, USW, 256, MT / 256, 2, G, c); pg8::EpiZt E{(bf16_t*)(ws + WS_R2 + R2_ZTL), (bf16_t*)(ws + WS_R2 + R2_ZTC)}; pg8::gemm_phase(lds, g, S, E); }
                __syncthreads();
                { pg8::Gemm g{USW, 256, 256}; pg8::SchedPlain S; S.set(us + US_CQ, ws + WS_WUQ + l * SZ_SM, USW, 256, MT / 256, 2, G, (c + G - 96 % G) % G); pg8::EpiStore E{(bf16_t*)(ws + WS_R2 + R2_QRAW), 512, nullptr, 0}; pg8::gemm_phase(lds, g, S, E); }
                __syncthreads();
                { pg8::Gemm g{USW, 256, 256}; pg8::SchedPlain S; S.set(us + US_CKV, ws + WS_WUKV + l * SZ_SM, USW, 256, MT / 256, 2, G, (c + G - 192 % G) % G); pg8::EpiStore E{(bf16_t*)(ws + WS_R2 + R2_KVRAW), 512, nullptr, 0}; pg8::gemm_phase(lds, g, S, E); }
                __syncthreads();
                phase_c1_rows(p, lds, l, G, c);
            } else if (s == 3 && PHM(3)) {
                { pg8::Gemm g{256, 256, 256}; pg8::SchedPlain S; S.set(ws + WS_R2 + R2_POOLED, ws + WS_BDPOOL + l * SZ_BDPOOL, 256, 256, MT / 256, 1, G, c); pg8::EpiStore E{br, DM, p.in[I_POOLS] + l * 256, 0}; pg8::gemm_phase(lds, g, S, E); }
                __syncthreads();
                { pg8::Gemm g{2048, 2048, 2048}; pg8::SchedPlain S; S.set(ws + WS_D1024, ws + WS_R2 + R2_ZTL, 2048, 2048, 4, 8, G, (c + G - 48 % G) % G); pg8::EpiStore E{br, DM, nullptr, 1}; pg8::gemm_phase(lds, g, S, E); }
                __syncthreads();
                { pg8::Gemm g{512, 512, 512}; pg8::SchedPlain S; S.set(ws + WS_D256, ws + WS_R2 + R2_ZTC, 512, 512, 16, 1, G, (c + G - 80 % G) % G, 0, 0, (size_t)256 * 512 * 2); pg8::EpiStore E{br, DM, nullptr, 2}; pg8::gemm_phase(lds, g, S, E); }
                __syncthreads();
                phase_mla_finish<false>(p, lds, l, G, c);
            } else if (s == 4 && PHM(4)) phase_attn(p, lds, l, G, c);
            else if (s == 5 && PHM(5)) { pg8::Gemm g{DM, 256, 256}; pg8::SchedGate S; S.init(MT / 256, 16, G, c); S.A = (const char*)br; S.B = (const char*)(ws + WS_WB + l * SZ_WB);
                pg8::EpiGate E{sg}; pg8::gemm_phase(lds, g, S, E);
                xcd_barrier(xbar);
                int tidm = threadIdx.x; asm volatile("" : "+v"(tidm));
#pragma unroll 3
                for (size_t i = (size_t)c * NTHR + tidm; i < (size_t)MT * 128; i += (size_t)G * NTHR) { const size_t row = i >> 7; const int d = (int)(i & 127) * 8; const bf16_t* gp = sg + row * 4096 + d;
                    float a[8];
#pragma unroll
                    for (int j = 0; j < 8; ++j) a[j] = 0.f;
#pragma unroll
                    for (int n = 0; n < 4; ++n) { const u32x4 v = *(const u32x4*)(gp + n * 1024); a[0] += bflo(v.x); a[1] += bfhi(v.x); a[2] += bflo(v.y); a[3] += bfhi(v.y); a[4] += bflo(v.z); a[5] += bfhi(v.z); a[6] += bflo(v.w); a[7] += bfhi(v.w); }
                    u32x4 w; w.x = pk2(a[0], a[1]); w.y = pk2(a[2], a[3]); w.z = pk2(a[4], a[5]); w.w = pk2(a[6], a[7]); *(u32x4*)(hm + row * DM + d) = w; } }
            else if (s == 6 && PHM(6)) { pg8::Gemm g{DM, DM, DM}; pg8::SchedPlain S; S.set(hm, ws + WS_WO + l * SZ_WO, DM, DM, MT / 256, 4, G, c);
                pg8::EpiResid E{l == 0 ? p.in[I_XP] : nullptr, p.in[I_XS], p.out, mod + (size_t)l * 9 * 6144 + 2 * 1024}; pg8::gemm_phase(lds, g, S, E); }
            else if (s == 7 && PHM(7)) phase_norm(p, l, 1, false, G, c);
            else if (s == 8 && PHM(8)) { pg8::Gemm g{DM, DM, DM}; pg8::SchedPlain S; S.set(hm, ws + WS_WUP + l * SZ_WUP, DM, DM, MT / 256, F2 / 256, G, c); pg8::EpiStore E{(bf16_t*)(ws + WS_R1), F2, nullptr, 0}; pg8::gemm_phase(lds, g, S, E); }
            else if (s == 9 && PHM(9)) phase_convact(p, l, G, c);
            else if (PHM(10)) { pg8::Gemm g{FH, FH, FH}; pg8::SchedPlain S; S.set(ws + WS_R2, ws + WS_WD + l * SZ_WD, FH, FH, MT / 256, 4, G, c);
                pg8::EpiResid E{nullptr, nullptr, p.out, mod + (size_t)l * 9 * 6144 + 5 * 1024}; pg8::gemm_phase(lds, g, S, E);
                if (l + 1 < NLAY && G == 256 && c >= 192) { __syncthreads(); convert_layer_weights(p, lds, l + 1, 64, c - 192); }
                else if (l + 1 < NLAY && G != 256) { __syncthreads(); convert_layer_weights(p, lds, l + 1, G, c); } }
        }
        if (ph + 1 < p.hi) {
            xcd_barrier(xbar); }
    }
}

constexpr int N_PHASES = 2 + NLAY * 11;

extern "C" void kernel_launch(void* const* d_in, const int* in_sizes, int n_in, void* d_out, int out_size, void* d_ws, size_t ws_size, hipStream_t stream) {
    static int grid = 0;
    if (grid == 0) {
        if (n_in != 31 || ws_size < WS_END) { fprintf(stderr, "kernel_launch: need 31 inputs and %zu bytes of workspace; got %d, %zu\n", (size_t)WS_END, n_in, ws_size); grid = -1; return; }
        int dev = 0, cus = 0, per_cu = 0;
        (void)hipGetDevice(&dev); (void)hipDeviceGetAttribute(&cus, hipDeviceAttributeMultiprocessorCount, dev);
        if (hipFuncSetAttribute((const void*)mega, hipFuncAttributeMaxDynamicSharedMemorySize, LDS_BYTES) != hipSuccess) { fprintf(stderr, "kernel_launch: hipFuncSetAttribute failed\n"); grid = -1; return; }
        if (hipOccupancyMaxActiveBlocksPerMultiprocessor(&per_cu, (const void*)mega, NTHR, LDS_BYTES) != hipSuccess || per_cu < 1) { fprintf(stderr, "kernel_launch: occupancy query failed (%d)\n", per_cu); grid = -1; return; }
        grid = cus * per_cu;
    }
    if (grid < 0) return;
    Params p{};
    for (int i = 0; i < 31; ++i) p.in[i] = (const float*)d_in[i];
    p.out = (float*)d_out; p.ws = (unsigned char*)d_ws; p.lo = 0; p.hi = N_PHASES;
    void* args[] = {&p};
    hipError_t e = hipLaunchCooperativeKernel((const void*)mega, dim3(grid), dim3(NTHR), args, LDS_BYTES, stream);
    if (e != hipSuccess) fprintf(stderr, "cooperative launch failed: %s (grid %d)\n", hipGetErrorString(e), grid);
}
```
